# Optimizing an MI355X kernel written in HIP

```python
import math
import jax, jax.numpy as jnp
from jax import lax
import numpy as np

D_MODEL = 2048
BATCH = 1
SEQ = 8192
DEPTH = 1

HEAD_DIM = 64
N_Q_HEADS = 16
N_KV_HEADS = 2
GROUP = N_Q_HEADS // N_KV_HEADS
WINDOW = 128
BLOCK = 128
ROT_DIM = HEAD_DIM // 4
ROPE_THETA = 500000.0
Q_W = N_Q_HEADS * HEAD_DIM
KV_W = N_KV_HEADS * HEAD_DIM

SSM_W = D_MODEL // 2
SSM_GC = 16
SSM_G = SSM_W // SSM_GC
SSM_P = 64

D_FF = 4 * D_MODEL

MIX_W = Q_W + SSM_W
IN_W = Q_W + 2 * KV_W + SSM_W + 2 * D_MODEL
EPS = 1e-6

kernel_name = "hybrid_swa_sink_s5_gated_block"


def rms_norm(x, g):
    xf = x.astype(jnp.float32)
    y = xf * lax.rsqrt(jnp.mean(xf * xf, axis=-1, keepdims=True) + EPS)
    return (y * g.astype(jnp.float32)).astype(x.dtype)


def partial_rope(x, pos):
    half = ROT_DIM // 2
    inv = ROPE_THETA ** (-jnp.arange(half, dtype=jnp.float32) * 2.0 / ROT_DIM)
    ang = pos.astype(jnp.float32)[:, None] * inv[None, :]
    cos = jnp.cos(ang)[None, :, None, :]
    sin = jnp.sin(ang)[None, :, None, :]
    xr = x[..., :ROT_DIM].astype(jnp.float32)
    x1, x2 = xr[..., :half], xr[..., half:]
    rot = jnp.concatenate([x1 * cos - x2 * sin, x2 * cos + x1 * sin], axis=-1)
    return jnp.concatenate([rot.astype(x.dtype), x[..., ROT_DIM:]], axis=-1)


def sliding_window_gqa_sinks(q, k, v, sinks):
    B, L = q.shape[0], q.shape[1]
    nb = L // BLOCK
    qb = q.reshape(B, nb, BLOCK, N_KV_HEADS, GROUP, HEAD_DIM)
    pad = jnp.zeros((B, BLOCK, N_KV_HEADS, HEAD_DIM), k.dtype)
    kp = jnp.concatenate([pad, k], axis=1)
    vp = jnp.concatenate([pad, v], axis=1)
    shp = (B, nb, BLOCK, N_KV_HEADS, HEAD_DIM)
    kb = jnp.concatenate([kp[:, :-BLOCK].reshape(shp), kp[:, BLOCK:].reshape(shp)], axis=2)
    vb = jnp.concatenate([vp[:, :-BLOCK].reshape(shp), vp[:, BLOCK:].reshape(shp)], axis=2)
    s = jnp.einsum('bnqhgd,bnkhd->bnhgqk', qb, kb).astype(jnp.float32) / math.sqrt(HEAD_DIM)
    qi = jnp.arange(BLOCK)[:, None]
    kj = jnp.arange(2 * BLOCK)[None, :]
    rel = qi + BLOCK - kj
    kpos = jnp.arange(nb)[:, None, None] * BLOCK - BLOCK + kj[None]
    mask = (rel >= 0)[None] & (rel < WINDOW)[None] & (kpos >= 0)
    s = jnp.where(mask[None, :, None, None], s, jnp.finfo(jnp.float32).min)
    sink = jnp.broadcast_to(
        sinks.astype(jnp.float32).reshape(N_KV_HEADS, GROUP)[None, None, :, :, None, None],
        s.shape[:-1] + (1,))
    p = jax.nn.softmax(jnp.concatenate([s, sink], axis=-1), axis=-1)[..., :-1]
    o = jnp.einsum('bnhgqk,bnkhd->bnqhgd', p.astype(v.dtype), vb)
    return o.reshape(B, L, Q_W)


def s5_mixer(u, lam_re, lam_im, log_dt, b_re, b_im, c_re, c_im, d_skip, w_glu):
    B, L = u.shape[0], u.shape[1]
    f32 = jnp.float32
    ug = u.reshape(B, L, SSM_G, SSM_GC).astype(f32)
    lr, li = lam_re.astype(f32), lam_im.astype(f32)
    dt = jnp.exp(log_dt.astype(f32))[:, None]
    mag = jnp.exp(lr * dt)
    a_re, a_im = mag * jnp.cos(li * dt), mag * jnp.sin(li * dt)
    den = lr * lr + li * li
    nr, ni = a_re - 1.0, a_im
    coef_re = (nr * lr + ni * li) / den
    coef_im = (ni * lr - nr * li) / den
    br, bi = b_re.astype(f32), b_im.astype(f32)
    bb_re = coef_re[..., None] * br - coef_im[..., None] * bi
    bb_im = coef_re[..., None] * bi + coef_im[..., None] * br
    bu_re = jnp.einsum('blgc,gpc->blgp', ug, bb_re)
    bu_im = jnp.einsum('blgc,gpc->blgp', ug, bb_im)
    at_re = jnp.broadcast_to(a_re, bu_re.shape)
    at_im = jnp.broadcast_to(a_im, bu_im.shape)

    def combine(e1, e2):
        ar1, ai1, br1, bi1 = e1
        ar2, ai2, br2, bi2 = e2
        return (ar2 * ar1 - ai2 * ai1,
                ar2 * ai1 + ai2 * ar1,
                ar2 * br1 - ai2 * bi1 + br2,
                ar2 * bi1 + ai2 * br1 + bi2)

    _, _, xs_re, xs_im = lax.associative_scan(combine, (at_re, at_im, bu_re, bu_im), axis=1)
    y = (jnp.einsum('blgp,gcp->blgc', xs_re, c_re.astype(f32))
         - jnp.einsum('blgp,gcp->blgc', xs_im, c_im.astype(f32))
         + d_skip.astype(f32)[None, None] * ug)
    y = jax.nn.gelu(y.reshape(B, L, SSM_W)).astype(u.dtype)
    zg = y @ w_glu
    return zg[..., :SSM_W] * jax.nn.sigmoid(zg[..., SSM_W:])


def setup_inputs(seed: int = 0) -> dict:
    key = jax.random.key(seed)
    ks = jax.random.split(key, 24)
    f32 = jnp.float32
    nrm = lambda k, shp, s: jax.random.normal(k, shp, f32) * s
    x = jax.random.normal(ks[0], (BATCH, SEQ, D_MODEL), f32)
    gain = lambda k: 1.0 + nrm(k, (DEPTH, D_MODEL), 0.02)
    n_idx = jnp.arange(SSM_P, dtype=f32)
    lam_re = -0.5 + nrm(ks[9], (DEPTH, SSM_G, SSM_P), 0.01)
    lam_im = jnp.pi * n_idx[None, None, :] + nrm(ks[10], (DEPTH, SSM_G, SSM_P), 0.01)
    log_dt = jax.random.uniform(ks[11], (DEPTH, SSM_G), f32, math.log(1e-3), math.log(1e-1))
    return {
        "x": x,
        "norm_mix_pre": gain(ks[1]),
        "norm_mix_post": gain(ks[2]),
        "norm_mlp_pre": gain(ks[3]),
        "norm_mlp_post": gain(ks[4]),
        "w_in": nrm(ks[5], (DEPTH, D_MODEL, IN_W), D_MODEL ** -0.5),
        "sinks": nrm(ks[6], (DEPTH, N_Q_HEADS), 0.5),
        "lam_re": lam_re,
        "lam_im": lam_im,
        "log_dt": log_dt,
        "b_re": nrm(ks[12], (DEPTH, SSM_G, SSM_P, SSM_GC), (2 * SSM_GC) ** -0.5),
        "b_im": nrm(ks[13], (DEPTH, SSM_G, SSM_P, SSM_GC), (2 * SSM_GC) ** -0.5),
        "c_re": nrm(ks[14], (DEPTH, SSM_G, SSM_GC, SSM_P), (2 * SSM_P) ** -0.5),
        "c_im": nrm(ks[15], (DEPTH, SSM_G, SSM_GC, SSM_P), (2 * SSM_P) ** -0.5),
        "d_skip": nrm(ks[16], (DEPTH, SSM_G, SSM_GC), 1.0),
        "w_glu": nrm(ks[17], (DEPTH, SSM_W, 2 * SSM_W), SSM_W ** -0.5),
        "w_branch": nrm(ks[18], (DEPTH, MIX_W, D_MODEL), (MIX_W // 2) ** -0.5),
        "w_out": nrm(ks[19], (DEPTH, D_MODEL, D_MODEL), D_MODEL ** -0.5),
        "w_up": nrm(ks[20], (DEPTH, D_MODEL, D_FF), D_MODEL ** -0.5),
        "w_down": nrm(ks[21], (DEPTH, D_FF, D_MODEL), D_FF ** -0.5),
    }


def reference(x, norm_mix_pre, norm_mix_post, norm_mlp_pre, norm_mlp_post, w_in, sinks,
              lam_re, lam_im, log_dt, b_re, b_im, c_re, c_im, d_skip, w_glu,
              w_branch, w_out, w_up, w_down):
    B, L, _ = x.shape
    pos = jnp.arange(L)
    o1 = Q_W
    o2 = o1 + KV_W
    o3 = o2 + KV_W
    o4 = o3 + SSM_W
    o5 = o4 + D_MODEL
    for l in range(DEPTH):
        h = rms_norm(x, norm_mix_pre[l])
        z = h @ w_in[l]
        q = z[..., :o1].reshape(B, L, N_Q_HEADS, HEAD_DIM)
        k = z[..., o1:o2].reshape(B, L, N_KV_HEADS, HEAD_DIM)
        v = z[..., o2:o3].reshape(B, L, N_KV_HEADS, HEAD_DIM)
        u = z[..., o3:o4]
        g_attn = jax.nn.sigmoid(z[..., o4:o5].astype(jnp.float32)).astype(x.dtype)
        g_ssm = jax.nn.sigmoid(z[..., o5:].astype(jnp.float32)).astype(x.dtype)
        q = partial_rope(q, pos)
        k = partial_rope(k, pos)
        o_attn = sliding_window_gqa_sinks(q, k, v, sinks[l])
        o_ssm = s5_mixer(u, lam_re[l], lam_im[l], log_dt[l], b_re[l], b_im[l],
                         c_re[l], c_im[l], d_skip[l], w_glu[l])
        y_attn = o_attn @ w_branch[l][:Q_W]
        y_ssm = o_ssm @ w_branch[l][Q_W:]
        mixed = (g_attn * y_attn + g_ssm * y_ssm) @ w_out[l]
        x = x + rms_norm(mixed, norm_mix_post[l])
        h2 = rms_norm(x, norm_mlp_pre[l])
        a = jax.nn.relu(h2 @ w_up[l])
        x = x + rms_norm((a * a) @ w_down[l], norm_mlp_post[l])
    return x
```

```cpp
#include <hip/hip_runtime.h>
#include <hip/hip_cooperative_groups.h>
#include <cstdio>
#include <cstdint>
namespace cg = cooperative_groups;

#ifndef COOP
#define COOP 0
#endif

typedef unsigned short bf16_t;
typedef float f32x4 __attribute__((ext_vector_type(4)));
typedef unsigned u32x2 __attribute__((ext_vector_type(2)));
typedef unsigned u32x4 __attribute__((ext_vector_type(4)));
#define LAS __attribute__((address_space(3)))

constexpr int SEQ = 8192, DM = 2048, INW = 6400, QW = 1024, SSMW = 1024, DFF = 8192;
constexpr int NG = 64, GC = 16, SP = 64, NH = 16;
constexpr size_t MiB = 1u << 20;
constexpr size_t WS_AP = 0, WS_BBAR = 1 * MiB, WS_ROPE = 1 * MiB + 512 * 1024, WS_PART1 = 2 * MiB, WS_PART2 = 3 * MiB;
constexpr size_t WS_WUP = 4 * MiB, WS_WDN = 36 * MiB, WS_WIN = 68 * MiB, WS_WGLU = 93 * MiB, WS_WBRA = 97 * MiB, WS_WBRS = 101 * MiB, WS_WOUT = 105 * MiB;
constexpr size_t WS_H = 113 * MiB, WS_OATT = 113 * MiB, WS_Q = 145 * MiB, WS_OSSM = 145 * MiB, WS_K = 161 * MiB, WS_VT = 163 * MiB, WS_AX = 165 * MiB, WS_Y = 189 * MiB;
constexpr size_t WS_M = 161 * MiB, WS_GA = 205 * MiB, WS_GS = 237 * MiB, WS_MIXED = 205 * MiB, WS_H2 = 68 * MiB, WS_A = 141 * MiB, WS_DN = 68 * MiB, WS_END = 269 * MiB;
constexpr size_t DO_S = 0, DO_KTAB = 16 * MiB, DO_BC = 17 * MiB, DO_YB = 25 * MiB;
constexpr int NAP = 18;

struct P {
    const float* in[20];
    float* out;
    unsigned char* ws;
};

__device__ __forceinline__ float bf2f(unsigned v) { return __uint_as_float(v << 16); }
__device__ __forceinline__ unsigned f2bf(float f) { unsigned u = __float_as_uint(f); return (u + 0x7fffu + ((u >> 16) & 1u)) >> 16; }
__device__ __forceinline__ unsigned pk2(float lo, float hi) { return f2bf(lo) | (f2bf(hi) << 16); }
__device__ __forceinline__ float wave_sum(float v) {
#pragma unroll
    for (int o = 1; o < 64; o <<= 1) v += __shfl_xor(v, o);
    return v;
}
__device__ __forceinline__ float wave_max(float v) {
#pragma unroll
    for (int o = 1; o < 64; o <<= 1) v = fmaxf(v, __shfl_xor(v, o));
    return v;
}
__device__ __forceinline__ float sigmoidf_(float v) { return 1.0f / (1.0f + __expf(-v)); }
__device__ __forceinline__ float gelu_tanh(float v) {
    const float z = 0.7978845608028654f * (v + 0.044715f * v * v * v);
    const float t = 1.0f - 2.0f / (__expf(2.0f * z) + 1.0f);
    return 0.5f * v * (1.0f + t);
}
__device__ __forceinline__ void sincos_d(double ang, float& s, float& c) {
    double rev = ang * 0.15915494309189535; rev -= rint(rev);
    const double q4 = rev * 4.0, qr = rint(q4); const int q = ((int)qr) & 3;
    const double th = (q4 - qr) * 1.5707963267948966, t2 = th * th;
    const double sn = th * (1.0 + t2 * (-1.0 / 6 + t2 * (1.0 / 120 + t2 * (-1.0 / 5040 + t2 * (1.0 / 362880 + t2 * (-1.0 / 39916800 + t2 * (1.0 / 6227020800.0)))))));
    const double cs = 1.0 + t2 * (-0.5 + t2 * (1.0 / 24 + t2 * (-1.0 / 720 + t2 * (1.0 / 40320 + t2 * (-1.0 / 3628800 + t2 * (1.0 / 479001600.0 + t2 * (-1.0 / 87178291200.0)))))));
    const double so = (q == 0) ? sn : (q == 1) ? cs : (q == 2) ? -sn : -cs;
    const double co = (q == 0) ? cs : (q == 1) ? -sn : (q == 2) ? -cs : sn;
    s = (float)so; c = (float)co;
}

__device__ __forceinline__ void transpose_item(const float* W, int N, bf16_t* WT, int ldk, int k0, int n0, int drow0, LAS float* scr, int lane) {
#pragma unroll 8
    for (int i = 0; i < 32; ++i) { const int kk = 2 * i + (lane >> 5); scr[kk * 33 + (lane & 31)] = W[(size_t)(k0 + kk) * N + n0 + (lane & 31)]; }
    asm volatile("s_waitcnt lgkmcnt(0)" ::: "memory");
    const int c = lane & 7;
#pragma unroll
    for (int j = 0; j < 4; ++j) { const int n = (lane >> 3) + 8 * j; const LAS float* s = scr + (8 * c) * 33 + n;
        u32x4 o; o.x = pk2(s[0 * 33], s[1 * 33]); o.y = pk2(s[2 * 33], s[3 * 33]); o.z = pk2(s[4 * 33], s[5 * 33]); o.w = pk2(s[6 * 33], s[7 * 33]);
        *(u32x4*)(WT + (size_t)(drow0 + n) * ldk + k0 + 8 * c) = o; }
    asm volatile("s_waitcnt lgkmcnt(0)" ::: "memory");
}
__device__ __forceinline__ void rms_row_bf16(const float* xrow, const float* gain, bf16_t* orow, int lane) {
    f32x4 v[8]; float s = 0.f;
#pragma unroll
    for (int j = 0; j < 8; ++j) { v[j] = ((const f32x4*)xrow)[64 * j + lane]; s += v[j].x * v[j].x + v[j].y * v[j].y + v[j].z * v[j].z + v[j].w * v[j].w; }
    const float r = rsqrtf(wave_sum(s) * (1.0f / DM) + 1e-6f);
#pragma unroll
    for (int j = 0; j < 8; ++j) { const f32x4 g = ((const f32x4*)gain)[64 * j + lane]; const f32x4 o = v[j] * r * g;
        u32x2 w; w.x = pk2(o.x, o.y); w.y = pk2(o.z, o.w); ((u32x2*)orow)[64 * j + lane] = w; }
}

struct GemmDesc { const bf16_t* A; const bf16_t* Bt; int M, N, K, lda, ldb, batch; size_t strideA, strideB; };

template <class Epi>
__device__ __forceinline__ void naive_gemm(LAS float* lds, const GemmDesc g, const Epi& E) {
    LAS float* As = lds;
    LAS float* Bs = lds + 16 * 132;
    const int tid = threadIdx.x, tx = tid & 31, ty = tid >> 5;
    const int tm = g.M / 128, tn = g.N / 128, ntile = tm * tn * g.batch;
    const int lr = tid >> 2, lk = (tid & 3) * 4;
    for (int tile = blockIdx.x; tile < ntile; tile += gridDim.x) {
        const int b = tile / (tm * tn), r = tile % (tm * tn), pm = r / tn, pn = r % tn;
        const bf16_t* A = g.A + (size_t)b * g.strideA + (size_t)(pm * 128 + lr) * g.lda + lk;
        const bf16_t* B = g.Bt + (size_t)b * g.strideB + (size_t)(pn * 128 + lr) * g.ldb + lk;
        float acc[8][4];
#pragma unroll
        for (int i = 0; i < 8; ++i)
#pragma unroll
            for (int j = 0; j < 4; ++j) acc[i][j] = 0.f;
        for (int k0 = 0; k0 < g.K; k0 += 16) {
            const u32x2 av = *(const u32x2*)(A + k0);
            const u32x2 bv = *(const u32x2*)(B + k0);
            __syncthreads();
            As[(lk + 0) * 132 + lr] = bf2f(av.x & 0xffffu); As[(lk + 1) * 132 + lr] = bf2f(av.x >> 16);
            As[(lk + 2) * 132 + lr] = bf2f(av.y & 0xffffu); As[(lk + 3) * 132 + lr] = bf2f(av.y >> 16);
            Bs[(lk + 0) * 132 + lr] = bf2f(bv.x & 0xffffu); Bs[(lk + 1) * 132 + lr] = bf2f(bv.x >> 16);
            Bs[(lk + 2) * 132 + lr] = bf2f(bv.y & 0xffffu); Bs[(lk + 3) * 132 + lr] = bf2f(bv.y >> 16);
            __syncthreads();
#pragma unroll
            for (int kk = 0; kk < 16; ++kk) {
                float a[8], bb[4];
#pragma unroll
                for (int i = 0; i < 8; ++i) a[i] = As[kk * 132 + ty * 8 + i];
#pragma unroll
                for (int j = 0; j < 4; ++j) bb[j] = Bs[kk * 132 + tx * 4 + j];
#pragma unroll
                for (int i = 0; i < 8; ++i)
#pragma unroll
                    for (int j = 0; j < 4; ++j) acc[i][j] += a[i] * bb[j];
            }
        }
#pragma unroll
        for (int i = 0; i < 8; ++i)
#pragma unroll
            for (int j = 0; j < 4; ++j) E(b, pm * 128 + ty * 8 + i, pn * 128 + tx * 4 + j, acc[i][j]);
        __syncthreads();
    }
}

struct EpiZ {
    bf16_t *q, *k, *vT, *ax, *ga, *gs;
    __device__ __forceinline__ void operator()(int, int row, int col, float v) const {
        if (col < 1024) q[(size_t)row * 1024 + col] = (bf16_t)f2bf(v);
        else if (col < 1152) k[(size_t)row * 128 + (col - 1024)] = (bf16_t)f2bf(v);
        else if (col < 1280) { const int c = col - 1152; vT[(size_t)c * SEQ + row] = (bf16_t)f2bf(v); }
        else if (col < 2304) { const int c = col - 1280, g = c >> 4, ci = c & 15; ax[((size_t)g * 512 + (row >> 4)) * 384 + (row & 15) * 16 + ci] = (bf16_t)f2bf(v); }
        else if (col < 4352) ga[(size_t)row * 2048 + (col - 2304)] = (bf16_t)f2bf(sigmoidf_(v));
        else gs[(size_t)row * 2048 + (col - 4352)] = (bf16_t)f2bf(sigmoidf_(v));
    }
};
struct EpiS { float* S; __device__ __forceinline__ void operator()(int g, int row, int col, float v) const { if (col < 128) S[((size_t)g * 512 + row) * 128 + col] = v; } };
struct EpiY { bf16_t* y; __device__ __forceinline__ void operator()(int g, int row, int col, float v) const {
    const int t = col >> 4, co = col & 15; y[(size_t)(row * 16 + t) * 1024 + g * 16 + co] = (bf16_t)f2bf(gelu_tanh(v)); } };
struct EpiF32 { float* o; int ld; __device__ __forceinline__ void operator()(int, int row, int col, float v) const { o[(size_t)row * ld + col] = v; } };
struct EpiT1 { float* t1; const bf16_t* ga; __device__ __forceinline__ void operator()(int, int row, int col, float v) const {
    const size_t i = (size_t)row * 2048 + col; t1[i] = bf2f(ga[i]) * v; } };
struct EpiM { const float* t1; const bf16_t* gs; bf16_t* m; __device__ __forceinline__ void operator()(int, int row, int col, float v) const {
    const size_t i = (size_t)row * 2048 + col; m[i] = (bf16_t)f2bf(t1[i] + bf2f(gs[i]) * v); } };
struct EpiUp { bf16_t* a; __device__ __forceinline__ void operator()(int, int row, int col, float v) const {
    const float r = fmaxf(v, 0.f); a[(size_t)row * DFF + col] = (bf16_t)f2bf(r * r); } };

constexpr int NPHASE = 18;

template <int PH>
__device__ __forceinline__ void run_phase(const P& p, LAS unsigned char* lds) {
    const int tid = threadIdx.x, lane = tid & 63, wave = tid >> 6;
    const int G = gridDim.x, gw = blockIdx.x * 8 + wave, NGW = G * 8;
    const size_t gt = (size_t)blockIdx.x * 512 + tid, NGT = (size_t)G * 512;
    unsigned char* ws = p.ws; unsigned char* dout = (unsigned char*)p.out;
    float2* AP = (float2*)(ws + WS_AP); float2* BBAR = (float2*)(ws + WS_BBAR); float2* ROPE = (float2*)(ws + WS_ROPE);
    bf16_t* WUP = (bf16_t*)(ws + WS_WUP); bf16_t* WDN = (bf16_t*)(ws + WS_WDN); bf16_t* WIN = (bf16_t*)(ws + WS_WIN); bf16_t* WGLU = (bf16_t*)(ws + WS_WGLU);
    bf16_t* WBRA = (bf16_t*)(ws + WS_WBRA); bf16_t* WBRS = (bf16_t*)(ws + WS_WBRS); bf16_t* WOUT = (bf16_t*)(ws + WS_WOUT);
    bf16_t* H = (bf16_t*)(ws + WS_H); bf16_t* OATT = (bf16_t*)(ws + WS_OATT); bf16_t* Q = (bf16_t*)(ws + WS_Q); bf16_t* OSSM = (bf16_t*)(ws + WS_OSSM);
    bf16_t* Kb = (bf16_t*)(ws + WS_K); bf16_t* VT = (bf16_t*)(ws + WS_VT); bf16_t* AX = (bf16_t*)(ws + WS_AX); bf16_t* Y = (bf16_t*)(ws + WS_Y);
    bf16_t* Mb = (bf16_t*)(ws + WS_M); bf16_t* GA = (bf16_t*)(ws + WS_GA); bf16_t* GS = (bf16_t*)(ws + WS_GS); float* MIXED = (float*)(ws + WS_MIXED);
    bf16_t* H2 = (bf16_t*)(ws + WS_H2); bf16_t* Ab = (bf16_t*)(ws + WS_A); float* DN = (float*)(ws + WS_DN);
    float* S = (float*)(dout + DO_S); float* KTAB = (float*)(dout + DO_KTAB); bf16_t* BC = (bf16_t*)(dout + DO_BC); bf16_t* YB = (bf16_t*)(dout + DO_YB);
    float* T1 = p.out; float* ZG = p.out; float* X1 = p.out;
    const float* x = p.in[0];

    if constexpr (PH == 0) {
        LAS float* scr = (LAS float*)(lds + wave * 16384);
        constexpr int I_IN = 32 * 200, I_GLU = 16 * 64, I_BR = 16 * 64, I_OUT = 32 * 64, I_UP = 32 * 256, I_DN = 128 * 64;
        constexpr int NIT = I_IN + I_GLU + 2 * I_BR + I_OUT + I_UP + I_DN;
        for (int it = gw; it < NIT; it += NGW) {
            int r = it;
            if (r < I_IN) { const int nb = r % 200, kb = r / 200; transpose_item(p.in[5], INW, WIN, 2048, 64 * kb, 32 * nb, 32 * nb, scr, lane); continue; } r -= I_IN;
            if (r < I_GLU) { const int nb = r % 64, kb = r / 64, n0 = 32 * nb, bj = n0 >> 10, j = n0 & 1023, t = j >> 7, jj = j & 127;
                transpose_item(p.in[15], 2048, WGLU, 1024, 64 * kb, n0, 256 * t + 128 * bj + jj, scr, lane); continue; } r -= I_GLU;
            if (r < I_BR) { const int nb = r % 64, kb = r / 64; transpose_item(p.in[16], 2048, WBRA, 1024, 64 * kb, 32 * nb, 32 * nb, scr, lane); continue; } r -= I_BR;
            if (r < I_BR) { const int nb = r % 64, kb = r / 64; transpose_item(p.in[16] + (size_t)1024 * 2048, 2048, WBRS, 1024, 64 * kb, 32 * nb, 32 * nb, scr, lane); continue; } r -= I_BR;
            if (r < I_OUT) { const int nb = r % 64, kb = r / 64; transpose_item(p.in[17], 2048, WOUT, 2048, 64 * kb, 32 * nb, 32 * nb, scr, lane); continue; } r -= I_OUT;
            if (r < I_UP) { const int nb = r % 256, kb = r / 256; transpose_item(p.in[18], DFF, WUP, 2048, 64 * kb, 32 * nb, 32 * nb, scr, lane); continue; } r -= I_UP;
            { const int nb = r % 64, kb = r / 64; transpose_item(p.in[19], 2048, WDN, DFF, 64 * kb, 32 * nb, 32 * nb, scr, lane); }
        }
        for (int m = gw; m < SEQ; m += NGW) rms_row_bf16(x + (size_t)m * DM, p.in[1], H + (size_t)m * DM, lane);
        for (size_t i = gt; i < (size_t)NG * SP; i += NGT) {
            const int g = (int)i / SP;
            const double dt = exp((double)p.in[9][g]), lr = (double)p.in[7][i], li = (double)p.in[8][i];
            for (int n = 0; n < NAP; ++n) {
                const double pw = (n == 17) ? 1024.0 : (double)n;
                const float mag = (float)exp(pw * lr * dt); float s, c; sincos_d(pw * li * dt, s, c);
                AP[i * NAP + n] = make_float2(mag * c, mag * s);
            }
            float s1, c1; sincos_d(li * dt, s1, c1);
            const double mag1 = exp(lr * dt), are = mag1 * (double)c1, aim = mag1 * (double)s1;
            const double nr = are - 1.0, ni = aim, den = lr * lr + li * li;
            const double cre = (nr * lr + ni * li) / den, cim = (ni * lr - nr * li) / den;
            for (int c = 0; c < GC; ++c) {
                const double br = (double)p.in[10][i * GC + c], bi = (double)p.in[11][i * GC + c];
                BBAR[i * GC + c] = make_float2((float)(cre * br - cim * bi), (float)(cre * bi + cim * br));
            }
        }
        for (size_t i = gt; i < (size_t)SEQ * 8; i += NGT) {
            const int pos = (int)(i >> 3), k = (int)(i & 7);
            const double inv = exp(-(double)k * 0.125 * 13.122363377404328);
            float s, c; sincos_d((double)pos * inv, s, c);
            ROPE[i] = make_float2(c, s);
        }
    }
    if constexpr (PH == 1) {
        for (size_t i = gt; i < (size_t)NG * 256 * 256; i += NGT) {
            const int g = (int)(i >> 16), r = (int)(i >> 8) & 255, k = (int)i & 255, s = k >> 4, ci = k & 15;
            float v = 0.f;
            if (r < 128) { const int pp = r & 63; const float2 a = AP[((size_t)g * SP + pp) * NAP + (15 - s)], b = BBAR[((size_t)g * SP + pp) * GC + ci];
                v = (r >> 6) ? (a.x * b.y + a.y * b.x) : (a.x * b.x - a.y * b.y); }
            BC[i] = (bf16_t)f2bf(v);
        }
        for (size_t i = gt; i < (size_t)NG * 256 * 128; i += NGT) {
            const int g = (int)(i >> 15), row = (int)(i >> 7) & 255, r = (int)i & 127, t = row >> 4, co = row & 15, pp = r & 63;
            const float2 a = AP[((size_t)g * SP + pp) * NAP + (t + 1)];
            const float cr = p.in[12][((size_t)g * GC + co) * SP + pp], cim = p.in[13][((size_t)g * GC + co) * SP + pp];
            const float wre = cr * a.x - cim * a.y, wim = cr * a.y + cim * a.x;
            YB[((size_t)g * 256 + row) * 384 + 256 + r] = (bf16_t)f2bf((r >> 6) ? -wim : wre);
        }
        for (size_t i = gt; i < (size_t)NG * 16 * 256; i += NGT) {
            const int g = (int)(i >> 12), tau = (int)(i >> 8) & 15, co = (int)(i >> 4) & 15, ci = (int)i & 15;
            float acc = 0.f;
            for (int pp = 0; pp < SP; ++pp) {
                const float2 a = AP[((size_t)g * SP + pp) * NAP + tau], b = BBAR[((size_t)g * SP + pp) * GC + ci];
                const float cr = p.in[12][((size_t)g * GC + co) * SP + pp], cim = p.in[13][((size_t)g * GC + co) * SP + pp];
                const float wre = cr * a.x - cim * a.y, wim = cr * a.y + cim * a.x;
                acc += wre * b.x - wim * b.y;
            }
            if (tau == 0 && co == ci) acc += p.in[14][g * GC + co];
            KTAB[i] = acc;
        }
    }
    if constexpr (PH == 2) {
        for (size_t i = gt; i < (size_t)NG * 256 * 256; i += NGT) {
            const int g = (int)(i >> 16), row = (int)(i >> 8) & 255, k = (int)i & 255, t = row >> 4, co = row & 15, s = k >> 4, ci = k & 15;
            const float v = (t >= s) ? KTAB[(((size_t)g * 16 + (t - s)) * 16 + co) * 16 + ci] : 0.f;
            YB[((size_t)g * 256 + row) * 384 + k] = (bf16_t)f2bf(v);
        }
    }
    if constexpr (PH == 3) { GemmDesc g{H, WIN, SEQ, INW, DM, DM, DM, 1, 0, 0}; EpiZ E{Q, Kb, VT, AX, GA, GS}; naive_gemm((LAS float*)lds, g, E); }
    if constexpr (PH == 4) {
        for (size_t i = gt; i < (size_t)SEQ * 18 * 8; i += NGT) {
            const int k = (int)(i & 7), hs = (int)((i >> 3) % 18), pos = (int)((i >> 3) / 18);
            bf16_t* base = (hs < 16) ? (Q + (size_t)pos * 1024 + hs * 64) : (Kb + (size_t)pos * 128 + (hs - 16) * 64);
            const float2 cs = ROPE[(size_t)pos * 8 + k];
            const float x1 = bf2f(base[k]), x2 = bf2f(base[8 + k]);
            base[k] = (bf16_t)f2bf(x1 * cs.x - x2 * cs.y); base[8 + k] = (bf16_t)f2bf(x2 * cs.x + x1 * cs.y);
        }
    }
    if constexpr (PH == 5) {
        LAS float* pw = (LAS float*)(lds + wave * 1024);
        for (int item = gw; item < SEQ * NH; item += NGW) {
            const int token = item >> 4, h = item & 15, hk = h >> 3;
            float sc[2];
#pragma unroll
            for (int j = 0; j < 2; ++j) {
                const int kpos = token - 127 + lane + 64 * j;
                float s = -1e30f;
                if (kpos >= 0) { float a = 0.f; const bf16_t* qp = Q + (size_t)token * 1024 + h * 64; const bf16_t* kp = Kb + (size_t)kpos * 128 + hk * 64;
                    for (int d = 0; d < 64; ++d) a += bf2f(qp[d]) * bf2f(kp[d]);
                    s = a * 0.125f; }
                sc[j] = s;
            }
            const float sink = p.in[6][h];
            const float mx = fmaxf(wave_max(fmaxf(sc[0], sc[1])), sink);
            const float p0 = (sc[0] > -1e29f) ? __expf(sc[0] - mx) : 0.f, p1 = (sc[1] > -1e29f) ? __expf(sc[1] - mx) : 0.f;
            const float den = wave_sum(p0 + p1) + __expf(sink - mx);
            pw[lane] = p0; pw[lane + 64] = p1;
            asm volatile("s_waitcnt lgkmcnt(0)" ::: "memory");
            float o = 0.f; const bf16_t* vp = VT + (size_t)(hk * 64 + lane) * SEQ;
            for (int i = 0; i < 128; ++i) { const int kpos = token - 127 + i; if (kpos >= 0) o += pw[i] * bf2f(vp[kpos]); }
            OATT[(size_t)token * 1024 + h * 64 + lane] = (bf16_t)f2bf(o / den);
            asm volatile("s_waitcnt lgkmcnt(0)" ::: "memory");
        }
    }
    if constexpr (PH == 6) { GemmDesc g{AX, BC, 512, 256, 256, 384, 256, NG, (size_t)512 * 384, (size_t)256 * 256}; EpiS E{S}; naive_gemm((LAS float*)lds, g, E); }
    if constexpr (PH == 7) {
        LAS float* Elr = (LAS float*)lds; LAS float* Eli = Elr + 512;
        for (int g = blockIdx.x; g < NG; g += G) {
            const int pp = tid & 63, seg = tid >> 6;
            const float2 A16 = AP[((size_t)g * SP + pp) * NAP + 16], A1k = AP[((size_t)g * SP + pp) * NAP + 17];
            const float* Sg = S + (size_t)g * 512 * 128;
            float lre = 0.f, lim = 0.f;
            for (int j = seg * 64; j < seg * 64 + 64; ++j) { const float sr = Sg[j * 128 + pp], si = Sg[j * 128 + 64 + pp];
                const float nr = A16.x * lre - A16.y * lim + sr, ni = A16.x * lim + A16.y * lre + si; lre = nr; lim = ni; }
            __syncthreads();
            Elr[seg * 64 + pp] = lre; Eli[seg * 64 + pp] = lim;
            __syncthreads();
            float cre = 0.f, cim = 0.f;
            for (int s2 = 0; s2 < seg; ++s2) { const float2 e = make_float2(Elr[s2 * 64 + pp], Eli[s2 * 64 + pp]);
                const float nr = A1k.x * cre - A1k.y * cim + e.x, ni = A1k.x * cim + A1k.y * cre + e.y; cre = nr; cim = ni; }
            for (int j = seg * 64; j < seg * 64 + 64; ++j) {
                bf16_t* axr = AX + ((size_t)g * 512 + j) * 384 + 256;
                axr[pp] = (bf16_t)f2bf(cre); axr[64 + pp] = (bf16_t)f2bf(cim);
                const float sr = Sg[j * 128 + pp], si = Sg[j * 128 + 64 + pp];
                const float nr = A16.x * cre - A16.y * cim + sr, ni = A16.x * cim + A16.y * cre + si; cre = nr; cim = ni; }
        }
    }
    if constexpr (PH == 8) { GemmDesc g{AX, YB, 512, 256, 384, 384, 384, NG, (size_t)512 * 384, (size_t)256 * 384}; EpiY E{Y}; naive_gemm((LAS float*)lds, g, E); }
    if constexpr (PH == 9) { GemmDesc g{Y, WGLU, SEQ, 2048, 1024, 1024, 1024, 1, 0, 0}; EpiF32 E{ZG, 2048}; naive_gemm((LAS float*)lds, g, E); }
    if constexpr (PH == 10) {
        for (size_t i = gt; i < (size_t)SEQ * 1024; i += NGT) {
            const int row = (int)(i >> 10), j = (int)i & 1023, t = j >> 7, jj = j & 127;
            const float a = ZG[(size_t)row * 2048 + 256 * t + jj], b = ZG[(size_t)row * 2048 + 256 * t + 128 + jj];
            OSSM[i] = (bf16_t)f2bf(a * sigmoidf_(b));
        }
    }
    if constexpr (PH == 11) { GemmDesc g{OATT, WBRA, SEQ, 2048, 1024, 1024, 1024, 1, 0, 0}; EpiT1 E{T1, GA}; naive_gemm((LAS float*)lds, g, E); }
    if constexpr (PH == 12) { GemmDesc g{OSSM, WBRS, SEQ, 2048, 1024, 1024, 1024, 1, 0, 0}; EpiM E{T1, GS, Mb}; naive_gemm((LAS float*)lds, g, E); }
    if constexpr (PH == 13) { GemmDesc g{Mb, WOUT, SEQ, 2048, 2048, 2048, 2048, 1, 0, 0}; EpiF32 E{MIXED, 2048}; naive_gemm((LAS float*)lds, g, E); }
    if constexpr (PH == 14) {
        for (int m = gw; m < SEQ; m += NGW) {
            const f32x4* mr = (const f32x4*)(MIXED + (size_t)m * DM); const f32x4* xr = (const f32x4*)(x + (size_t)m * DM);
            f32x4 v[8]; float s = 0.f;
#pragma unroll
            for (int j = 0; j < 8; ++j) { v[j] = mr[64 * j + lane]; s += v[j].x * v[j].x + v[j].y * v[j].y + v[j].z * v[j].z + v[j].w * v[j].w; }
            const float r = rsqrtf(wave_sum(s) * (1.0f / DM) + 1e-6f); float s2 = 0.f;
#pragma unroll
            for (int j = 0; j < 8; ++j) { const f32x4 g = ((const f32x4*)p.in[2])[64 * j + lane]; v[j] = xr[64 * j + lane] + v[j] * r * g;
                ((f32x4*)(X1 + (size_t)m * DM))[64 * j + lane] = v[j]; s2 += v[j].x * v[j].x + v[j].y * v[j].y + v[j].z * v[j].z + v[j].w * v[j].w; }
            const float r2 = rsqrtf(wave_sum(s2) * (1.0f / DM) + 1e-6f);
#pragma unroll
            for (int j = 0; j < 8; ++j) { const f32x4 g = ((const f32x4*)p.in[3])[64 * j + lane]; const f32x4 o = v[j] * r2 * g;
                u32x2 w; w.x = pk2(o.x, o.y); w.y = pk2(o.z, o.w); ((u32x2*)(H2 + (size_t)m * DM))[64 * j + lane] = w; }
        }
    }
    if constexpr (PH == 15) { GemmDesc g{H2, WUP, SEQ, DFF, DM, DM, DM, 1, 0, 0}; EpiUp E{Ab}; naive_gemm((LAS float*)lds, g, E); }
    if constexpr (PH == 16) { GemmDesc g{Ab, WDN, SEQ, DM, DFF, DFF, DFF, 1, 0, 0}; EpiF32 E{DN, 2048}; naive_gemm((LAS float*)lds, g, E); }
    if constexpr (PH == 17) {
        for (int m = gw; m < SEQ; m += NGW) {
            const f32x4* dr = (const f32x4*)(DN + (size_t)m * DM); f32x4* xr = (f32x4*)(X1 + (size_t)m * DM);
            f32x4 v[8]; float s = 0.f;
#pragma unroll
            for (int j = 0; j < 8; ++j) { v[j] = dr[64 * j + lane]; s += v[j].x * v[j].x + v[j].y * v[j].y + v[j].z * v[j].z + v[j].w * v[j].w; }
            const float r = rsqrtf(wave_sum(s) * (1.0f / DM) + 1e-6f);
#pragma unroll
            for (int j = 0; j < 8; ++j) { const f32x4 g = ((const f32x4*)p.in[4])[64 * j + lane]; xr[64 * j + lane] = xr[64 * j + lane] + v[j] * r * g; }
        }
    }
}

constexpr int LDS_BYTES = 147456;

template <int PH>
__global__ void __launch_bounds__(512, 2) k_phase(P p) {
    extern __shared__ __attribute__((aligned(16))) unsigned char lds_raw[];
    run_phase<PH>(p, (LAS unsigned char*)lds_raw);
}
#if COOP
template <int PH>
__device__ __forceinline__ void run_all(const P& p, LAS unsigned char* lds, cg::grid_group& grid) {
    run_phase<PH>(p, lds);
    if constexpr (PH + 1 < NPHASE) { grid.sync(); run_all<PH + 1>(p, lds, grid); }
}
__global__ void __launch_bounds__(512, 2) k_all(P p) {
    extern __shared__ __attribute__((aligned(16))) unsigned char lds_raw[];
    cg::grid_group grid = cg::this_grid();
    run_all<0>(p, (LAS unsigned char*)lds_raw, grid);
}
#endif
template <int PH>
static void launch_phases(const P& p, int grid, hipStream_t stream) {
    hipLaunchKernelGGL(k_phase<PH>, dim3(grid), dim3(512), LDS_BYTES, stream, p);
    if constexpr (PH + 1 < NPHASE) launch_phases<PH + 1>(p, grid, stream);
}
template <int PH>
static void set_attr() {
    (void)hipFuncSetAttribute((const void*)k_phase<PH>, hipFuncAttributeMaxDynamicSharedMemorySize, LDS_BYTES);
    if constexpr (PH + 1 < NPHASE) set_attr<PH + 1>();
}

extern "C" void kernel_launch(void* const* d_in, const int* in_sizes, int n_in, void* d_out, int out_size, void* d_ws, size_t ws_size, hipStream_t stream) {
    static int grid = 0;
    if (grid == 0) {
        if (n_in != 20 || out_size != SEQ * DM || ws_size < WS_END) { fprintf(stderr, "kernel_launch: unexpected shapes (n_in %d out %d ws %zu)\n", n_in, out_size, ws_size); grid = -1; return; }
        int dev = 0, cus = 0;
        (void)hipGetDevice(&dev); (void)hipDeviceGetAttribute(&cus, hipDeviceAttributeMultiprocessorCount, dev);
        set_attr<0>();
#if COOP
        (void)hipFuncSetAttribute((const void*)k_all, hipFuncAttributeMaxDynamicSharedMemorySize, LDS_BYTES);
        int per_cu = 0;
        (void)hipOccupancyMaxActiveBlocksPerMultiprocessor(&per_cu, (const void*)k_all, 512, LDS_BYTES);
        if (per_cu < 1) { fprintf(stderr, "kernel_launch: occupancy query says %d blocks/CU\n", per_cu); per_cu = 1; }
#endif
        (void)hipGetLastError();
        grid = cus;
    }
    if (grid < 0) return;
    P p{};
    for (int i = 0; i < 20; ++i) p.in[i] = (const float*)d_in[i];
    p.out = (float*)d_out; p.ws = (unsigned char*)d_ws;
#if COOP
    void* args[] = {&p};
    hipError_t e = hipLaunchCooperativeKernel((const void*)k_all, dim3(grid), dim3(512), args, LDS_BYTES, stream);
    if (e != hipSuccess) fprintf(stderr, "cooperative launch failed: %s (grid %d)\n", hipGetErrorString(e), grid);
#else
    launch_phases<0>(p, grid, stream);
#endif
}
```

```cpp
#include <hip/hip_runtime.h>
#include <hip/hip_cooperative_groups.h>
#include <cstdio>
#include <cstdint>
namespace cg = cooperative_groups;

#ifndef COOP
#define COOP 1
#endif

typedef unsigned short bf16_t;
typedef float f32x4 __attribute__((ext_vector_type(4)));
typedef unsigned u32x2 __attribute__((ext_vector_type(2)));
typedef unsigned u32x4 __attribute__((ext_vector_type(4)));
#define LAS __attribute__((address_space(3)))

constexpr int SEQ = 8192, DM = 2048, INW = 6400, QW = 1024, SSMW = 1024, DFF = 8192;
constexpr int NG = 64, GC = 16, SP = 64, NH = 16;
constexpr size_t MiB = 1u << 20;
constexpr size_t WS_AP = 0, WS_BBAR = 1 * MiB, WS_ROPE = 1 * MiB + 512 * 1024, WS_PART1 = 2 * MiB, WS_PART2 = 3 * MiB;
constexpr size_t WS_WUP = 4 * MiB, WS_WDN = 36 * MiB, WS_WIN = 68 * MiB, WS_WGLU = 93 * MiB, WS_WBRA = 97 * MiB, WS_WBRS = 101 * MiB, WS_WOUT = 105 * MiB;
constexpr size_t WS_H = 113 * MiB, WS_OATT = 113 * MiB, WS_Q = 145 * MiB, WS_OSSM = 145 * MiB, WS_K = 161 * MiB, WS_VT = 163 * MiB, WS_AX = 165 * MiB, WS_Y = 189 * MiB;
constexpr size_t WS_M = 161 * MiB, WS_GA = 205 * MiB, WS_GS = 237 * MiB, WS_MIXED = 205 * MiB, WS_H2 = 68 * MiB, WS_A = 141 * MiB, WS_DN = 68 * MiB, WS_END = 269 * MiB;
constexpr size_t DO_S = 0, DO_KTAB = 16 * MiB, DO_BC = 17 * MiB, DO_YB = 25 * MiB;
constexpr int NAP = 18;

struct P {
    const float* in[20];
    float* out;
    unsigned char* ws;
};

__device__ __forceinline__ float bf2f(unsigned v) { return __uint_as_float(v << 16); }
__device__ __forceinline__ unsigned f2bf(float f) { unsigned u = __float_as_uint(f); return (u + 0x7fffu + ((u >> 16) & 1u)) >> 16; }
__device__ __forceinline__ unsigned pk2(float lo, float hi) { return f2bf(lo) | (f2bf(hi) << 16); }
__device__ __forceinline__ float wave_sum(float v) {
#pragma unroll
    for (int o = 1; o < 64; o <<= 1) v += __shfl_xor(v, o);
    return v;
}
__device__ __forceinline__ float wave_max(float v) {
#pragma unroll
    for (int o = 1; o < 64; o <<= 1) v = fmaxf(v, __shfl_xor(v, o));
    return v;
}
__device__ __forceinline__ float sigmoidf_(float v) { return __builtin_amdgcn_rcpf(1.0f + __expf(-v)); }
__device__ __forceinline__ float gelu_tanh(float v) {
    const float z2 = 1.5957691216057308f * (v + 0.044715f * v * v * v);
    return v * __builtin_amdgcn_rcpf(1.0f + __expf(-z2));
}
__device__ __forceinline__ void sincos_d(double ang, float& s, float& c) {
    double rev = ang * 0.15915494309189535; rev -= rint(rev);
    const double q4 = rev * 4.0, qr = rint(q4); const int q = ((int)qr) & 3;
    const double th = (q4 - qr) * 1.5707963267948966, t2 = th * th;
    const double sn = th * (1.0 + t2 * (-1.0 / 6 + t2 * (1.0 / 120 + t2 * (-1.0 / 5040 + t2 * (1.0 / 362880 + t2 * (-1.0 / 39916800 + t2 * (1.0 / 6227020800.0)))))));
    const double cs = 1.0 + t2 * (-0.5 + t2 * (1.0 / 24 + t2 * (-1.0 / 720 + t2 * (1.0 / 40320 + t2 * (-1.0 / 3628800 + t2 * (1.0 / 479001600.0 + t2 * (-1.0 / 87178291200.0)))))));
    const double so = (q == 0) ? sn : (q == 1) ? cs : (q == 2) ? -sn : -cs;
    const double co = (q == 0) ? cs : (q == 1) ? -sn : (q == 2) ? -cs : sn;
    s = (float)so; c = (float)co;
}

__device__ __forceinline__ void transpose_item(const float* W, int N, bf16_t* WT, int ldk, int k0, int n0, int drow0, LAS float* scr, int lane) {
#pragma unroll 8
    for (int i = 0; i < 32; ++i) { const int kk = 2 * i + (lane >> 5); scr[kk * 33 + (lane & 31)] = W[(size_t)(k0 + kk) * N + n0 + (lane & 31)]; }
    asm volatile("s_waitcnt lgkmcnt(0)" ::: "memory");
    const int c = lane & 7;
#pragma unroll
    for (int j = 0; j < 4; ++j) { const int n = (lane >> 3) + 8 * j; const LAS float* s = scr + (8 * c) * 33 + n;
        u32x4 o; o.x = pk2(s[0 * 33], s[1 * 33]); o.y = pk2(s[2 * 33], s[3 * 33]); o.z = pk2(s[4 * 33], s[5 * 33]); o.w = pk2(s[6 * 33], s[7 * 33]);
        *(u32x4*)(WT + (size_t)(drow0 + n) * ldk + k0 + 8 * c) = o; }
    asm volatile("s_waitcnt lgkmcnt(0)" ::: "memory");
}
__device__ __forceinline__ void rms_row_bf16(const float* xrow, const float* gain, bf16_t* orow, int lane) {
    f32x4 v[8]; float s = 0.f;
#pragma unroll
    for (int j = 0; j < 8; ++j) { v[j] = ((const f32x4*)xrow)[64 * j + lane]; s += v[j].x * v[j].x + v[j].y * v[j].y + v[j].z * v[j].z + v[j].w * v[j].w; }
    const float r = rsqrtf(wave_sum(s) * (1.0f / DM) + 1e-6f);
#pragma unroll
    for (int j = 0; j < 8; ++j) { const f32x4 g = ((const f32x4*)gain)[64 * j + lane]; const f32x4 o = v[j] * r * g;
        u32x2 w; w.x = pk2(o.x, o.y); w.y = pk2(o.z, o.w); ((u32x2*)orow)[64 * j + lane] = w; }
}

namespace pg8 {
typedef short bf16x8 __attribute__((ext_vector_type(8)));
constexpr int BM = 256, BK = 64, HALF = 128, HTB = HALF * BK * 2, STAGE_BYTES = 8 * HTB, NXCD = 8, WGM = 8;
__device__ __forceinline__ int lds_byte(int r, int c) { const int st = (r >> 4) * 2 + (c >> 5), rr = r & 15, cc = c & 31, ob = rr * 64 + cc * 2; return st * 1024 + (ob ^ (((ob >> 9) & 1) << 5)); }
__device__ __forceinline__ void stage_rc(int b, int& R, int& C) { const int st = b / 1024, sb = b % 1024, swz = sb ^ (((sb >> 9) & 1) << 5); R = (st >> 1) * 16 + swz / 64; C = (st & 1) * 32 + (swz % 64) / 2; }
__device__ __forceinline__ int perm32(int rho) { const int n = rho >> 4, i = rho & 15; return 8 * (i >> 2) + 4 * n + (i & 3); }

struct Unit { int pm, pn, b; };
struct Gemm { const bf16_t* A; const bf16_t* Bt; int M, N, K, lda, ldb, nb; size_t sA, sB; };

struct Order {
    int nM, nN, nwg, nb, G, c;
    __device__ void init(int M, int N, int nb_, int G_, int c_) { nM = M / BM; nN = N / BM; nwg = nM * nN; nb = nb_; G = G_; c = c_; }
    __device__ bool next(int i, Unit& u) const {
        const long L = (long)i * G + c; if (L >= (long)nwg * nb) return false;
        u.b = (int)(L / nwg); int wgid = (int)(L % nwg);
        { const int q = nwg / NXCD, r = nwg % NXCD, xcd = wgid % NXCD, off = wgid / NXCD; wgid = (xcd < r ? xcd * (q + 1) : r * (q + 1) + (xcd - r) * q) + off; }
        const int nig = WGM * nN, gid = wgid / nig, fm = gid * WGM, gsz = (nM - fm) < WGM ? (nM - fm) : WGM;
        u.pm = fm + ((wgid % nig) % gsz); u.pn = (wgid % nig) / gsz; return true;
    }
};

template <class Epi>
__device__ __forceinline__ void gemm_phase(LAS unsigned char* lds, const Gemm g, const Order& S, const Epi& E, const int tid) {
    const int wid = __builtin_amdgcn_readfirstlane(tid >> 6), lane = tid & 63, wr = wid >> 2, wc = wid & 3, fr = lane & 15, fq = lane >> 4;
    int K_ = g.K; asm volatile("" : "+s"(K_));
    const int nt = K_ / BK;
    unsigned voffA[2], voffB[2];
#pragma unroll
    for (int i = 0; i < 2; ++i) { int R, C; stage_rc(tid * 16 + i * 8192, R, C); const int Rb = Epi::PERM ? ((R & ~31) + perm32(R & 31)) : R;
        voffA[i] = (unsigned)(R * g.lda + C) * 2u; voffB[i] = (unsigned)(Rb * g.ldb + C) * 2u; }
    const size_t kstep = (size_t)(BK * 2);
    const size_t hstepA = (size_t)HALF * g.lda * 2, tstepA = 2 * hstepA, hstepB = (size_t)HALF * g.ldb * 2, tstepB = 2 * hstepB;
    const unsigned ldsw = (unsigned)wid * 1024u;
    const int aoff = lds_byte(wr * 64 + fr, fq * 8), boff = lds_byte(wc * 32 + fr, fq * 8);
#define PG8_SA(b, h) (((b) * 2 + (h)) * HTB)
#define PG8_SB(b, h) ((4 + (b) * 2 + (h)) * HTB)
#define PG8_STAGE(bufoff, gbase, voff) do { _Pragma("unroll") for (int _i = 0; _i < 2; ++_i) \
        __builtin_amdgcn_global_load_lds((const unsigned*)((const char*)(gbase) + (voff)[_i]), (LAS unsigned*)(lds + (bufoff) + ldsw + _i * 8192), 16, 0, 0); } while (0)
#define PG8_LDA(dst, b, h) do { _Pragma("unroll") for (int m = 0; m < 4; ++m) _Pragma("unroll") for (int k = 0; k < 2; ++k) dst[m][k] = *(const LAS bf16x8*)(lds + PG8_SA(b, h) + aoff + m * 2048 + k * 1024); } while (0)
#define PG8_LDB(dst, b, h) do { _Pragma("unroll") for (int n = 0; n < 2; ++n) _Pragma("unroll") for (int k = 0; k < 2; ++k) dst[n][k] = *(const LAS bf16x8*)(lds + PG8_SB(b, h) + boff + n * 2048 + k * 1024); } while (0)
#define PG8_MMA(ai, bj, At, Bt) do { __builtin_amdgcn_s_setprio(1); _Pragma("unroll") for (int m = 0; m < 4; ++m) _Pragma("unroll") for (int n = 0; n < 2; ++n) _Pragma("unroll") for (int k = 0; k < 2; ++k) \
        acc[ai][bj][m][n] = __builtin_amdgcn_mfma_f32_16x16x32_bf16(Bt[n][k], At[m][k], acc[ai][bj][m][n], 0, 0, 0); __builtin_amdgcn_s_setprio(0); } while (0)
#define PG8_WAIT_V(n) asm volatile("s_waitcnt vmcnt(" #n ")" ::: "memory")
#define PG8_WAIT_L(n) asm volatile("s_waitcnt lgkmcnt(" #n ")" ::: "memory")
#define PG8_BAR __builtin_amdgcn_s_barrier()
#define PG8_SCHED __builtin_amdgcn_sched_barrier(0)
    Unit cur, nxt; int ui = 0;
    if (!S.next(0, cur)) return;
    f32x4 acc[2][2][4][2];
#pragma unroll
    for (int a = 0; a < 2; ++a)
#pragma unroll
        for (int b = 0; b < 2; ++b)
#pragma unroll
            for (int m = 0; m < 4; ++m)
#pragma unroll
                for (int n = 0; n < 2; ++n) acc[a][b][m][n] = (f32x4){0.f, 0.f, 0.f, 0.f};
    bf16x8 At[4][2], B0[2][2], B1[2][2];
    const char* cA = (const char*)g.A + (size_t)cur.b * g.sA * 2 + (size_t)cur.pm * tstepA; const char* cB = (const char*)g.Bt + (size_t)cur.b * g.sB * 2 + (size_t)cur.pn * tstepB;
    PG8_STAGE(PG8_SB(0, 0), cB, voffB); PG8_STAGE(PG8_SB(0, 1), cB + hstepB, voffB); PG8_STAGE(PG8_SA(0, 0), cA, voffA); PG8_STAGE(PG8_SA(0, 1), cA + hstepA, voffA);
    if (wr == 1) PG8_BAR;
    PG8_WAIT_V(2); PG8_BAR;
    PG8_STAGE(PG8_SB(1, 0), cB + kstep, voffB); PG8_STAGE(PG8_SA(1, 0), cA + kstep, voffA); PG8_STAGE(PG8_SB(1, 1), cB + hstepB + kstep, voffB);
    PG8_WAIT_V(6); PG8_BAR;
    for (;;) {
        const bool has_next = S.next(ui + 1, nxt);
        const char* nA = has_next ? (const char*)g.A + (size_t)nxt.b * g.sA * 2 + (size_t)nxt.pm * tstepA : cA;
        const char* nB = has_next ? (const char*)g.Bt + (size_t)nxt.b * g.sB * 2 + (size_t)nxt.pn * tstepB : cB;
        for (int t = 0; t < nt; t += 2) {
            const bool last = (t == nt - 2);
            const char* a1 = cA + (size_t)(t + 1) * kstep;
            const char* a2 = last ? nA : cA + (size_t)(t + 2) * kstep; const char* b2 = last ? nB : cB + (size_t)(t + 2) * kstep;
            const char* a3 = a2 + kstep; const char* b3 = b2 + kstep;
            PG8_LDB(B0, 0, 0); PG8_LDB(B1, 0, 1); PG8_SCHED; PG8_LDA(At, 0, 0); PG8_STAGE(PG8_SA(1, 1), a1 + hstepA, voffA);
            PG8_WAIT_V(8); PG8_WAIT_L(0); PG8_BAR; PG8_MMA(0, 0, At, B0); PG8_MMA(0, 1, At, B1); PG8_BAR; PG8_SCHED;
            PG8_LDA(At, 0, 1); PG8_STAGE(PG8_SB(0, 0), b2, voffB); PG8_STAGE(PG8_SB(0, 1), b2 + hstepB, voffB); PG8_STAGE(PG8_SA(0, 0), a2, voffA);
            PG8_WAIT_V(8); PG8_WAIT_L(0); PG8_BAR; PG8_MMA(1, 0, At, B0); PG8_MMA(1, 1, At, B1); PG8_BAR; PG8_SCHED;
            PG8_LDB(B0, 1, 0); PG8_LDB(B1, 1, 1); PG8_SCHED; PG8_LDA(At, 1, 0); PG8_STAGE(PG8_SA(0, 1), a2 + hstepA, voffA);
            PG8_WAIT_V(8); PG8_WAIT_L(0); PG8_BAR; PG8_MMA(0, 0, At, B0); PG8_MMA(0, 1, At, B1); PG8_BAR; PG8_SCHED;
            PG8_LDA(At, 1, 1); PG8_STAGE(PG8_SB(1, 0), b3, voffB); PG8_STAGE(PG8_SB(1, 1), b3 + hstepB, voffB); PG8_STAGE(PG8_SA(1, 0), a3, voffA);
            PG8_WAIT_V(8); PG8_WAIT_L(0); PG8_BAR; PG8_MMA(1, 0, At, B0); PG8_MMA(1, 1, At, B1); PG8_BAR; PG8_SCHED;
        }
        if (wr == 0) PG8_BAR;
        E(acc, cur, wr, wc, fr, fq);
        if (!has_next) break;
#pragma unroll
        for (int a = 0; a < 2; ++a)
#pragma unroll
            for (int b = 0; b < 2; ++b)
#pragma unroll
                for (int m = 0; m < 4; ++m)
#pragma unroll
                    for (int n = 0; n < 2; ++n) acc[a][b][m][n] = (f32x4){0.f, 0.f, 0.f, 0.f};
        cur = nxt; cA = nA; cB = nB; ++ui;
        if (wr == 1) PG8_BAR;
    }
    PG8_WAIT_V(0);
    PG8_BAR;
#undef PG8_SA
#undef PG8_SB
#undef PG8_STAGE
#undef PG8_LDA
#undef PG8_LDB
#undef PG8_MMA
#undef PG8_WAIT_V
#undef PG8_WAIT_L
#undef PG8_BAR
#undef PG8_SCHED
}
}

typedef f32x4 acc_t[2][2][4][2];
#define EPI_ROW(ai, m) (u.pm * 256 + (ai) * 128 + wr * 64 + (m) * 16 + fr)
__device__ __forceinline__ u32x4 pack8(const f32x4 a, const f32x4 b) { u32x4 w; w.x = pk2(a.x, a.y); w.y = pk2(a.z, a.w); w.z = pk2(b.x, b.y); w.w = pk2(b.z, b.w); return w; }
__device__ __forceinline__ f32x4 sig4(const f32x4 v) { f32x4 o; o.x = sigmoidf_(v.x); o.y = sigmoidf_(v.y); o.z = sigmoidf_(v.z); o.w = sigmoidf_(v.w); return o; }

struct EpiZf {
    static constexpr bool PERM = true;
    bf16_t *q, *k, *vT, *ax, *ga, *gs; const float* rope;
    __device__ __forceinline__ void operator()(const acc_t& acc, const pg8::Unit& u, int wr, int wc, int fr, int fq) const {
        const int pn = u.pn;
#pragma unroll
        for (int ai = 0; ai < 2; ++ai)
#pragma unroll
            for (int m = 0; m < 4; ++m) {
                const int row = EPI_ROW(ai, m);
#pragma unroll
                for (int bj = 0; bj < 2; ++bj) {
                    f32x4 v0 = acc[ai][bj][m][0], v1 = acc[ai][bj][m][1];
                    const int cl = bj * 128 + wc * 32 + 8 * fq;
                    if (pn < 4 || (pn == 4 && bj == 0)) {
                        if ((wc & 1) == 0) {
                            f32x4 p0, p1;
                            p0.x = __shfl_xor(v0.x, 16); p0.y = __shfl_xor(v0.y, 16); p0.z = __shfl_xor(v0.z, 16); p0.w = __shfl_xor(v0.w, 16);
                            p1.x = __shfl_xor(v1.x, 16); p1.y = __shfl_xor(v1.y, 16); p1.z = __shfl_xor(v1.z, 16); p1.w = __shfl_xor(v1.w, 16);
                            if (fq < 2) {
                                const f32x4* rp = (const f32x4*)(rope + (size_t)row * 16);
                                const f32x4 r0 = rp[0], r1 = rp[1], r2 = rp[2], r3 = rp[3];
                                const float sg = (fq == 0) ? -1.f : 1.f;
                                v0.x = v0.x * r0.x + sg * p0.x * r0.y; v0.y = v0.y * r0.z + sg * p0.y * r0.w;
                                v0.z = v0.z * r1.x + sg * p0.z * r1.y; v0.w = v0.w * r1.z + sg * p0.w * r1.w;
                                v1.x = v1.x * r2.x + sg * p1.x * r2.y; v1.y = v1.y * r2.z + sg * p1.y * r2.w;
                                v1.z = v1.z * r3.x + sg * p1.z * r3.y; v1.w = v1.w * r3.z + sg * p1.w * r3.w;
                            }
                        }
                        bf16_t* dst = (pn < 4) ? (q + (size_t)row * 1024 + pn * 256 + cl) : (k + (size_t)row * 128 + cl);
                        *(u32x4*)dst = pack8(v0, v1);
                    } else if (pn == 4) {
                        bf16_t* dst = vT + (size_t)(cl - 128) * SEQ + row;
                        dst[0 * (size_t)SEQ] = (bf16_t)f2bf(v0.x); dst[1 * (size_t)SEQ] = (bf16_t)f2bf(v0.y); dst[2 * (size_t)SEQ] = (bf16_t)f2bf(v0.z); dst[3 * (size_t)SEQ] = (bf16_t)f2bf(v0.w);
                        dst[4 * (size_t)SEQ] = (bf16_t)f2bf(v1.x); dst[5 * (size_t)SEQ] = (bf16_t)f2bf(v1.y); dst[6 * (size_t)SEQ] = (bf16_t)f2bf(v1.z); dst[7 * (size_t)SEQ] = (bf16_t)f2bf(v1.w);
                    } else if (pn < 9) {
                        const int c = (pn - 5) * 256 + cl, g = c >> 4, ci0 = c & 15;
                        *(u32x4*)(ax + ((size_t)g * 512 + (row >> 4)) * 384 + (row & 15) * 16 + ci0) = pack8(v0, v1);
                    } else if (pn < 17) {
                        *(u32x4*)(ga + (size_t)row * 2048 + (pn - 9) * 256 + cl) = pack8(sig4(v0), sig4(v1));
                    } else {
                        *(u32x4*)(gs + (size_t)row * 2048 + (pn - 17) * 256 + cl) = pack8(sig4(v0), sig4(v1));
                    }
                }
            }
    }
};
struct EpiSf {
    static constexpr bool PERM = false; float* S;
    __device__ __forceinline__ void operator()(const acc_t& acc, const pg8::Unit& u, int wr, int wc, int fr, int fq) const {
#pragma unroll
        for (int ai = 0; ai < 2; ++ai)
#pragma unroll
            for (int m = 0; m < 4; ++m) { const int row = EPI_ROW(ai, m);
#pragma unroll
                for (int n = 0; n < 2; ++n) *(f32x4*)(S + ((size_t)u.b * 512 + row) * 128 + wc * 32 + 16 * n + 4 * fq) = acc[ai][0][m][n]; }
    }
};
struct EpiYf {
    static constexpr bool PERM = true; bf16_t* y;
    __device__ __forceinline__ void operator()(const acc_t& acc, const pg8::Unit& u, int wr, int wc, int fr, int fq) const {
#pragma unroll
        for (int ai = 0; ai < 2; ++ai)
#pragma unroll
            for (int m = 0; m < 4; ++m) { const int row = EPI_ROW(ai, m);
#pragma unroll
                for (int bj = 0; bj < 2; ++bj) { const int c = bj * 128 + wc * 32 + 8 * fq, t = c >> 4, co0 = c & 15;
                    bf16_t* dst = y + (size_t)(row * 16 + t) * 1024 + u.b * 16 + co0;
#pragma unroll
                    for (int n = 0; n < 2; ++n) { const f32x4 v = acc[ai][bj][m][n];
                        u32x2 w; w.x = pk2(gelu_tanh(v.x), gelu_tanh(v.y)); w.y = pk2(gelu_tanh(v.z), gelu_tanh(v.w)); *(u32x2*)(dst + 4 * n) = w;
                        asm volatile("" ::: "memory"); } } }
    }
};
struct EpiGLUf {
    static constexpr bool PERM = true; bf16_t* o;
    __device__ __forceinline__ void operator()(const acc_t& acc, const pg8::Unit& u, int wr, int wc, int fr, int fq) const {
#pragma unroll
        for (int ai = 0; ai < 2; ++ai)
#pragma unroll
            for (int m = 0; m < 4; ++m) { const int row = EPI_ROW(ai, m);
                const f32x4 v0 = acc[ai][0][m][0] * sig4(acc[ai][1][m][0]), v1 = acc[ai][0][m][1] * sig4(acc[ai][1][m][1]);
                *(u32x4*)(o + (size_t)row * 1024 + u.pn * 128 + wc * 32 + 8 * fq) = pack8(v0, v1); }
    }
};
__device__ __forceinline__ f32x4 ld_bf4(const bf16_t* p) { const u32x2 w = *(const u32x2*)p; f32x4 o; o.x = bf2f(w.x & 0xffffu); o.y = bf2f(w.x >> 16); o.z = bf2f(w.y & 0xffffu); o.w = bf2f(w.y >> 16); return o; }
struct EpiT1f {
    static constexpr bool PERM = false; f32x4* t1; const bf16_t* ga; int tid;
    __device__ __forceinline__ void operator()(const acc_t& acc, const pg8::Unit& u, int wr, int wc, int fr, int fq) const {
        f32x4* base = t1 + (size_t)(u.pm * 8 + u.pn) * 32 * 512 + tid;
#pragma unroll
        for (int ai = 0; ai < 2; ++ai)
#pragma unroll
            for (int m = 0; m < 4; ++m) { const int row = EPI_ROW(ai, m);
#pragma unroll
                for (int bj = 0; bj < 2; ++bj)
#pragma unroll
                    for (int n = 0; n < 2; ++n) { const int col = u.pn * 256 + bj * 128 + wc * 32 + 16 * n + 4 * fq;
                        base[(((ai * 2 + bj) * 4 + m) * 2 + n) * 512] = ld_bf4(ga + (size_t)row * 2048 + col) * acc[ai][bj][m][n]; } }
    }
};
struct EpiMf {
    static constexpr bool PERM = false; const f32x4* t1; const bf16_t* gs; bf16_t* mo; int tid;
    __device__ __forceinline__ void operator()(const acc_t& acc, const pg8::Unit& u, int wr, int wc, int fr, int fq) const {
        const f32x4* base = t1 + (size_t)(u.pm * 8 + u.pn) * 32 * 512 + tid;
#pragma unroll
        for (int ai = 0; ai < 2; ++ai)
#pragma unroll
            for (int m = 0; m < 4; ++m) { const int row = EPI_ROW(ai, m);
#pragma unroll
                for (int bj = 0; bj < 2; ++bj)
#pragma unroll
                    for (int n = 0; n < 2; ++n) { const int col = u.pn * 256 + bj * 128 + wc * 32 + 16 * n + 4 * fq;
                        const f32x4 v = base[(((ai * 2 + bj) * 4 + m) * 2 + n) * 512] + ld_bf4(gs + (size_t)row * 2048 + col) * acc[ai][bj][m][n];
                        u32x2 w; w.x = pk2(v.x, v.y); w.y = pk2(v.z, v.w); *(u32x2*)(mo + (size_t)row * 2048 + col) = w; } }
    }
};
struct EpiF32f {
    static constexpr bool PERM = false; float* o;
    __device__ __forceinline__ void operator()(const acc_t& acc, const pg8::Unit& u, int wr, int wc, int fr, int fq) const {
#pragma unroll
        for (int ai = 0; ai < 2; ++ai)
#pragma unroll
            for (int m = 0; m < 4; ++m) { const int row = EPI_ROW(ai, m);
#pragma unroll
                for (int bj = 0; bj < 2; ++bj)
#pragma unroll
                    for (int n = 0; n < 2; ++n) *(f32x4*)(o + (size_t)row * 2048 + u.pn * 256 + bj * 128 + wc * 32 + 16 * n + 4 * fq) = acc[ai][bj][m][n]; }
    }
};
struct EpiUpf {
    static constexpr bool PERM = true; bf16_t* a;
    __device__ __forceinline__ void operator()(const acc_t& acc, const pg8::Unit& u, int wr, int wc, int fr, int fq) const {
#pragma unroll
        for (int ai = 0; ai < 2; ++ai)
#pragma unroll
            for (int m = 0; m < 4; ++m) { const int row = EPI_ROW(ai, m);
#pragma unroll
                for (int bj = 0; bj < 2; ++bj) {
                    f32x4 v0 = acc[ai][bj][m][0], v1 = acc[ai][bj][m][1];
                    v0.x = fmaxf(v0.x, 0.f); v0.y = fmaxf(v0.y, 0.f); v0.z = fmaxf(v0.z, 0.f); v0.w = fmaxf(v0.w, 0.f);
                    v1.x = fmaxf(v1.x, 0.f); v1.y = fmaxf(v1.y, 0.f); v1.z = fmaxf(v1.z, 0.f); v1.w = fmaxf(v1.w, 0.f);
                    *(u32x4*)(a + (size_t)row * DFF + u.pn * 256 + bj * 128 + wc * 32 + 8 * fq) = pack8(v0 * v0, v1 * v1); } }
    }
};

typedef float f32x16 __attribute__((ext_vector_type(16)));
typedef short s16x8 __attribute__((ext_vector_type(8)));
__device__ __forceinline__ void attn_item(const bf16_t* Q, const bf16_t* Kb, const bf16_t* VT, bf16_t* O, const float sink, const int qt, const int h, const int lane) {
    const int r = lane & 31, hf = lane >> 5, q0 = qt * 32, hk = h >> 3;
    s16x8 qf[4];
#pragma unroll
    for (int kk = 0; kk < 4; ++kk) qf[kk] = *(const s16x8*)(Q + (size_t)(q0 + r) * 1024 + h * 64 + 16 * kk + 8 * hf);
    f32x16 st[5];
#pragma unroll
    for (int kt = 0; kt < 5; ++kt) {
        int key = q0 - 128 + 32 * kt + r; key = key < 0 ? 0 : key;
        f32x16 a = {0.f, 0.f, 0.f, 0.f, 0.f, 0.f, 0.f, 0.f, 0.f, 0.f, 0.f, 0.f, 0.f, 0.f, 0.f, 0.f};
#pragma unroll
        for (int kk = 0; kk < 4; ++kk) {
            const s16x8 kf = *(const s16x8*)(Kb + (size_t)key * 128 + hk * 64 + 16 * kk + 8 * hf);
            a = __builtin_amdgcn_mfma_f32_32x32x16_bf16(kf, qf[kk], a, 0, 0, 0);
        }
        st[kt] = a;
    }
    float mx = sink;
#pragma unroll
    for (int kt = 0; kt < 5; ++kt)
#pragma unroll
        for (int e = 0; e < 16; ++e) {
            const int kofs = -128 + 32 * kt + (e & 3) + 8 * (e >> 2) + 4 * hf;
            const int diff = r - kofs;
            const bool ok = (diff >= 0) && (diff < 128) && (q0 + kofs >= 0);
            const float s = ok ? st[kt][e] * 0.125f : -1e30f;
            st[kt][e] = s; mx = fmaxf(mx, s);
        }
    mx = fmaxf(mx, __shfl_xor(mx, 32));
    float sum = 0.f;
#pragma unroll
    for (int kt = 0; kt < 5; ++kt)
#pragma unroll
        for (int e = 0; e < 16; ++e) { const float pv = (st[kt][e] > -1e29f) ? __expf(st[kt][e] - mx) : 0.f; st[kt][e] = pv; sum += pv; }
    sum += __shfl_xor(sum, 32);
    sum += __expf(sink - mx);
    const float inv = 1.0f / sum;
    f32x16 o0 = {0.f, 0.f, 0.f, 0.f, 0.f, 0.f, 0.f, 0.f, 0.f, 0.f, 0.f, 0.f, 0.f, 0.f, 0.f, 0.f}, o1 = o0;
#pragma unroll
    for (int kt = 0; kt < 5; ++kt)
#pragma unroll
        for (int s = 0; s < 2; ++s) {
            u32x4 pw; pw.x = pk2(st[kt][8 * s + 0], st[kt][8 * s + 1]); pw.y = pk2(st[kt][8 * s + 2], st[kt][8 * s + 3]);
            pw.z = pk2(st[kt][8 * s + 4], st[kt][8 * s + 5]); pw.w = pk2(st[kt][8 * s + 6], st[kt][8 * s + 7]);
            const s16x8 pf = __builtin_bit_cast(s16x8, pw);
            int kb = q0 - 128 + 32 * kt + 16 * s + 4 * hf; const int kb0 = kb < 0 ? 0 : kb, kb1 = (kb + 8) < 0 ? 0 : (kb + 8);
#pragma unroll
            for (int dt = 0; dt < 2; ++dt) {
                const bf16_t* vp = VT + (size_t)(hk * 64 + 32 * dt + r) * SEQ;
                const u32x2 a0 = *(const u32x2*)(vp + kb0), a1 = *(const u32x2*)(vp + kb1);
                u32x4 vw; vw.x = a0.x; vw.y = a0.y; vw.z = a1.x; vw.w = a1.y;
                const s16x8 vf = __builtin_bit_cast(s16x8, vw);
                if (dt == 0) o0 = __builtin_amdgcn_mfma_f32_32x32x16_bf16(vf, pf, o0, 0, 0, 0);
                else o1 = __builtin_amdgcn_mfma_f32_32x32x16_bf16(vf, pf, o1, 0, 0, 0);
            }
        }
    bf16_t* op = O + (size_t)(q0 + r) * 1024 + h * 64 + 4 * hf;
#pragma unroll
    for (int i = 0; i < 4; ++i) {
        u32x2 w; w.x = pk2(o0[4 * i] * inv, o0[4 * i + 1] * inv); w.y = pk2(o0[4 * i + 2] * inv, o0[4 * i + 3] * inv); *(u32x2*)(op + 8 * i) = w;
        u32x2 w1; w1.x = pk2(o1[4 * i] * inv, o1[4 * i + 1] * inv); w1.y = pk2(o1[4 * i + 2] * inv, o1[4 * i + 3] * inv); *(u32x2*)(op + 32 + 8 * i) = w1;
    }
}

constexpr int NPHASE = 12;

template <int PH>
__device__ __forceinline__ void run_phase(const P& p, LAS unsigned char* lds) {
    int tid_ = threadIdx.x; asm volatile("" : "+v"(tid_));
    const int tid = tid_, lane = tid & 63, wave = tid >> 6;
    int bid_ = blockIdx.x; asm volatile("" : "+s"(bid_));
    const int bid = bid_;
    const int G = gridDim.x, gw = bid * 8 + wave, NGW = G * 8;
    const size_t gt = (size_t)bid * 512 + tid, NGT = (size_t)G * 512;
    unsigned char* ws = p.ws; unsigned char* dout = (unsigned char*)p.out;
    asm volatile("" : "+s"(ws), "+s"(dout));
    float2* AP = (float2*)(ws + WS_AP); float2* BBAR = (float2*)(ws + WS_BBAR); float2* ROPE = (float2*)(ws + WS_ROPE);
    bf16_t* WUP = (bf16_t*)(ws + WS_WUP); bf16_t* WDN = (bf16_t*)(ws + WS_WDN); bf16_t* WIN = (bf16_t*)(ws + WS_WIN); bf16_t* WGLU = (bf16_t*)(ws + WS_WGLU);
    bf16_t* WBRA = (bf16_t*)(ws + WS_WBRA); bf16_t* WBRS = (bf16_t*)(ws + WS_WBRS); bf16_t* WOUT = (bf16_t*)(ws + WS_WOUT);
    bf16_t* H = (bf16_t*)(ws + WS_H); bf16_t* OATT = (bf16_t*)(ws + WS_OATT); bf16_t* Q = (bf16_t*)(ws + WS_Q); bf16_t* OSSM = (bf16_t*)(ws + WS_OSSM);
    bf16_t* Kb = (bf16_t*)(ws + WS_K); bf16_t* VT = (bf16_t*)(ws + WS_VT); bf16_t* AX = (bf16_t*)(ws + WS_AX); bf16_t* Y = (bf16_t*)(ws + WS_Y);
    bf16_t* Mb = (bf16_t*)(ws + WS_M); bf16_t* GA = (bf16_t*)(ws + WS_GA); bf16_t* GS = (bf16_t*)(ws + WS_GS); float* MIXED = (float*)(ws + WS_MIXED);
    bf16_t* H2 = (bf16_t*)(ws + WS_H2); bf16_t* Ab = (bf16_t*)(ws + WS_A); float* DN = (float*)(ws + WS_DN);
    float* S = (float*)(dout + DO_S); float* KTAB = (float*)(dout + DO_KTAB); bf16_t* BC = (bf16_t*)(dout + DO_BC); bf16_t* YB = (bf16_t*)(dout + DO_YB);
    float* T1 = (float*)dout; float* X1 = (float*)dout;
    const float* x = p.in[0];

    if constexpr (PH == 0) {
        LAS float* scr = (LAS float*)(lds + wave * 16384);
        constexpr int I_IN = 32 * 200, I_GLU = 16 * 64, I_BR = 16 * 64, I_OUT = 32 * 64, I_UP = 32 * 256, I_DN = 128 * 64;
        constexpr int NIT = I_IN + I_GLU + 2 * I_BR + I_OUT + I_UP + I_DN;
        for (int it = gw; it < NIT; it += NGW) {
            int r = it;
            if (r < I_IN) { const int nb = r % 200, kb = r / 200; transpose_item(p.in[5], INW, WIN, 2048, 64 * kb, 32 * nb, 32 * nb, scr, lane); continue; } r -= I_IN;
            if (r < I_GLU) { const int nb = r % 64, kb = r / 64, n0 = 32 * nb, bj = n0 >> 10, j = n0 & 1023, t = j >> 7, jj = j & 127;
                transpose_item(p.in[15], 2048, WGLU, 1024, 64 * kb, n0, 256 * t + 128 * bj + jj, scr, lane); continue; } r -= I_GLU;
            if (r < I_BR) { const int nb = r % 64, kb = r / 64; transpose_item(p.in[16], 2048, WBRA, 1024, 64 * kb, 32 * nb, 32 * nb, scr, lane); continue; } r -= I_BR;
            if (r < I_BR) { const int nb = r % 64, kb = r / 64; transpose_item(p.in[16] + (size_t)1024 * 2048, 2048, WBRS, 1024, 64 * kb, 32 * nb, 32 * nb, scr, lane); continue; } r -= I_BR;
            if (r < I_OUT) { const int nb = r % 64, kb = r / 64; transpose_item(p.in[17], 2048, WOUT, 2048, 64 * kb, 32 * nb, 32 * nb, scr, lane); continue; } r -= I_OUT;
            if (r < I_UP) { const int nb = r % 256, kb = r / 256; transpose_item(p.in[18], DFF, WUP, 2048, 64 * kb, 32 * nb, 32 * nb, scr, lane); continue; } r -= I_UP;
            { const int nb = r % 64, kb = r / 64; transpose_item(p.in[19], 2048, WDN, DFF, 64 * kb, 32 * nb, 32 * nb, scr, lane); }
        }
        for (int m = gw; m < SEQ; m += NGW) rms_row_bf16(x + (size_t)m * DM, p.in[1], H + (size_t)m * DM, lane);
        for (size_t i = gt; i < (size_t)NG * SP; i += NGT) {
            const int g = (int)i / SP;
            const double dt = exp((double)p.in[9][g]), lr = (double)p.in[7][i], li = (double)p.in[8][i];
            for (int n = 0; n < NAP; ++n) {
                const double pw = (n == 17) ? 1024.0 : (double)n;
                const float mag = (float)exp(pw * lr * dt); float s, c; sincos_d(pw * li * dt, s, c);
                AP[i * NAP + n] = make_float2(mag * c, mag * s);
            }
            float s1, c1; sincos_d(li * dt, s1, c1);
            const double mag1 = exp(lr * dt), are = mag1 * (double)c1, aim = mag1 * (double)s1;
            const double nr = are - 1.0, ni = aim, den = lr * lr + li * li;
            const double cre = (nr * lr + ni * li) / den, cim = (ni * lr - nr * li) / den;
            for (int c = 0; c < GC; ++c) {
                const double br = (double)p.in[10][i * GC + c], bi = (double)p.in[11][i * GC + c];
                BBAR[i * GC + c] = make_float2((float)(cre * br - cim * bi), (float)(cre * bi + cim * br));
            }
        }
        for (size_t i = gt; i < (size_t)SEQ * 8; i += NGT) {
            const int pos = (int)(i >> 3), k = (int)(i & 7);
            const double inv = exp(-(double)k * 0.125 * 13.122363377404328);
            float s, c; sincos_d((double)pos * inv, s, c);
            ROPE[i] = make_float2(c, s);
        }
        }
    if constexpr (PH == 1) {
        { pg8::Gemm g{H, WIN, SEQ, INW, DM, DM, DM, 1, 0, 0}; pg8::Order S; S.init(SEQ, INW, 1, G, bid);
          EpiZf E{Q, Kb, VT, AX, GA, GS, (const float*)ROPE}; pg8::gemm_phase(lds, g, S, E, tid); }
        for (size_t i = gt; i < (size_t)NG * 256 * 256; i += NGT) {
            const int g = (int)(i >> 16), r = (int)(i >> 8) & 255, k = (int)i & 255, s = k >> 4, ci = k & 15;
            float v = 0.f;
            if (r < 128) { const int pp = r & 63; const float2 a = AP[((size_t)g * SP + pp) * NAP + (15 - s)], b = BBAR[((size_t)g * SP + pp) * GC + ci];
                v = (r >> 6) ? (a.x * b.y + a.y * b.x) : (a.x * b.x - a.y * b.y); }
            BC[i] = (bf16_t)f2bf(v);
        }
        for (size_t i = gt; i < (size_t)NG * 256 * 128; i += NGT) {
            const int g = (int)(i >> 15), row = (int)(i >> 7) & 255, r = (int)i & 127, t = row >> 4, co = row & 15, pp = r & 63;
            const float2 a = AP[((size_t)g * SP + pp) * NAP + (t + 1)];
            const float cr = p.in[12][((size_t)g * GC + co) * SP + pp], cim = p.in[13][((size_t)g * GC + co) * SP + pp];
            const float wre = cr * a.x - cim * a.y, wim = cr * a.y + cim * a.x;
            YB[((size_t)g * 256 + row) * 384 + 256 + r] = (bf16_t)f2bf((r >> 6) ? -wim : wre);
        }
        for (size_t i = gt; i < (size_t)NG * 16 * 256; i += NGT) {
            const int g = (int)(i >> 12), tau = (int)(i >> 8) & 15, co = (int)(i >> 4) & 15, ci = (int)i & 15;
            float acc = 0.f;
            for (int pp = 0; pp < SP; ++pp) {
                const float2 a = AP[((size_t)g * SP + pp) * NAP + tau], b = BBAR[((size_t)g * SP + pp) * GC + ci];
                const float cr = p.in[12][((size_t)g * GC + co) * SP + pp], cim = p.in[13][((size_t)g * GC + co) * SP + pp];
                const float wre = cr * a.x - cim * a.y, wim = cr * a.y + cim * a.x;
                acc += wre * b.x - wim * b.y;
            }
            if (tau == 0 && co == ci) acc += p.in[14][g * GC + co];
            KTAB[i] = acc;
        }
        }
    if constexpr (PH == 2) {
        { pg8::Gemm g{AX, BC, 512, 256, 256, 384, 256, NG, (size_t)512 * 384, (size_t)256 * 256}; pg8::Order S_; S_.init(512, 256, NG, G, bid);
          EpiSf E{S}; pg8::gemm_phase(lds, g, S_, E, tid); }
        for (size_t i = gt; i < (size_t)NG * 256 * 256; i += NGT) {
            const int g = (int)(i >> 16), row = (int)(i >> 8) & 255, k = (int)i & 255, t = row >> 4, co = row & 15, s = k >> 4, ci = k & 15;
            const float v = (t >= s) ? KTAB[(((size_t)g * 16 + (t - s)) * 16 + co) * 16 + ci] : 0.f;
            YB[((size_t)g * 256 + row) * 384 + k] = (bf16_t)f2bf(v);
        }
            for (int item = gw; item < 256 * NH; item += NGW) { const int h = item & 15, qt = item >> 4; attn_item(Q, Kb, VT, OATT, p.in[6][h], qt, h, lane); }
    }
    if constexpr (PH == 3) {
        LAS float* Elr = (LAS float*)lds; LAS float* Eli = Elr + 512;
        for (int g = bid; g < NG; g += G) {
            const int pp = tid & 63, seg = tid >> 6;
            const float2 A16 = AP[((size_t)g * SP + pp) * NAP + 16], A1k = AP[((size_t)g * SP + pp) * NAP + 17];
            const float* Sg = S + (size_t)g * 512 * 128;
            float lre = 0.f, lim = 0.f;
            for (int j = seg * 64; j < seg * 64 + 64; ++j) { const float sr = Sg[j * 128 + pp], si = Sg[j * 128 + 64 + pp];
                const float nr = A16.x * lre - A16.y * lim + sr, ni = A16.x * lim + A16.y * lre + si; lre = nr; lim = ni; }
            __syncthreads();
            Elr[seg * 64 + pp] = lre; Eli[seg * 64 + pp] = lim;
            __syncthreads();
            float cre = 0.f, cim = 0.f;
            for (int s2 = 0; s2 < seg; ++s2) { const float2 e = make_float2(Elr[s2 * 64 + pp], Eli[s2 * 64 + pp]);
                const float nr = A1k.x * cre - A1k.y * cim + e.x, ni = A1k.x * cim + A1k.y * cre + e.y; cre = nr; cim = ni; }
            for (int j = seg * 64; j < seg * 64 + 64; ++j) {
                bf16_t* axr = AX + ((size_t)g * 512 + j) * 384 + 256;
                axr[pp] = (bf16_t)f2bf(cre); axr[64 + pp] = (bf16_t)f2bf(cim);
                const float sr = Sg[j * 128 + pp], si = Sg[j * 128 + 64 + pp];
                const float nr = A16.x * cre - A16.y * cim + sr, ni = A16.x * cim + A16.y * cre + si; cre = nr; cim = ni; }
        }
        }
    if constexpr (PH == 4) { pg8::Gemm g{AX, YB, 512, 256, 384, 384, 384, NG, (size_t)512 * 384, (size_t)256 * 384}; pg8::Order S_; S_.init(512, 256, NG, G, bid);
        EpiYf E{Y}; pg8::gemm_phase(lds, g, S_, E, tid); }
    if constexpr (PH == 5) { pg8::Gemm g{Y, WGLU, SEQ, 2048, 1024, 1024, 1024, 1, 0, 0}; pg8::Order S_; S_.init(SEQ, 2048, 1, G, bid);
        EpiGLUf E{OSSM}; pg8::gemm_phase(lds, g, S_, E, tid); }
    if constexpr (PH == 6) {
        { pg8::Gemm g{OATT, WBRA, SEQ, 2048, 1024, 1024, 1024, 1, 0, 0}; pg8::Order S_; S_.init(SEQ, 2048, 1, G, bid);
          EpiT1f E{(f32x4*)T1, GA, tid}; pg8::gemm_phase(lds, g, S_, E, tid); }
        { pg8::Gemm g{OSSM, WBRS, SEQ, 2048, 1024, 1024, 1024, 1, 0, 0}; pg8::Order S_; S_.init(SEQ, 2048, 1, G, bid);
          EpiMf E{(const f32x4*)T1, GS, Mb, tid}; pg8::gemm_phase(lds, g, S_, E, tid); }
    }
    if constexpr (PH == 7) { pg8::Gemm g{Mb, WOUT, SEQ, 2048, 2048, 2048, 2048, 1, 0, 0}; pg8::Order S_; S_.init(SEQ, 2048, 1, G, bid);
        EpiF32f E{MIXED}; pg8::gemm_phase(lds, g, S_, E, tid); }
    if constexpr (PH == 8) {
        for (int m = gw; m < SEQ; m += NGW) {
            const f32x4* mr = (const f32x4*)(MIXED + (size_t)m * DM); const f32x4* xr = (const f32x4*)(x + (size_t)m * DM);
            f32x4 v[8]; float s = 0.f;
#pragma unroll
            for (int j = 0; j < 8; ++j) { v[j] = mr[64 * j + lane]; s += v[j].x * v[j].x + v[j].y * v[j].y + v[j].z * v[j].z + v[j].w * v[j].w; }
            const float r = rsqrtf(wave_sum(s) * (1.0f / DM) + 1e-6f); float s2 = 0.f;
#pragma unroll
            for (int j = 0; j < 8; ++j) { const f32x4 g = ((const f32x4*)p.in[2])[64 * j + lane]; v[j] = xr[64 * j + lane] + v[j] * r * g;
                ((f32x4*)(X1 + (size_t)m * DM))[64 * j + lane] = v[j]; s2 += v[j].x * v[j].x + v[j].y * v[j].y + v[j].z * v[j].z + v[j].w * v[j].w; }
            const float r2 = rsqrtf(wave_sum(s2) * (1.0f / DM) + 1e-6f);
#pragma unroll
            for (int j = 0; j < 8; ++j) { const f32x4 g = ((const f32x4*)p.in[3])[64 * j + lane]; const f32x4 o = v[j] * r2 * g;
                u32x2 w; w.x = pk2(o.x, o.y); w.y = pk2(o.z, o.w); ((u32x2*)(H2 + (size_t)m * DM))[64 * j + lane] = w; }
        }
        }
    if constexpr (PH == 9) { pg8::Gemm g{H2, WUP, SEQ, DFF, DM, DM, DM, 1, 0, 0}; pg8::Order S_; S_.init(SEQ, DFF, 1, G, bid);
        EpiUpf E{Ab}; pg8::gemm_phase(lds, g, S_, E, tid); }
    if constexpr (PH == 10) { pg8::Gemm g{Ab, WDN, SEQ, DM, DFF, DFF, DFF, 1, 0, 0}; pg8::Order S_; S_.init(SEQ, DM, 1, G, bid);
        EpiF32f E{DN}; pg8::gemm_phase(lds, g, S_, E, tid); }
    if constexpr (PH == 11) {
        for (int m = gw; m < SEQ; m += NGW) {
            const f32x4* dr = (const f32x4*)(DN + (size_t)m * DM); f32x4* xr = (f32x4*)(X1 + (size_t)m * DM);
            f32x4 v[8]; float s = 0.f;
#pragma unroll
            for (int j = 0; j < 8; ++j) { v[j] = dr[64 * j + lane]; s += v[j].x * v[j].x + v[j].y * v[j].y + v[j].z * v[j].z + v[j].w * v[j].w; }
            const float r = rsqrtf(wave_sum(s) * (1.0f / DM) + 1e-6f);
#pragma unroll
            for (int j = 0; j < 8; ++j) { const f32x4 g = ((const f32x4*)p.in[4])[64 * j + lane]; xr[64 * j + lane] = xr[64 * j + lane] + v[j] * r * g; }
        }
        }
}

constexpr int LDS_BYTES = 147456;

template <int PH>
__global__ void __launch_bounds__(512, 2) k_phase(P p) {
    extern __shared__ __attribute__((aligned(16))) unsigned char lds_raw[];
    run_phase<PH>(p, (LAS unsigned char*)lds_raw);
}
#if COOP
template <int PH>
__device__ __forceinline__ void run_all(const P& p, LAS unsigned char* lds, cg::grid_group& grid) {
    run_phase<PH>(p, lds);
#ifndef PH_HI
#define PH_HI NPHASE
#endif
#ifndef PH_LO
#define PH_LO 0
#endif
    if constexpr (PH + 1 < PH_HI) { grid.sync(); run_all<PH + 1>(p, lds, grid); }
}
__global__ void __launch_bounds__(512, 2) k_all(P p) {
    extern __shared__ __attribute__((aligned(16))) unsigned char lds_raw[];
    cg::grid_group grid = cg::this_grid();
    run_all<PH_LO>(p, (LAS unsigned char*)lds_raw, grid);
}
#endif
template <int PH>
static void launch_phases(const P& p, int grid, hipStream_t stream) {
    hipLaunchKernelGGL(k_phase<PH>, dim3(grid), dim3(512), LDS_BYTES, stream, p);
    if constexpr (PH + 1 < NPHASE) launch_phases<PH + 1>(p, grid, stream);
}
template <int PH>
static void set_attr() {
    (void)hipFuncSetAttribute((const void*)k_phase<PH>, hipFuncAttributeMaxDynamicSharedMemorySize, LDS_BYTES);
    if constexpr (PH + 1 < NPHASE) set_attr<PH + 1>();
}

extern "C" void kernel_launch(void* const* d_in, const int* in_sizes, int n_in, void* d_out, int out_size, void* d_ws, size_t ws_size, hipStream_t stream) {
    static int grid = 0;
    if (grid == 0) {
        if (n_in != 20 || out_size != SEQ * DM || ws_size < WS_END) { fprintf(stderr, "kernel_launch: unexpected shapes (n_in %d out %d ws %zu)\n", n_in, out_size, ws_size); grid = -1; return; }
        int dev = 0, cus = 0;
        (void)hipGetDevice(&dev); (void)hipDeviceGetAttribute(&cus, hipDeviceAttributeMultiprocessorCount, dev);
        set_attr<0>();
#if COOP
        (void)hipFuncSetAttribute((const void*)k_all, hipFuncAttributeMaxDynamicSharedMemorySize, LDS_BYTES);
        int per_cu = 0;
        (void)hipOccupancyMaxActiveBlocksPerMultiprocessor(&per_cu, (const void*)k_all, 512, LDS_BYTES);
        if (per_cu < 1) { fprintf(stderr, "kernel_launch: occupancy query says %d blocks/CU\n", per_cu); per_cu = 1; }
#endif
        (void)hipGetLastError();
        grid = cus;
    }
    if (grid < 0) return;
    P p{};
    for (int i = 0; i < 20; ++i) p.in[i] = (const float*)d_in[i];
    p.out = (float*)d_out; p.ws = (unsigned char*)d_ws;
#if COOP
    void* args[] = {&p};
    hipError_t e = hipLaunchCooperativeKernel((const void*)k_all, dim3(grid), dim3(512), args, LDS_BYTES, stream);
    if (e != hipSuccess) fprintf(stderr, "cooperative launch failed: %s (grid %d)\n", hipGetErrorString(e), grid);
#else
    launch_phases<0>(p, grid, stream);
#endif
}
```

```cpp
#include <hip/hip_runtime.h>
#include <hip/hip_cooperative_groups.h>
#include <cstdio>
#include <cstdint>
namespace cg = cooperative_groups;


typedef unsigned short bf16_t;
typedef float f32x4 __attribute__((ext_vector_type(4)));
typedef unsigned u32x2 __attribute__((ext_vector_type(2)));
typedef unsigned u32x4 __attribute__((ext_vector_type(4)));
#define LAS __attribute__((address_space(3)))

constexpr int SEQ = 8192, DM = 2048, INW = 6400, QW = 1024, SSMW = 1024, DFF = 8192;
constexpr int NG = 64, GC = 16, SP = 64, NH = 16;
constexpr size_t MiB = 1u << 20;
constexpr size_t WS_AP = 0, WS_BBAR = 1 * MiB, WS_ROPE = 1 * MiB + 512 * 1024, WS_CTL = 2 * MiB, CTL_BYTES = 16384, WS_PART1 = 3 * MiB, WS_PART2 = 0;
constexpr size_t WS_WUP = 4 * MiB, WS_WDN = 36 * MiB, WS_WIN = 68 * MiB, WS_WGLU = 93 * MiB, WS_WBRA = 97 * MiB, WS_WBRS = 101 * MiB, WS_WOUT = 105 * MiB;
constexpr size_t WS_H = 113 * MiB, WS_OSSM = 113 * MiB  , WS_Q = 145 * MiB, WS_OATT = 145 * MiB  , WS_K = 161 * MiB, WS_VT = 163 * MiB, WS_AX = 165 * MiB, WS_Y = 189 * MiB;
constexpr size_t WS_M = 161 * MiB, WS_GA = 205 * MiB, WS_GS = 237 * MiB, WS_MIXED = 205 * MiB, WS_H2 = 68 * MiB, WS_A = 141 * MiB, WS_DN = 68 * MiB, WS_END = 269 * MiB;
constexpr size_t DO_S = 0, DO_KTAB = 16 * MiB, DO_BC = 17 * MiB, DO_YB = 25 * MiB;
constexpr int NAP = 18;

struct P {
    const float* in[20];
    float* out;
    unsigned char* ws;
    unsigned long long use_cg_sync;
};

__device__ __forceinline__ float bf2f(unsigned v) { return __uint_as_float(v << 16); }
__device__ __forceinline__ unsigned f2bf(float f) { unsigned u = __float_as_uint(f); return (u + 0x7fffu + ((u >> 16) & 1u)) >> 16; }
__device__ __forceinline__ unsigned pk2(float lo, float hi) { return f2bf(lo) | (f2bf(hi) << 16); }
__device__ __forceinline__ float wave_sum(float v) {
#pragma unroll
    for (int o = 1; o < 64; o <<= 1) v += __shfl_xor(v, o);
    return v;
}
__device__ __forceinline__ float wave_max(float v) {
#pragma unroll
    for (int o = 1; o < 64; o <<= 1) v = fmaxf(v, __shfl_xor(v, o));
    return v;
}
__device__ __forceinline__ float sigmoidf_(float v) { return __builtin_amdgcn_rcpf(1.0f + __expf(-v)); }
__device__ __forceinline__ float gelu_tanh(float v) {
    const float z2 = 1.5957691216057308f * (v + 0.044715f * v * v * v);
    return v * __builtin_amdgcn_rcpf(1.0f + __expf(-z2));
}
__device__ __forceinline__ void sincos_d(double ang, float& s, float& c) {
    double rev = ang * 0.15915494309189535; rev -= rint(rev);
    const double q4 = rev * 4.0, qr = rint(q4); const int q = ((int)qr) & 3;
    const double th = (q4 - qr) * 1.5707963267948966, t2 = th * th;
    const double sn = th * (1.0 + t2 * (-1.0 / 6 + t2 * (1.0 / 120 + t2 * (-1.0 / 5040 + t2 * (1.0 / 362880 + t2 * (-1.0 / 39916800 + t2 * (1.0 / 6227020800.0)))))));
    const double cs = 1.0 + t2 * (-0.5 + t2 * (1.0 / 24 + t2 * (-1.0 / 720 + t2 * (1.0 / 40320 + t2 * (-1.0 / 3628800 + t2 * (1.0 / 479001600.0 + t2 * (-1.0 / 87178291200.0)))))));
    const double so = (q == 0) ? sn : (q == 1) ? cs : (q == 2) ? -sn : -cs;
    const double co = (q == 0) ? cs : (q == 1) ? -sn : (q == 2) ? -cs : sn;
    s = (float)so; c = (float)co;
}

__device__ __forceinline__ void transpose_item(const float* W, int N, bf16_t* WT, int ldk, int k0, int n0, int drow0, LAS float* scr, int lane) {
#pragma unroll 8
    for (int i = 0; i < 32; ++i) { const int kk = 2 * i + (lane >> 5); scr[kk * 33 + (lane & 31)] = W[(size_t)(k0 + kk) * N + n0 + (lane & 31)]; }
    asm volatile("s_waitcnt lgkmcnt(0)" ::: "memory");
    const int c = lane & 7;
#pragma unroll
    for (int j = 0; j < 4; ++j) { const int n = (lane >> 3) + 8 * j; const LAS float* s = scr + (8 * c) * 33 + n;
        u32x4 o; o.x = pk2(s[0 * 33], s[1 * 33]); o.y = pk2(s[2 * 33], s[3 * 33]); o.z = pk2(s[4 * 33], s[5 * 33]); o.w = pk2(s[6 * 33], s[7 * 33]);
        *(u32x4*)(WT + (size_t)(drow0 + n) * ldk + k0 + 8 * c) = o; }
    asm volatile("s_waitcnt lgkmcnt(0)" ::: "memory");
}
__device__ __forceinline__ void rms_row_bf16(const float* xrow, const float* gain, bf16_t* orow, int lane) {
    f32x4 v[8]; float s = 0.f;
#pragma unroll
    for (int j = 0; j < 8; ++j) { v[j] = ((const f32x4*)xrow)[64 * j + lane]; s += v[j].x * v[j].x + v[j].y * v[j].y + v[j].z * v[j].z + v[j].w * v[j].w; }
    const float r = rsqrtf(wave_sum(s) * (1.0f / DM) + 1e-6f);
#pragma unroll
    for (int j = 0; j < 8; ++j) { const f32x4 g = ((const f32x4*)gain)[64 * j + lane]; const f32x4 o = v[j] * r * g;
        u32x2 w; w.x = pk2(o.x, o.y); w.y = pk2(o.z, o.w); ((u32x2*)orow)[64 * j + lane] = w; }
}

namespace pg8 {
typedef short bf16x8 __attribute__((ext_vector_type(8)));
constexpr int BM = 256, BK = 64, HALF = 128, HTB = HALF * BK * 2, STAGE_BYTES = 8 * HTB, NXCD = 8, WGM = 8;
__device__ __forceinline__ int lds_byte(int r, int c) { const int st = (r >> 4) * 2 + (c >> 5), rr = r & 15, cc = c & 31, ob = rr * 64 + cc * 2; return st * 1024 + (ob ^ (((ob >> 9) & 1) << 5)); }
__device__ __forceinline__ void stage_rc(int b, int& R, int& C) { const int st = b / 1024, sb = b % 1024, swz = sb ^ (((sb >> 9) & 1) << 5); R = (st >> 1) * 16 + swz / 64; C = (st & 1) * 32 + (swz % 64) / 2; }
__device__ __forceinline__ int perm32(int rho) { const int n = rho >> 4, i = rho & 15; return 8 * (i >> 2) + 4 * n + (i & 3); }

struct Unit { int pm, pn, b; };
struct Gemm { const bf16_t* A; const bf16_t* Bt; int M, N, K, lda, ldb, nb; size_t sA, sB; };

struct Order {
    int nM, nN, nwg, nb, G, c, maxi, base;
    __device__ void init(int M, int N, int nb_, int G_, int c_, int maxi_ = (1 << 30), int base_ = 0) { nM = M / BM; nN = N / BM; nwg = nM * nN; nb = nb_; G = G_; c = c_; maxi = maxi_; base = base_; }
    __device__ bool next(int i, Unit& u) const {
        if (i >= maxi) return false;
        const long L = (long)base + (long)i * G + c; if (L >= (long)nwg * nb) return false;
        u.b = (int)(L / nwg); int wgid = (int)(L % nwg);
        { const int q = nwg / NXCD, r = nwg % NXCD, xcd = wgid % NXCD, off = wgid / NXCD; wgid = (xcd < r ? xcd * (q + 1) : r * (q + 1) + (xcd - r) * q) + off; }
        const int nig = WGM * nN, gid = wgid / nig, fm = gid * WGM, gsz = (nM - fm) < WGM ? (nM - fm) : WGM;
        u.pm = fm + ((wgid % nig) % gsz); u.pn = (wgid % nig) / gsz; return true;
    }
};

template <class Epi>
__device__ __forceinline__ void gemm_phase(LAS unsigned char* lds, const Gemm g, const Order& S, const Epi& E, const int tid) {
    const int wid = __builtin_amdgcn_readfirstlane(tid >> 6), lane = tid & 63, wr = wid >> 2, wc = wid & 3, fr = lane & 15, fq = lane >> 4;
    int K_ = g.K; asm volatile("" : "+s"(K_));
    const int nt = K_ / BK;
    unsigned voffA[2], voffB[2];
#pragma unroll
    for (int i = 0; i < 2; ++i) { int R, C; stage_rc(tid * 16 + i * 8192, R, C); const int Rb = Epi::PERM ? ((R & ~31) + perm32(R & 31)) : R;
        voffA[i] = (unsigned)(R * g.lda + C) * 2u; voffB[i] = (unsigned)(Rb * g.ldb + C) * 2u; }
    const size_t kstep = (size_t)(BK * 2);
    const size_t hstepA = (size_t)HALF * g.lda * 2, tstepA = 2 * hstepA, hstepB = (size_t)HALF * g.ldb * 2, tstepB = 2 * hstepB;
    const unsigned ldsw = (unsigned)wid * 1024u;
    const int aoff = lds_byte(wr * 64 + fr, fq * 8), boff = lds_byte(wc * 32 + fr, fq * 8);
#define PG8_SA(b, h) (((b) * 2 + (h)) * HTB)
#define PG8_SB(b, h) ((4 + (b) * 2 + (h)) * HTB)
#define PG8_STAGE(bufoff, gbase, voff) do { _Pragma("unroll") for (int _i = 0; _i < 2; ++_i) \
        __builtin_amdgcn_global_load_lds((const unsigned*)((const char*)(gbase) + (voff)[_i]), (LAS unsigned*)(lds + (bufoff) + ldsw + _i * 8192), 16, 0, 0); } while (0)
#define PG8_LDA(dst, b, h) do { _Pragma("unroll") for (int m = 0; m < 4; ++m) _Pragma("unroll") for (int k = 0; k < 2; ++k) dst[m][k] = *(const LAS bf16x8*)(lds + PG8_SA(b, h) + aoff + m * 2048 + k * 1024); } while (0)
#define PG8_LDB(dst, b, h) do { _Pragma("unroll") for (int n = 0; n < 2; ++n) _Pragma("unroll") for (int k = 0; k < 2; ++k) dst[n][k] = *(const LAS bf16x8*)(lds + PG8_SB(b, h) + boff + n * 2048 + k * 1024); } while (0)
#define PG8_MMA(ai, bj, At, Bt) do { __builtin_amdgcn_s_setprio(1); _Pragma("unroll") for (int m = 0; m < 4; ++m) _Pragma("unroll") for (int n = 0; n < 2; ++n) _Pragma("unroll") for (int k = 0; k < 2; ++k) \
        acc[ai][bj][m][n] = __builtin_amdgcn_mfma_f32_16x16x32_bf16(Bt[n][k], At[m][k], acc[ai][bj][m][n], 0, 0, 0); __builtin_amdgcn_s_setprio(0); } while (0)
#define PG8_WAIT_V(n) asm volatile("s_waitcnt vmcnt(" #n ")" ::: "memory")
#define PG8_WAIT_L(n) asm volatile("s_waitcnt lgkmcnt(" #n ")" ::: "memory")
#define PG8_BAR __builtin_amdgcn_s_barrier()
#define PG8_SCHED __builtin_amdgcn_sched_barrier(0)
    Unit cur, nxt; int ui = 0;
    if (!S.next(0, cur)) return;
    f32x4 acc[2][2][4][2];
#pragma unroll
    for (int a = 0; a < 2; ++a)
#pragma unroll
        for (int b = 0; b < 2; ++b)
#pragma unroll
            for (int m = 0; m < 4; ++m)
#pragma unroll
                for (int n = 0; n < 2; ++n) acc[a][b][m][n] = (f32x4){0.f, 0.f, 0.f, 0.f};
    bf16x8 At[4][2], B0[2][2], B1[2][2];
    const char* cA = (const char*)g.A + (size_t)cur.b * g.sA * 2 + (size_t)cur.pm * tstepA; const char* cB = (const char*)g.Bt + (size_t)cur.b * g.sB * 2 + (size_t)cur.pn * tstepB;
    PG8_STAGE(PG8_SB(0, 0), cB, voffB); PG8_STAGE(PG8_SB(0, 1), cB + hstepB, voffB); PG8_STAGE(PG8_SA(0, 0), cA, voffA); PG8_STAGE(PG8_SA(0, 1), cA + hstepA, voffA);
    if (wr == 1) PG8_BAR;
    PG8_WAIT_V(2); PG8_BAR;
    PG8_STAGE(PG8_SB(1, 0), cB + kstep, voffB); PG8_STAGE(PG8_SA(1, 0), cA + kstep, voffA); PG8_STAGE(PG8_SB(1, 1), cB + hstepB + kstep, voffB);
    PG8_WAIT_V(6); PG8_BAR;
    for (;;) {
        const bool has_next = S.next(ui + 1, nxt);
        const char* nA = has_next ? (const char*)g.A + (size_t)nxt.b * g.sA * 2 + (size_t)nxt.pm * tstepA : cA;
        const char* nB = has_next ? (const char*)g.Bt + (size_t)nxt.b * g.sB * 2 + (size_t)nxt.pn * tstepB : cB;
        for (int t = 0; t < nt; t += 2) {
            const bool last = (t == nt - 2);
            const char* a1 = cA + (size_t)(t + 1) * kstep;
            const char* a2 = last ? nA : cA + (size_t)(t + 2) * kstep; const char* b2 = last ? nB : cB + (size_t)(t + 2) * kstep;
            const char* a3 = a2 + kstep; const char* b3 = b2 + kstep;
            PG8_LDB(B0, 0, 0); PG8_LDB(B1, 0, 1); PG8_SCHED; PG8_LDA(At, 0, 0); PG8_STAGE(PG8_SA(1, 1), a1 + hstepA, voffA);
            PG8_WAIT_V(8); PG8_WAIT_L(0); PG8_BAR; PG8_MMA(0, 0, At, B0); PG8_MMA(0, 1, At, B1); PG8_BAR; PG8_SCHED;
            PG8_LDA(At, 0, 1); PG8_STAGE(PG8_SB(0, 0), b2, voffB); PG8_STAGE(PG8_SB(0, 1), b2 + hstepB, voffB); PG8_STAGE(PG8_SA(0, 0), a2, voffA);
            PG8_WAIT_V(8); PG8_WAIT_L(0); PG8_BAR; PG8_MMA(1, 0, At, B0); PG8_MMA(1, 1, At, B1); PG8_BAR; PG8_SCHED;
            PG8_LDB(B0, 1, 0); PG8_LDB(B1, 1, 1); PG8_SCHED; PG8_LDA(At, 1, 0); PG8_STAGE(PG8_SA(0, 1), a2 + hstepA, voffA);
            PG8_WAIT_V(8); PG8_WAIT_L(0); PG8_BAR; PG8_MMA(0, 0, At, B0); PG8_MMA(0, 1, At, B1); PG8_BAR; PG8_SCHED;
            PG8_LDA(At, 1, 1); PG8_STAGE(PG8_SB(1, 0), b3, voffB); PG8_STAGE(PG8_SB(1, 1), b3 + hstepB, voffB); PG8_STAGE(PG8_SA(1, 0), a3, voffA);
            PG8_WAIT_V(8); PG8_WAIT_L(0); PG8_BAR; PG8_MMA(1, 0, At, B0); PG8_MMA(1, 1, At, B1); PG8_BAR; PG8_SCHED;
        }
        if (wr == 0) PG8_BAR;
        if constexpr (Epi::FUSED) E.fused(acc, cur, wr, wc, fr, fq); else E(acc, cur, wr, wc, fr, fq);
        if (!has_next) break;
#pragma unroll
        for (int a = 0; a < 2; ++a)
#pragma unroll
            for (int b = 0; b < 2; ++b)
#pragma unroll
                for (int m = 0; m < 4; ++m)
#pragma unroll
                    for (int n = 0; n < 2; ++n) acc[a][b][m][n] = (f32x4){0.f, 0.f, 0.f, 0.f};
        cur = nxt; cA = nA; cB = nB; ++ui;
        if (wr == 1) PG8_BAR;
    }
    PG8_WAIT_V(0);
    PG8_BAR;
#undef PG8_SA
#undef PG8_SB
#undef PG8_STAGE
#undef PG8_LDA
#undef PG8_LDB
#undef PG8_MMA
#undef PG8_WAIT_V
#undef PG8_WAIT_L
#undef PG8_BAR
#undef PG8_SCHED
}
}

#define XB_TMO      128
#define XB_XCNT(j)  (256  + 64 * (j))
#define XB_XSUB(j)  (1280 + 64 * (j))
#define XB_XGEN(j)  (2304 + 64 * (j))
#define XB_TOP      3328
#define XB_TOPGEN   3392
#define XCD_BAR_WORDS 3456
#define XB_SPIN_CAP (1u << 22)
__device__ __forceinline__ unsigned xb_ld(unsigned* p)              { return __hip_atomic_load(p, __ATOMIC_RELAXED, __HIP_MEMORY_SCOPE_AGENT); }
__device__ __forceinline__ unsigned xb_add(unsigned* p, unsigned v) { return __hip_atomic_fetch_add(p, v, __ATOMIC_RELAXED, __HIP_MEMORY_SCOPE_AGENT); }
__device__ __forceinline__ unsigned xb_xcc_id() { return (unsigned)__builtin_amdgcn_s_getreg((3 << 11) | 20) & 0xFu; }
#define XB_SPIN(cond, bar) do { unsigned _sp = 0; while (cond) { __builtin_amdgcn_s_sleep(1); \
    if ((++_sp & 255u) == 0u) { if (xb_ld(&(bar)[XB_TMO])) break; if (_sp > XB_SPIN_CAP) { atomicAdd(&(bar)[XB_TMO], 1u); break; } } } } while (0)
struct XcdBarrier { unsigned* bar; unsigned x; volatile LAS unsigned* st; };
__device__ __forceinline__ XcdBarrier xcd_barrier_post(unsigned* bar, volatile LAS unsigned* st) {
    XcdBarrier b; b.bar = bar; b.x = xb_xcc_id(); b.st = st;
    if (threadIdx.x == 0) (void)xb_add(&bar[XB_XCNT(b.x)], 1u);
    return b;
}
__device__ __forceinline__ void xcd_barrier_complete(unsigned* bar, unsigned x, unsigned& nloc, unsigned& nx) {
    const unsigned G = gridDim.x * gridDim.y * gridDim.z;
    unsigned sum, cnt, mine, sp = 0u;
    for (;;) {
        sum = 0u; cnt = 0u; mine = 0u;
#pragma unroll
        for (unsigned j = 0; j < 16; ++j) { const unsigned c = xb_ld(&bar[XB_XCNT(j)]); sum += c; cnt += (c > 0u) ? 1u : 0u; mine = (j == x) ? c : mine; }
        if (sum == G) break;
        __builtin_amdgcn_s_sleep(1);
        if ((++sp & 255u) == 0u) { if (xb_ld(&bar[XB_TMO])) break; if (sp > XB_SPIN_CAP) { atomicAdd(&bar[XB_TMO], 1u); break; } }
    }
    nloc = mine > 0u ? mine : 1u; nx = cnt > 0u ? cnt : 1u;
}
__device__ __forceinline__ void xcd_barrier(const XcdBarrier& b) {
    asm volatile("s_waitcnt vmcnt(0)" ::: "memory");
    __syncthreads();
    if (threadIdx.x == 0) {
        unsigned* bar = b.bar;
        __builtin_amdgcn_s_waitcnt(0);
        unsigned nloc = b.st[0], nx = b.st[1];
        if (nloc == 0u) { xcd_barrier_complete(bar, b.x, nloc, nx); b.st[0] = nloc; b.st[1] = nx; }
        const unsigned old = xb_add(&bar[XB_XSUB(b.x)], 1u);
        const unsigned gen = old / nloc;
        if (old + 1u == (gen + 1u) * nloc) {
            __builtin_amdgcn_fence(__ATOMIC_RELEASE, "agent");
            asm volatile("s_waitcnt vmcnt(0)" ::: "memory");
            const unsigned og = xb_add(&bar[XB_TOP], 1u);
            const unsigned tg = og / nx;
            if (og + 1u == (tg + 1u) * nx) xb_add(&bar[XB_TOPGEN], 1u);
            else XB_SPIN(xb_ld(&bar[XB_TOPGEN]) == tg, bar);
            __builtin_amdgcn_fence(__ATOMIC_ACQUIRE, "agent");
            xb_add(&bar[XB_XGEN(b.x)], 1u);
            asm volatile("s_waitcnt vmcnt(0)" ::: "memory");
        } else {
            XB_SPIN(xb_ld(&bar[XB_XGEN(b.x)]) == gen, bar);
            __builtin_amdgcn_fence(__ATOMIC_ACQUIRE, "agent");
            asm volatile("s_waitcnt vmcnt(0)" ::: "memory");
        }
    }
    __syncthreads();
}

typedef f32x4 acc_t[2][2][4][2];
#define EPI_ROW(ai, m) (u.pm * 256 + (ai) * 128 + wr * 64 + (m) * 16 + fr)
__device__ __forceinline__ u32x4 pack8(const f32x4 a, const f32x4 b) { u32x4 w; w.x = pk2(a.x, a.y); w.y = pk2(a.z, a.w); w.z = pk2(b.x, b.y); w.w = pk2(b.z, b.w); return w; }
__device__ __forceinline__ f32x4 sig4(const f32x4 v) { f32x4 o; o.x = sigmoidf_(v.x); o.y = sigmoidf_(v.y); o.z = sigmoidf_(v.z); o.w = sigmoidf_(v.w); return o; }

struct EpiZf {
    static constexpr bool PERM = true, FUSED = false;
    bf16_t *q, *k, *vT, *ax, *ga, *gs; const float* rope;
    __device__ __forceinline__ void operator()(const acc_t& acc, const pg8::Unit& u, int wr, int wc, int fr, int fq) const {
        const int pn = u.pn;
#pragma unroll
        for (int ai = 0; ai < 2; ++ai)
#pragma unroll
            for (int m = 0; m < 4; ++m) {
                const int row = EPI_ROW(ai, m);
#pragma unroll
                for (int bj = 0; bj < 2; ++bj) {
                    f32x4 v0 = acc[ai][bj][m][0], v1 = acc[ai][bj][m][1];
                    const int cl = bj * 128 + wc * 32 + 8 * fq;
                    if (pn < 4 || (pn == 4 && bj == 0)) {
                        if ((wc & 1) == 0) {
                            f32x4 p0, p1;
                            p0.x = __shfl_xor(v0.x, 16); p0.y = __shfl_xor(v0.y, 16); p0.z = __shfl_xor(v0.z, 16); p0.w = __shfl_xor(v0.w, 16);
                            p1.x = __shfl_xor(v1.x, 16); p1.y = __shfl_xor(v1.y, 16); p1.z = __shfl_xor(v1.z, 16); p1.w = __shfl_xor(v1.w, 16);
                            if (fq < 2) {
                                const f32x4* rp = (const f32x4*)(rope + (size_t)row * 16);
                                const f32x4 r0 = rp[0], r1 = rp[1], r2 = rp[2], r3 = rp[3];
                                const float sg = (fq == 0) ? -1.f : 1.f;
                                v0.x = v0.x * r0.x + sg * p0.x * r0.y; v0.y = v0.y * r0.z + sg * p0.y * r0.w;
                                v0.z = v0.z * r1.x + sg * p0.z * r1.y; v0.w = v0.w * r1.z + sg * p0.w * r1.w;
                                v1.x = v1.x * r2.x + sg * p1.x * r2.y; v1.y = v1.y * r2.z + sg * p1.y * r2.w;
                                v1.z = v1.z * r3.x + sg * p1.z * r3.y; v1.w = v1.w * r3.z + sg * p1.w * r3.w;
                            }
                        }
                        bf16_t* dst = (pn < 4) ? (q + (size_t)row * 1024 + pn * 256 + cl) : (k + (size_t)row * 128 + cl);
                        *(u32x4*)dst = pack8(v0, v1);
                    } else if (pn == 4) {
                        bf16_t* dst = vT + (size_t)(cl - 128) * SEQ + row;
                        dst[0 * (size_t)SEQ] = (bf16_t)f2bf(v0.x); dst[1 * (size_t)SEQ] = (bf16_t)f2bf(v0.y); dst[2 * (size_t)SEQ] = (bf16_t)f2bf(v0.z); dst[3 * (size_t)SEQ] = (bf16_t)f2bf(v0.w);
                        dst[4 * (size_t)SEQ] = (bf16_t)f2bf(v1.x); dst[5 * (size_t)SEQ] = (bf16_t)f2bf(v1.y); dst[6 * (size_t)SEQ] = (bf16_t)f2bf(v1.z); dst[7 * (size_t)SEQ] = (bf16_t)f2bf(v1.w);
                    } else if (pn < 9) {
                        const int c = (pn - 5) * 256 + cl, g = c >> 4, ci0 = c & 15;
                        *(u32x4*)(ax + ((size_t)g * 512 + (row >> 4)) * 384 + (row & 15) * 16 + ci0) = pack8(v0, v1);
                    } else if (pn < 17) {
                        *(u32x4*)(ga + (size_t)row * 2048 + (pn - 9) * 256 + cl) = pack8(sig4(v0), sig4(v1));
                    } else {
                        *(u32x4*)(gs + (size_t)row * 2048 + (pn - 17) * 256 + cl) = pack8(sig4(v0), sig4(v1));
                    }
                }
            }
    }
};
struct EpiSf {
    static constexpr bool PERM = false, FUSED = false; float* S;
    __device__ __forceinline__ void operator()(const acc_t& acc, const pg8::Unit& u, int wr, int wc, int fr, int fq) const {
#pragma unroll
        for (int ai = 0; ai < 2; ++ai)
#pragma unroll
            for (int m = 0; m < 4; ++m) { const int row = EPI_ROW(ai, m);
#pragma unroll
                for (int n = 0; n < 2; ++n) *(f32x4*)(S + ((size_t)u.b * 512 + row) * 128 + wc * 32 + 16 * n + 4 * fq) = acc[ai][0][m][n]; }
    }
};
struct EpiYf {
    static constexpr bool PERM = true, FUSED = false; bf16_t* y;
    __device__ __forceinline__ void operator()(const acc_t& acc, const pg8::Unit& u, int wr, int wc, int fr, int fq) const {
#pragma unroll
        for (int ai = 0; ai < 2; ++ai)
#pragma unroll
            for (int m = 0; m < 4; ++m) { const int row = EPI_ROW(ai, m);
#pragma unroll
                for (int bj = 0; bj < 2; ++bj) { const int c = bj * 128 + wc * 32 + 8 * fq, t = c >> 4, co0 = c & 15;
                    bf16_t* dst = y + (size_t)(row * 16 + t) * 1024 + u.b * 16 + co0;
#pragma unroll
                    for (int n = 0; n < 2; ++n) { const f32x4 v = acc[ai][bj][m][n];
                        u32x2 w; w.x = pk2(gelu_tanh(v.x), gelu_tanh(v.y)); w.y = pk2(gelu_tanh(v.z), gelu_tanh(v.w)); *(u32x2*)(dst + 4 * n) = w;
                        asm volatile("" ::: "memory"); } } }
    }
};
struct EpiGLUf {
    static constexpr bool PERM = true, FUSED = false; bf16_t* o;
    __device__ __forceinline__ void operator()(const acc_t& acc, const pg8::Unit& u, int wr, int wc, int fr, int fq) const {
#pragma unroll
        for (int ai = 0; ai < 2; ++ai)
#pragma unroll
            for (int m = 0; m < 4; ++m) { const int row = EPI_ROW(ai, m);
                const f32x4 v0 = acc[ai][0][m][0] * sig4(acc[ai][1][m][0]), v1 = acc[ai][0][m][1] * sig4(acc[ai][1][m][1]);
                *(u32x4*)(o + (size_t)row * 1024 + u.pn * 128 + wc * 32 + 8 * fq) = pack8(v0, v1); }
    }
};
__device__ __forceinline__ f32x4 ld_bf4(const bf16_t* p) { const u32x2 w = *(const u32x2*)p; f32x4 o; o.x = bf2f(w.x & 0xffffu); o.y = bf2f(w.x >> 16); o.z = bf2f(w.y & 0xffffu); o.w = bf2f(w.y >> 16); return o; }
__device__ __forceinline__ void ld_bf8(const bf16_t* p, f32x4& lo, f32x4& hi) { const u32x4 w = *(const u32x4*)p;
    lo.x = bf2f(w.x & 0xffffu); lo.y = bf2f(w.x >> 16); lo.z = bf2f(w.y & 0xffffu); lo.w = bf2f(w.y >> 16); hi.x = bf2f(w.z & 0xffffu); hi.y = bf2f(w.z >> 16); hi.z = bf2f(w.w & 0xffffu); hi.w = bf2f(w.w >> 16); }
struct EpiT1f {
    static constexpr bool PERM = true, FUSED = false; f32x4* t1; const bf16_t* ga; int tid;
    __device__ __forceinline__ void operator()(const acc_t& acc, const pg8::Unit& u, int wr, int wc, int fr, int fq) const {
        f32x4* base = t1 + (size_t)(u.pm * 8 + u.pn) * 32 * 512 + tid;
#pragma unroll
        for (int ai = 0; ai < 2; ++ai)
#pragma unroll
            for (int m = 0; m < 4; ++m) { const int row = EPI_ROW(ai, m);
#pragma unroll
                for (int bj = 0; bj < 2; ++bj) { const int col = u.pn * 256 + bj * 128 + wc * 32 + 8 * fq; f32x4 g0, g1; ld_bf8(ga + (size_t)row * 2048 + col, g0, g1);
                    base[(((ai * 2 + bj) * 4 + m) * 2 + 0) * 512] = g0 * acc[ai][bj][m][0]; base[(((ai * 2 + bj) * 4 + m) * 2 + 1) * 512] = g1 * acc[ai][bj][m][1]; } }
    }
};
struct EpiMf {
    static constexpr bool PERM = true, FUSED = false; const f32x4* t1; const bf16_t* gs; bf16_t* mo; int tid;
    __device__ __forceinline__ void operator()(const acc_t& acc, const pg8::Unit& u, int wr, int wc, int fr, int fq) const {
        const f32x4* base = t1 + (size_t)(u.pm * 8 + u.pn) * 32 * 512 + tid;
#pragma unroll
        for (int ai = 0; ai < 2; ++ai)
#pragma unroll
            for (int m = 0; m < 4; ++m) { const int row = EPI_ROW(ai, m);
#pragma unroll
                for (int bj = 0; bj < 2; ++bj) { const int col = u.pn * 256 + bj * 128 + wc * 32 + 8 * fq; f32x4 g0, g1; ld_bf8(gs + (size_t)row * 2048 + col, g0, g1);
                    const f32x4 v0 = base[(((ai * 2 + bj) * 4 + m) * 2 + 0) * 512] + g0 * acc[ai][bj][m][0], v1 = base[(((ai * 2 + bj) * 4 + m) * 2 + 1) * 512] + g1 * acc[ai][bj][m][1];
                    *(u32x4*)(mo + (size_t)row * 2048 + col) = pack8(v0, v1); } }
    }
};
struct EpiF32f {
    static constexpr bool PERM = false, FUSED = false; float* o;
    __device__ __forceinline__ void operator()(const acc_t& acc, const pg8::Unit& u, int wr, int wc, int fr, int fq) const {
#pragma unroll
        for (int ai = 0; ai < 2; ++ai)
#pragma unroll
            for (int m = 0; m < 4; ++m) { const int row = EPI_ROW(ai, m);
#pragma unroll
                for (int bj = 0; bj < 2; ++bj)
#pragma unroll
                    for (int n = 0; n < 2; ++n) *(f32x4*)(o + (size_t)row * 2048 + u.pn * 256 + bj * 128 + wc * 32 + 16 * n + 4 * fq) = acc[ai][bj][m][n]; }
    }
};
struct EpiUpf {
    static constexpr bool PERM = true, FUSED = false; bf16_t* a;
    __device__ __forceinline__ void operator()(const acc_t& acc, const pg8::Unit& u, int wr, int wc, int fr, int fq) const {
#pragma unroll
        for (int ai = 0; ai < 2; ++ai)
#pragma unroll
            for (int m = 0; m < 4; ++m) { const int row = EPI_ROW(ai, m);
#pragma unroll
                for (int bj = 0; bj < 2; ++bj) {
                    f32x4 v0 = acc[ai][bj][m][0], v1 = acc[ai][bj][m][1];
                    v0.x = fmaxf(v0.x, 0.f); v0.y = fmaxf(v0.y, 0.f); v0.z = fmaxf(v0.z, 0.f); v0.w = fmaxf(v0.w, 0.f);
                    v1.x = fmaxf(v1.x, 0.f); v1.y = fmaxf(v1.y, 0.f); v1.z = fmaxf(v1.z, 0.f); v1.w = fmaxf(v1.w, 0.f);
                    *(u32x4*)(a + (size_t)row * DFF + u.pn * 256 + bj * 128 + wc * 32 + 8 * fq) = pack8(v0 * v0, v1 * v1); } }
    }
};


__device__ __forceinline__ void row_partials(const acc_t& acc, float* part, const pg8::Unit& u, int wr, int wc, int fr, int fq) {
#pragma unroll
    for (int ai = 0; ai < 2; ++ai)
#pragma unroll
        for (int m = 0; m < 4; ++m) {
            float s = 0.f;
#pragma unroll
            for (int bj = 0; bj < 2; ++bj)
#pragma unroll
                for (int n = 0; n < 2; ++n) { const f32x4 v = acc[ai][bj][m][n]; s += (v.x * v.x + v.y * v.y) + (v.z * v.z + v.w * v.w); }
            s += __shfl_xor(s, 16); s += __shfl_xor(s, 32);
            if (fq == 0) part[(size_t)EPI_ROW(ai, m) * 32 + u.pn * 4 + wc] = s;
        }
}
__device__ __forceinline__ void row_rinv(const float* part, float (&rinv)[2][4], const pg8::Unit& u, int wr, int fr, int fq) {
#pragma unroll
    for (int ai = 0; ai < 2; ++ai)
#pragma unroll
        for (int m = 0; m < 4; ++m) {
            const f32x4* pp = (const f32x4*)(part + (size_t)EPI_ROW(ai, m) * 32 + fq * 8);
            const f32x4 a = pp[0], b = pp[1];
            float s = ((a.x + a.y) + (a.z + a.w)) + ((b.x + b.y) + (b.z + b.w));
            s += __shfl_xor(s, 16); s += __shfl_xor(s, 32);
            rinv[ai][m] = rsqrtf(s * (1.0f / DM) + 1e-6f);
        }
}
struct EpiOutNormF {
    static constexpr bool PERM = true, FUSED = true;
    const float* x; const float* g1; const float* g2; float* x1; bf16_t* h2; float* part1; float* part2; XcdBarrier xb;
    __device__ __forceinline__ void fused(acc_t& acc, const pg8::Unit& u, int wr, int wc, int fr, int fq) const {
        float rinv[2][4];
        row_partials(acc, part1, u, wr, wc, fr, fq);
        xcd_barrier(xb);
        row_rinv(part1, rinv, u, wr, fr, fq);
#pragma unroll
        for (int bj = 0; bj < 2; ++bj)
#pragma unroll
            for (int n = 0; n < 2; ++n) { const int col = u.pn * 256 + bj * 128 + wc * 32 + 8 * fq + 4 * n; const f32x4 gv = *(const f32x4*)(g1 + col);
#pragma unroll
                for (int ai = 0; ai < 2; ++ai)
#pragma unroll
                    for (int m = 0; m < 4; ++m) { const f32x4 xv = *(const f32x4*)(x + (size_t)EPI_ROW(ai, m) * DM + col); acc[ai][bj][m][n] = xv + acc[ai][bj][m][n] * rinv[ai][m] * gv;
                        asm volatile("" : "+v"(acc[ai][bj][m][n])); }
                asm volatile("" ::: "memory"); }
        row_partials(acc, part2, u, wr, wc, fr, fq);
        xcd_barrier(xb);
        row_rinv(part2, rinv, u, wr, fr, fq);
#pragma unroll
        for (int bj = 0; bj < 2; ++bj)
#pragma unroll
            for (int n = 0; n < 2; ++n) { const int col = u.pn * 256 + bj * 128 + wc * 32 + 8 * fq + 4 * n; const f32x4 gv = *(const f32x4*)(g2 + col);
#pragma unroll
                for (int ai = 0; ai < 2; ++ai)
#pragma unroll
                    for (int m = 0; m < 4; ++m) { const size_t o = (size_t)EPI_ROW(ai, m) * DM + col; const f32x4 v = acc[ai][bj][m][n];
                        *(f32x4*)(x1 + o) = v; const f32x4 hv = v * rinv[ai][m] * gv; u32x2 w; w.x = pk2(hv.x, hv.y); w.y = pk2(hv.z, hv.w); *(u32x2*)(h2 + o) = w; } }
    }
};
struct EpiDownNormF {
    static constexpr bool PERM = true, FUSED = true;
    const float* g; float* x1; float* part; XcdBarrier xb;
    __device__ __forceinline__ void fused(acc_t& acc, const pg8::Unit& u, int wr, int wc, int fr, int fq) const {
        float rinv[2][4];
        row_partials(acc, part, u, wr, wc, fr, fq);
        xcd_barrier(xb);
        row_rinv(part, rinv, u, wr, fr, fq);
#pragma unroll
        for (int bj = 0; bj < 2; ++bj)
#pragma unroll
            for (int n = 0; n < 2; ++n) { const int col = u.pn * 256 + bj * 128 + wc * 32 + 8 * fq + 4 * n; const f32x4 gv = *(const f32x4*)(g + col);
#pragma unroll
                for (int ai = 0; ai < 2; ++ai)
#pragma unroll
                    for (int m = 0; m < 4; ++m) { float* o = x1 + (size_t)EPI_ROW(ai, m) * DM + col; *(f32x4*)o = *(const f32x4*)o + acc[ai][bj][m][n] * rinv[ai][m] * gv; } }
    }
};

typedef float f32x16 __attribute__((ext_vector_type(16)));
typedef short s16x8 __attribute__((ext_vector_type(8)));
__device__ __forceinline__ void attn_item(const bf16_t* Q, const bf16_t* Kb, const bf16_t* VT, bf16_t* O, const float sink, const int qt, const int h, const int lane) {
    const int r = lane & 31, hf = lane >> 5, q0 = qt * 32, hk = h >> 3;
    s16x8 qf[4];
#pragma unroll
    for (int kk = 0; kk < 4; ++kk) qf[kk] = *(const s16x8*)(Q + (size_t)(q0 + r) * 1024 + h * 64 + 16 * kk + 8 * hf);
    f32x16 st[5];
#pragma unroll
    for (int kt = 0; kt < 5; ++kt) {
        int key = q0 - 128 + 32 * kt + r; key = key < 0 ? 0 : key;
        f32x16 a = {0.f, 0.f, 0.f, 0.f, 0.f, 0.f, 0.f, 0.f, 0.f, 0.f, 0.f, 0.f, 0.f, 0.f, 0.f, 0.f};
#pragma unroll
        for (int kk = 0; kk < 4; ++kk) {
            const s16x8 kf = *(const s16x8*)(Kb + (size_t)key * 128 + hk * 64 + 16 * kk + 8 * hf);
            a = __builtin_amdgcn_mfma_f32_32x32x16_bf16(kf, qf[kk], a, 0, 0, 0);
        }
        st[kt] = a;
    }
    float mx = sink;
#pragma unroll
    for (int kt = 0; kt < 5; ++kt)
#pragma unroll
        for (int e = 0; e < 16; ++e) {
            const int kofs = -128 + 32 * kt + (e & 3) + 8 * (e >> 2) + 4 * hf;
            const int diff = r - kofs;
            const bool ok = (diff >= 0) && (diff < 128) && (q0 + kofs >= 0);
            const float s = ok ? st[kt][e] * 0.125f : -1e30f;
            st[kt][e] = s; mx = fmaxf(mx, s);
        }
    mx = fmaxf(mx, __shfl_xor(mx, 32));
    float sum = 0.f;
#pragma unroll
    for (int kt = 0; kt < 5; ++kt)
#pragma unroll
        for (int e = 0; e < 16; ++e) { const float pv = (st[kt][e] > -1e29f) ? __expf(st[kt][e] - mx) : 0.f; st[kt][e] = pv; sum += pv; }
    sum += __shfl_xor(sum, 32);
    sum += __expf(sink - mx);
    const float inv = 1.0f / sum;
    f32x16 o0 = {0.f, 0.f, 0.f, 0.f, 0.f, 0.f, 0.f, 0.f, 0.f, 0.f, 0.f, 0.f, 0.f, 0.f, 0.f, 0.f}, o1 = o0;
#pragma unroll
    for (int kt = 0; kt < 5; ++kt)
#pragma unroll
        for (int s = 0; s < 2; ++s) {
            u32x4 pw; pw.x = pk2(st[kt][8 * s + 0], st[kt][8 * s + 1]); pw.y = pk2(st[kt][8 * s + 2], st[kt][8 * s + 3]);
            pw.z = pk2(st[kt][8 * s + 4], st[kt][8 * s + 5]); pw.w = pk2(st[kt][8 * s + 6], st[kt][8 * s + 7]);
            const s16x8 pf = __builtin_bit_cast(s16x8, pw);
            int kb = q0 - 128 + 32 * kt + 16 * s + 4 * hf; const int kb0 = kb < 0 ? 0 : kb, kb1 = (kb + 8) < 0 ? 0 : (kb + 8);
#pragma unroll
            for (int dt = 0; dt < 2; ++dt) {
                const bf16_t* vp = VT + (size_t)(hk * 64 + 32 * dt + r) * SEQ;
                const u32x2 a0 = *(const u32x2*)(vp + kb0), a1 = *(const u32x2*)(vp + kb1);
                u32x4 vw; vw.x = a0.x; vw.y = a0.y; vw.z = a1.x; vw.w = a1.y;
                const s16x8 vf = __builtin_bit_cast(s16x8, vw);
                if (dt == 0) o0 = __builtin_amdgcn_mfma_f32_32x32x16_bf16(vf, pf, o0, 0, 0, 0);
                else o1 = __builtin_amdgcn_mfma_f32_32x32x16_bf16(vf, pf, o1, 0, 0, 0);
            }
        }
    bf16_t* op = O + (size_t)(q0 + r) * 1024 + h * 64 + 4 * hf;
#pragma unroll
    for (int i = 0; i < 4; ++i) {
        u32x2 w; w.x = pk2(o0[4 * i] * inv, o0[4 * i + 1] * inv); w.y = pk2(o0[4 * i + 2] * inv, o0[4 * i + 3] * inv); *(u32x2*)(op + 8 * i) = w;
        u32x2 w1; w1.x = pk2(o1[4 * i] * inv, o1[4 * i + 1] * inv); w1.y = pk2(o1[4 * i + 2] * inv, o1[4 * i + 3] * inv); *(u32x2*)(op + 32 + 8 * i) = w1;
    }
}


constexpr int NPHASE = 10;

#ifndef PROBE_PH
#define PROBE_PH -1
#endif
template <int PH, int REP = 1>
__device__ __forceinline__ void run_phase(const P& p, LAS unsigned char* lds, const XcdBarrier& xb) {
    int tid_ = threadIdx.x; asm volatile("" : "+v"(tid_));
    const int tid = tid_, lane = tid & 63, wave = tid >> 6;
    int bid_ = blockIdx.x; asm volatile("" : "+s"(bid_));
    const int bid = bid_;
    const int G = gridDim.x, gw = bid * 8 + wave, NGW = G * 8;
    const size_t gt = (size_t)bid * 512 + tid, NGT = (size_t)G * 512;
    unsigned char* ws = p.ws; unsigned char* dout = (unsigned char*)p.out;
    asm volatile("" : "+s"(ws), "+s"(dout));
    float* PART1 = (float*)(ws + WS_PART1); float* PART2 = (float*)(ws + WS_PART2);
    float2* AP = (float2*)(ws + WS_AP); float2* BBAR = (float2*)(ws + WS_BBAR); float2* ROPE = (float2*)(ws + WS_ROPE);
    bf16_t* WUP = (bf16_t*)(ws + WS_WUP); bf16_t* WDN = (bf16_t*)(ws + WS_WDN); bf16_t* WIN = (bf16_t*)(ws + WS_WIN); bf16_t* WGLU = (bf16_t*)(ws + WS_WGLU);
    bf16_t* WBRA = (bf16_t*)(ws + WS_WBRA); bf16_t* WBRS = (bf16_t*)(ws + WS_WBRS); bf16_t* WOUT = (bf16_t*)(ws + WS_WOUT);
    bf16_t* H = (bf16_t*)(ws + WS_H); bf16_t* OATT = (bf16_t*)(ws + WS_OATT); bf16_t* Q = (bf16_t*)(ws + WS_Q); bf16_t* OSSM = (bf16_t*)(ws + WS_OSSM);
    bf16_t* Kb = (bf16_t*)(ws + WS_K); bf16_t* VT = (bf16_t*)(ws + WS_VT); bf16_t* AX = (bf16_t*)(ws + WS_AX); bf16_t* Y = (bf16_t*)(ws + WS_Y);
    bf16_t* Mb = (bf16_t*)(ws + WS_M); bf16_t* GA = (bf16_t*)(ws + WS_GA); bf16_t* GS = (bf16_t*)(ws + WS_GS); float* MIXED = (float*)(ws + WS_MIXED);
    bf16_t* H2 = (bf16_t*)(ws + WS_H2); bf16_t* Ab = (bf16_t*)(ws + WS_A); float* DN = (float*)(ws + WS_DN);
    float* S = (float*)(dout + DO_S); float* KTAB = (float*)(dout + DO_KTAB); bf16_t* BC = (bf16_t*)(dout + DO_BC); bf16_t* YB = (bf16_t*)(dout + DO_YB);
    float* T1 = (float*)dout; float* X1 = (float*)dout;
    const float* x = p.in[0];

    if constexpr (PH == 0) {
        LAS float* scr = (LAS float*)(lds + wave * 16384);
        constexpr int I_IN = 32 * 200, I_GLU = 16 * 64, I_BR = 16 * 64, I_OUT = 32 * 64, I_UP = 32 * 256, I_DN = 128 * 64;
        constexpr int NIT = I_IN + I_GLU + 2 * I_BR + I_OUT;
        for (int it = gw; it < NIT; it += NGW) {
            int r = it;
            if (r < I_IN) { const int nb = r % 200, kb = r / 200; transpose_item(p.in[5], INW, WIN, 2048, 64 * kb, 32 * nb, 32 * nb, scr, lane); continue; } r -= I_IN;
            if (r < I_GLU) { const int nb = r % 64, kb = r / 64, n0 = 32 * nb, bj = n0 >> 10, j = n0 & 1023, t = j >> 7, jj = j & 127;
                transpose_item(p.in[15], 2048, WGLU, 1024, 64 * kb, n0, 256 * t + 128 * bj + jj, scr, lane); continue; } r -= I_GLU;
            if (r < I_BR) { const int nb = r % 64, kb = r / 64; transpose_item(p.in[16], 2048, WBRA, 1024, 64 * kb, 32 * nb, 32 * nb, scr, lane); continue; } r -= I_BR;
            if (r < I_BR) { const int nb = r % 64, kb = r / 64; transpose_item(p.in[16] + (size_t)1024 * 2048, 2048, WBRS, 1024, 64 * kb, 32 * nb, 32 * nb, scr, lane); continue; } r -= I_BR;
            { const int nb = r % 64, kb = r / 64; transpose_item(p.in[17], 2048, WOUT, 2048, 64 * kb, 32 * nb, 32 * nb, scr, lane); }
        }
        for (int m = gw; m < SEQ; m += NGW) rms_row_bf16(x + (size_t)m * DM, p.in[1], H + (size_t)m * DM, lane);
        for (size_t i = gt; i < (size_t)NG * SP; i += NGT) {
            const int g = (int)i / SP;
            const double dt = exp((double)p.in[9][g]), lr = (double)p.in[7][i], li = (double)p.in[8][i];
            for (int n = 0; n < NAP; ++n) {
                const double pw = (n == 17) ? 1024.0 : (double)n;
                const float mag = (float)exp(pw * lr * dt); float s, c; sincos_d(pw * li * dt, s, c);
                AP[((size_t)g * NAP + n) * SP + ((int)i % SP)] = make_float2(mag * c, mag * s);
            }
            float s1, c1; sincos_d(li * dt, s1, c1);
            const double mag1 = exp(lr * dt), are = mag1 * (double)c1, aim = mag1 * (double)s1;
            const double nr = are - 1.0, ni = aim, den = lr * lr + li * li;
            const double cre = (nr * lr + ni * li) / den, cim = (ni * lr - nr * li) / den;
            for (int c = 0; c < GC; ++c) {
                const double br = (double)p.in[10][i * GC + c], bi = (double)p.in[11][i * GC + c];
                BBAR[i * GC + c] = make_float2((float)(cre * br - cim * bi), (float)(cre * bi + cim * br));
            }
        }
        for (size_t i = gt; i < (size_t)SEQ * 8; i += NGT) {
            const int pos = (int)(i >> 3), k = (int)(i & 7);
            const double inv = exp(-(double)k * 0.125 * 13.122363377404328);
            float s, c; sincos_d((double)pos * inv, s, c);
            ROPE[i] = make_float2(c, s);
        }
        }
    if constexpr (PH == 1) {
        { pg8::Gemm g{H, WIN, SEQ, INW, DM, DM, DM, 1, 0, 0}; pg8::Order S; S.init(SEQ, INW, 1, G, bid, 3);
          EpiZf E{Q, Kb, VT, AX, GA, GS, (const float*)ROPE}; pg8::gemm_phase(lds, g, S, E, tid); }
        for (size_t e = gt; e < (size_t)NG * 256 * 32; e += NGT) {
            const int g = (int)(e >> 13), r = (int)(e >> 5) & 255, k8 = (int)e & 31, s_ = k8 >> 1, ci0 = (k8 & 1) * 8;
            u32x4 w = {0u, 0u, 0u, 0u};
            if (r < 128) { const int pp = r & 63; const float2 a = AP[((size_t)g * NAP + 15 - s_) * SP + pp];
                const f32x4* bp = (const f32x4*)(BBAR + ((size_t)g * SP + pp) * GC + ci0); const f32x4 b0 = bp[0], b1 = bp[1], b2 = bp[2], b3 = bp[3];
                if (r >> 6) { w.x = pk2(a.x * b0.y + a.y * b0.x, a.x * b0.w + a.y * b0.z); w.y = pk2(a.x * b1.y + a.y * b1.x, a.x * b1.w + a.y * b1.z);
                              w.z = pk2(a.x * b2.y + a.y * b2.x, a.x * b2.w + a.y * b2.z); w.w = pk2(a.x * b3.y + a.y * b3.x, a.x * b3.w + a.y * b3.z); }
                else {        w.x = pk2(a.x * b0.x - a.y * b0.y, a.x * b0.z - a.y * b0.w); w.y = pk2(a.x * b1.x - a.y * b1.y, a.x * b1.z - a.y * b1.w);
                              w.z = pk2(a.x * b2.x - a.y * b2.y, a.x * b2.z - a.y * b2.w); w.w = pk2(a.x * b3.x - a.y * b3.y, a.x * b3.z - a.y * b3.w); } }
            *(u32x4*)(BC + e * 8) = w;
        }
        for (size_t e = gt; e < (size_t)NG * 256 * 16; e += NGT) {
            const int g = (int)(e >> 12), row = (int)(e >> 4) & 255, r0 = ((int)e & 15) * 8, t = row >> 4, co = row & 15, pp0 = r0 & 63;
            const f32x4* ap = (const f32x4*)(AP + ((size_t)g * NAP + t + 1) * SP + pp0); const f32x4 a0 = ap[0], a1 = ap[1], a2 = ap[2], a3 = ap[3];
            const f32x4* crp = (const f32x4*)(p.in[12] + ((size_t)g * GC + co) * SP + pp0); const f32x4* cip = (const f32x4*)(p.in[13] + ((size_t)g * GC + co) * SP + pp0);
            const f32x4 cr0 = crp[0], cr1 = crp[1], ci0 = cip[0], ci1 = cip[1];
            u32x4 w;
            if (r0 >> 6) { w.x = pk2(-(cr0.x * a0.y + ci0.x * a0.x), -(cr0.y * a0.w + ci0.y * a0.z)); w.y = pk2(-(cr0.z * a1.y + ci0.z * a1.x), -(cr0.w * a1.w + ci0.w * a1.z));
                           w.z = pk2(-(cr1.x * a2.y + ci1.x * a2.x), -(cr1.y * a2.w + ci1.y * a2.z)); w.w = pk2(-(cr1.z * a3.y + ci1.z * a3.x), -(cr1.w * a3.w + ci1.w * a3.z)); }
            else {         w.x = pk2(cr0.x * a0.x - ci0.x * a0.y, cr0.y * a0.z - ci0.y * a0.w); w.y = pk2(cr0.z * a1.x - ci0.z * a1.y, cr0.w * a1.z - ci0.w * a1.w);
                           w.z = pk2(cr1.x * a2.x - ci1.x * a2.y, cr1.y * a2.z - ci1.y * a2.w); w.w = pk2(cr1.z * a3.x - ci1.z * a3.y, cr1.w * a3.z - ci1.w * a3.w); }
            *(u32x4*)(YB + ((size_t)g * 256 + row) * 384 + 256 + r0) = w;
        }
        {
            LAS float* Cre = (LAS float*)lds; LAS float* Cim = Cre + 16 * 65; LAS float* APr = Cim + 16 * 65; LAS float* APi = APr + 256; LAS float* Bbr = APi + 256; LAS float* Bbi = Bbr + 1024;
            for (int item = bid; item < NG * 4; item += G) {
                const int g = item >> 2, tq = item & 3;
                __syncthreads();
                for (int i = tid; i < 1024; i += 512) { Cre[(i >> 6) * 65 + (i & 63)] = p.in[12][(size_t)g * 1024 + i]; Cim[(i >> 6) * 65 + (i & 63)] = p.in[13][(size_t)g * 1024 + i];
                    const float2 b = BBAR[(size_t)g * 1024 + i]; Bbr[i] = b.x; Bbi[i] = b.y; }
                if (tid < 256) { const float2 a = AP[((size_t)g * NAP + 4 * tq + (tid >> 6)) * SP + (tid & 63)]; APr[tid] = a.x; APi[tid] = a.y; }
                __syncthreads();
#pragma unroll
                for (int rr = 0; rr < 2; ++rr) {
                    const int idx = tid + 512 * rr, tl = idx >> 8, co = (idx >> 4) & 15, ci = idx & 15;
                    float acc = 0.f;
#pragma unroll 8
                    for (int pp = 0; pp < SP; ++pp) {
                        const float cr = Cre[co * 65 + pp], cim = Cim[co * 65 + pp], ax = APr[tl * 64 + pp], ay = APi[tl * 64 + pp];
                        const float wre = cr * ax - cim * ay, wim = cr * ay + cim * ax;
                        acc += wre * Bbr[pp * 16 + ci] - wim * Bbi[pp * 16 + ci];
                    }
                    const int tau = 4 * tq + tl;
                    if (tau == 0 && co == ci) acc += p.in[14][g * GC + co];
                    KTAB[(((size_t)g * 16 + tau) * 16 + co) * 16 + ci] = acc;
                }
            }
            __syncthreads();
        }
        }
    if constexpr (PH == 2) {
        { pg8::Gemm g{AX, BC, 512, 256, 256, 384, 256, NG, (size_t)512 * 384, (size_t)256 * 256}; pg8::Order S_; S_.init(512, 256, NG, G, bid);
          EpiSf E{S}; pg8::gemm_phase(lds, g, S_, E, tid); }
        for (size_t e = gt; e < (size_t)NG * 256 * 32; e += NGT) {
            const int g = (int)(e >> 13), row = (int)(e >> 5) & 255, k8 = (int)e & 31, s_ = k8 >> 1, ci0 = (k8 & 1) * 8, t = row >> 4, co = row & 15;
            u32x4 w = {0u, 0u, 0u, 0u};
            if (t >= s_) { const f32x4* kp = (const f32x4*)(KTAB + (((size_t)g * 16 + (t - s_)) * 16 + co) * 16 + ci0); w = pack8(kp[0], kp[1]); }
            *(u32x4*)(YB + ((size_t)g * 256 + row) * 384 + 8 * k8) = w;
        }
            for (int item = gw; item < 256 * NH; item += NGW) { const int h = item & 15, qt = item >> 4; attn_item(Q, Kb, VT, (PROBE_PH == 2 && REP == 0) ? Y : OATT, p.in[6][h], qt, h, lane); }
    }
    if constexpr (PH == 3) {
        if (bid >= 96) {
            LAS float* scr = (LAS float*)(lds + wave * 16384);
            constexpr int I_UP = 32 * 256, I_DN = 128 * 64;
            for (int it = (bid - 96) * 8 + wave; it < I_UP + I_DN; it += (G - 96) * 8) {
                if (it < I_UP) { const int nb = it % 256, kb = it / 256; transpose_item(p.in[18], DFF, WUP, 2048, 64 * kb, 32 * nb, 32 * nb, scr, lane); }
                else { const int r = it - I_UP, nb = r % 64, kb = r / 64; transpose_item(p.in[19], 2048, WDN, DFF, 64 * kb, 32 * nb, 32 * nb, scr, lane); }
            }
        } else if (bid >= 64) {
            pg8::Gemm g{H, WIN, SEQ, INW, DM, DM, DM, 1, 0, 0}; pg8::Order S_; S_.init(SEQ, INW, 1, 1 << 20, bid - 64, 1, 768);
            EpiZf E{Q, Kb, VT, AX, GA, GS, (const float*)ROPE}; pg8::gemm_phase(lds, g, S_, E, tid);
        } else {
        LAS float* Elr = (LAS float*)lds; LAS float* Eli = Elr + 512;
        if (bid < NG) { const int g = bid;
            const int pp = tid & 63, seg = tid >> 6;
            const float2 A16 = AP[((size_t)g * NAP + 16) * SP + pp], A1k = AP[((size_t)g * NAP + 17) * SP + pp];
            const float* Sg = S + (size_t)g * 512 * 128;
            float lre = 0.f, lim = 0.f;
            for (int j = seg * 64; j < seg * 64 + 64; ++j) { const float sr = Sg[j * 128 + pp], si = Sg[j * 128 + 64 + pp];
                const float nr = A16.x * lre - A16.y * lim + sr, ni = A16.x * lim + A16.y * lre + si; lre = nr; lim = ni; }
            __syncthreads();
            Elr[seg * 64 + pp] = lre; Eli[seg * 64 + pp] = lim;
            __syncthreads();
            float cre = 0.f, cim = 0.f;
            for (int s2 = 0; s2 < seg; ++s2) { const float2 e = make_float2(Elr[s2 * 64 + pp], Eli[s2 * 64 + pp]);
                const float nr = A1k.x * cre - A1k.y * cim + e.x, ni = A1k.x * cim + A1k.y * cre + e.y; cre = nr; cim = ni; }
            for (int j = seg * 64; j < seg * 64 + 64; ++j) {
                bf16_t* axr = AX + ((size_t)g * 512 + j) * 384 + 256;
                axr[pp] = (bf16_t)f2bf(cre); axr[64 + pp] = (bf16_t)f2bf(cim);
                const float sr = Sg[j * 128 + pp], si = Sg[j * 128 + 64 + pp];
                const float nr = A16.x * cre - A16.y * cim + sr, ni = A16.x * cim + A16.y * cre + si; cre = nr; cim = ni; }
        }
                }
    }
    if constexpr (PH == 4) { pg8::Gemm g{AX, YB, 512, 256, 384, 384, 384, NG, (size_t)512 * 384, (size_t)256 * 384}; pg8::Order S_; S_.init(512, 256, NG, G, bid);
        EpiYf E{Y}; pg8::gemm_phase(lds, g, S_, E, tid); }
    if constexpr (PH == 5) { pg8::Gemm g{Y, WGLU, SEQ, 2048, 1024, 1024, 1024, 1, 0, 0}; pg8::Order S_; S_.init(SEQ, 2048, 1, G, bid);
        EpiGLUf E{OSSM}; pg8::gemm_phase(lds, g, S_, E, tid); }
    if constexpr (PH == 6) {
        { pg8::Gemm g{OATT, WBRA, SEQ, 2048, 1024, 1024, 1024, 1, 0, 0}; pg8::Order S_; S_.init(SEQ, 2048, 1, G, bid);
          EpiT1f E{(f32x4*)T1, GA, tid}; pg8::gemm_phase(lds, g, S_, E, tid); }
        { pg8::Gemm g{OSSM, WBRS, SEQ, 2048, 1024, 1024, 1024, 1, 0, 0}; pg8::Order S_; S_.init(SEQ, 2048, 1, G, bid);
          EpiMf E{(const f32x4*)T1, GS, Mb, tid}; pg8::gemm_phase(lds, g, S_, E, tid); }
    }
    if constexpr (PH == 7) { pg8::Gemm g{Mb, WOUT, SEQ, 2048, 2048, 2048, 2048, 1, 0, 0}; pg8::Order S_; S_.init(SEQ, 2048, 1, G, bid);
        EpiOutNormF E{x, p.in[2], p.in[3], X1, H2, PART1, PART2, xb}; pg8::gemm_phase(lds, g, S_, E, tid); }
    if constexpr (PH == 8) { pg8::Gemm g{H2, WUP, SEQ, DFF, DM, DM, DM, 1, 0, 0}; pg8::Order S_; S_.init(SEQ, DFF, 1, G, bid);
        EpiUpf E{Ab}; pg8::gemm_phase(lds, g, S_, E, tid); }
    if constexpr (PH == 9) { pg8::Gemm g{Ab, WDN, SEQ, DM, DFF, DFF, DFF, 1, 0, 0}; pg8::Order S_; S_.init(SEQ, DM, 1, G, bid);
        EpiDownNormF E{p.in[4], X1, PART1, xb}; pg8::gemm_phase(lds, g, S_, E, tid); }
}

constexpr int LDS_BYTES = 147456;

template <int PH>
__device__ __forceinline__ void run_all(const P& p, LAS unsigned char* lds, cg::grid_group& grid, const XcdBarrier& xb) {
    if constexpr (PH == PROBE_PH) { run_phase<PH, 0>(p, lds, xb); xcd_barrier(xb); }
    run_phase<PH>(p, lds, xb);
#ifndef PH_HI
#define PH_HI NPHASE
#endif
#ifndef PH_LO
#define PH_LO 0
#endif
    if constexpr (PH + 1 < PH_HI) {
        if constexpr (PH == 0) { if (p.use_cg_sync) grid.sync(); else xcd_barrier(xb); } else xcd_barrier(xb);
        run_all<PH + 1>(p, lds, grid, xb);
    }
}
__global__ void __launch_bounds__(512, 2) k_all(P p) {
    extern __shared__ __attribute__((aligned(16))) unsigned char lds_raw[];
    cg::grid_group grid = cg::this_grid();
    LAS unsigned char* lds = (LAS unsigned char*)lds_raw;
    volatile LAS unsigned* misc = (volatile LAS unsigned*)(lds + 131072);
    if (threadIdx.x < 2) misc[threadIdx.x] = 0u;
    __syncthreads();
    const XcdBarrier xb = xcd_barrier_post((unsigned*)(p.ws + WS_CTL), misc);
    run_all<PH_LO>(p, lds, grid, xb);
}

extern "C" void kernel_launch(void* const* d_in, const int* in_sizes, int n_in, void* d_out, int out_size, void* d_ws, size_t ws_size, hipStream_t stream) {
    static int grid = 0;
    if (grid == 0) {
        if (n_in != 20 || out_size != SEQ * DM || ws_size < WS_END) { fprintf(stderr, "kernel_launch: unexpected shapes (n_in %d out %d ws %zu)\n", n_in, out_size, ws_size); grid = -1; return; }
        int dev = 0, cus = 0;
        (void)hipGetDevice(&dev); (void)hipDeviceGetAttribute(&cus, hipDeviceAttributeMultiprocessorCount, dev);
        (void)hipFuncSetAttribute((const void*)k_all, hipFuncAttributeMaxDynamicSharedMemorySize, LDS_BYTES);
        int per_cu = 0;
        (void)hipOccupancyMaxActiveBlocksPerMultiprocessor(&per_cu, (const void*)k_all, 512, LDS_BYTES);
        if (per_cu < 1) fprintf(stderr, "kernel_launch: occupancy query says %d blocks/CU\n", per_cu);
        (void)hipGetLastError();
        if (cus != 256) { fprintf(stderr, "kernel_launch: built for a 256-CU device (one 512-thread workgroup per CU, one 256x256 tile per workgroup in the fused-norm GEMM phases); found %d CUs\n", cus); grid = -1; return; }
        grid = cus;
    }
    if (grid < 0) return;
    P p{};
    for (int i = 0; i < 20; ++i) p.in[i] = (const float*)d_in[i];
    p.out = (float*)d_out; p.ws = (unsigned char*)d_ws;
    (void)hipMemsetAsync((char*)d_ws + WS_CTL, 0, CTL_BYTES, stream);
    void* args[] = {&p};
    hipError_t e = hipLaunchCooperativeKernel((const void*)k_all, dim3(grid), dim3(512), args, LDS_BYTES, stream);
    if (e != hipSuccess) fprintf(stderr, "cooperative launch failed: %s (grid %d)\n", hipGetErrorString(e), grid);
}
```

```cpp
#include <hip/hip_runtime.h>
#include <hip/hip_cooperative_groups.h>
#include <cstdio>
#include <cstdint>
namespace cg = cooperative_groups;


typedef unsigned short bf16_t;
typedef float f32x4 __attribute__((ext_vector_type(4)));
typedef unsigned u32x2 __attribute__((ext_vector_type(2)));
typedef unsigned u32x4 __attribute__((ext_vector_type(4)));
#define LAS __attribute__((address_space(3)))

constexpr int SEQ = 8192, DM = 2048, INW = 6400, QW = 1024, SSMW = 1024, DFF = 8192;
constexpr int NG = 64, GC = 16, SP = 64, NH = 16;
constexpr size_t MiB = 1u << 20;
constexpr size_t WS_AP = 0, WS_BBAR = 1 * MiB, WS_ROPE = 1 * MiB + 512 * 1024, WS_CTL = 2 * MiB, CTL_BYTES = 16384, WS_PART1 = 3 * MiB, WS_PART2 = 0;
constexpr size_t WS_WUP = 4 * MiB, WS_WDN = 36 * MiB, WS_WIN = 68 * MiB, WS_WGLU = 93 * MiB, WS_WBRA = 97 * MiB, WS_WBRS = 101 * MiB, WS_WOUT = 105 * MiB;
constexpr size_t WS_H = 113 * MiB, WS_OSSM = 113 * MiB  , WS_Q = 145 * MiB, WS_OATT = 145 * MiB  , WS_K = 161 * MiB, WS_VT = 163 * MiB, WS_AX = 165 * MiB, WS_Y = 189 * MiB;
constexpr size_t WS_M = 161 * MiB, WS_GA = 205 * MiB, WS_GS = 237 * MiB, WS_MIXED = 205 * MiB, WS_H2 = 68 * MiB, WS_A = 141 * MiB, WS_DN = 68 * MiB, WS_END = 269 * MiB;
constexpr size_t DO_S = 0, DO_KTAB = 16 * MiB, DO_BC = 17 * MiB, DO_YB = 25 * MiB;
constexpr int NAP = 18;

struct P {
    const float* in[20];
    float* out;
    unsigned char* ws;
    unsigned long long use_cg_sync;
};

__device__ __forceinline__ float bf2f(unsigned v) { return __uint_as_float(v << 16); }
__device__ __forceinline__ unsigned f2bf(float f) { unsigned u = __float_as_uint(f); return (u + 0x7fffu + ((u >> 16) & 1u)) >> 16; }
__device__ __forceinline__ unsigned pk2(float lo, float hi) { return f2bf(lo) | (f2bf(hi) << 16); }
__device__ __forceinline__ float wave_sum(float v) {
#pragma unroll
    for (int o = 1; o < 64; o <<= 1) v += __shfl_xor(v, o);
    return v;
}
__device__ __forceinline__ float wave_max(float v) {
#pragma unroll
    for (int o = 1; o < 64; o <<= 1) v = fmaxf(v, __shfl_xor(v, o));
    return v;
}
__device__ __forceinline__ float sigmoidf_(float v) { return __builtin_amdgcn_rcpf(1.0f + __expf(-v)); }
__device__ __forceinline__ float gelu_tanh(float v) {
    const float z2 = 1.5957691216057308f * (v + 0.044715f * v * v * v);
    return v * __builtin_amdgcn_rcpf(1.0f + __expf(-z2));
}
__device__ __forceinline__ void sincos_d(double ang, float& s, float& c) {
    double rev = ang * 0.15915494309189535; rev -= rint(rev);
    const double q4 = rev * 4.0, qr = rint(q4); const int q = ((int)qr) & 3;
    const double th = (q4 - qr) * 1.5707963267948966, t2 = th * th;
    const double sn = th * (1.0 + t2 * (-1.0 / 6 + t2 * (1.0 / 120 + t2 * (-1.0 / 5040 + t2 * (1.0 / 362880 + t2 * (-1.0 / 39916800 + t2 * (1.0 / 6227020800.0)))))));
    const double cs = 1.0 + t2 * (-0.5 + t2 * (1.0 / 24 + t2 * (-1.0 / 720 + t2 * (1.0 / 40320 + t2 * (-1.0 / 3628800 + t2 * (1.0 / 479001600.0 + t2 * (-1.0 / 87178291200.0)))))));
    const double so = (q == 0) ? sn : (q == 1) ? cs : (q == 2) ? -sn : -cs;
    const double co = (q == 0) ? cs : (q == 1) ? -sn : (q == 2) ? -cs : sn;
    s = (float)so; c = (float)co;
}

struct TItem { const float* W; bf16_t* WT; int N, ldk, k0, n0, drow0; };
constexpr int TI_IN = 32 * 200, TI_GLU = 16 * 64, TI_BR = 16 * 64, TI_OUT = 32 * 64, TI_UP = 32 * 256, TI_DN = 128 * 64;
constexpr int TI_P0 = TI_IN + TI_GLU + 2 * TI_BR + TI_OUT, TI_ALL = TI_P0 + TI_UP + TI_DN;
__device__ __forceinline__ TItem titem(const P& p, int r) {
    unsigned char* ws = p.ws; TItem t;
    if (r < TI_IN) { const int nb = r % 200, kb = r / 200; t = TItem{p.in[5], (bf16_t*)(ws + WS_WIN), INW, 2048, 64 * kb, 32 * nb, 32 * nb}; return t; } r -= TI_IN;
    if (r < TI_GLU) { const int nb = r % 64, kb = r / 64, n0 = 32 * nb, bj = n0 >> 10, j = n0 & 1023, tt = j >> 7, jj = j & 127;
        t = TItem{p.in[15], (bf16_t*)(ws + WS_WGLU), 2048, 1024, 64 * kb, n0, 256 * tt + 128 * bj + jj}; return t; } r -= TI_GLU;
    if (r < TI_BR) { const int nb = r % 64, kb = r / 64; t = TItem{p.in[16], (bf16_t*)(ws + WS_WBRA), 2048, 1024, 64 * kb, 32 * nb, 32 * nb}; return t; } r -= TI_BR;
    if (r < TI_BR) { const int nb = r % 64, kb = r / 64; t = TItem{p.in[16] + (size_t)1024 * 2048, (bf16_t*)(ws + WS_WBRS), 2048, 1024, 64 * kb, 32 * nb, 32 * nb}; return t; } r -= TI_BR;
    if (r < TI_OUT) { const int nb = r % 64, kb = r / 64; t = TItem{p.in[17], (bf16_t*)(ws + WS_WOUT), 2048, 2048, 64 * kb, 32 * nb, 32 * nb}; return t; } r -= TI_OUT;
    if (r < TI_UP) { const int nb = r % 256, kb = r / 256; t = TItem{p.in[18], (bf16_t*)(ws + WS_WUP), DFF, 2048, 64 * kb, 32 * nb, 32 * nb}; return t; } r -= TI_UP;
    { const int nb = r % 64, kb = r / 64; t = TItem{p.in[19], (bf16_t*)(ws + WS_WDN), 2048, DFF, 64 * kb, 32 * nb, 32 * nb}; return t; }
}
__device__ __forceinline__ void titem_load(const TItem& t, f32x4 (&v)[8], int lane) {
#pragma unroll
    for (int i = 0; i < 8; ++i) v[i] = *(const f32x4*)(t.W + (size_t)(t.k0 + 8 * i + (lane >> 3)) * t.N + t.n0 + (lane & 7) * 4);
}
__device__ __forceinline__ void transpose_items(const P& p, int it0, int it1, int step, LAS float* scr, int lane) {
    if (it0 >= it1) return;
    TItem cur = titem(p, it0); f32x4 v[8]; titem_load(cur, v, lane);
    for (int it = it0; it < it1; it += step) {
        const bool more = it + step < it1;
        TItem nxt = cur; f32x4 nv[8];
        if (more) { nxt = titem(p, it + step); titem_load(nxt, nv, lane); }
#pragma unroll
        for (int i = 0; i < 8; ++i) { LAS float* d = scr + (8 * i + (lane >> 3)) * 33 + (lane & 7) * 4; d[0] = v[i].x; d[1] = v[i].y; d[2] = v[i].z; d[3] = v[i].w; }
        asm volatile("s_waitcnt lgkmcnt(0)" ::: "memory");
        const int c = lane & 7;
#pragma unroll
        for (int j = 0; j < 4; ++j) { const int n = (lane >> 3) + 8 * j; const LAS float* sp = scr + (8 * c) * 33 + n;
            u32x4 o; o.x = pk2(sp[0 * 33], sp[1 * 33]); o.y = pk2(sp[2 * 33], sp[3 * 33]); o.z = pk2(sp[4 * 33], sp[5 * 33]); o.w = pk2(sp[6 * 33], sp[7 * 33]);
            *(u32x4*)(cur.WT + (size_t)(cur.drow0 + n) * cur.ldk + cur.k0 + 8 * c) = o; }
        asm volatile("s_waitcnt lgkmcnt(0)" ::: "memory");
        if (more) { cur = nxt;
#pragma unroll
            for (int i = 0; i < 8; ++i) v[i] = nv[i]; }
    }
}
__device__ __forceinline__ void rms_row_bf16(const float* xrow, const float* gain, bf16_t* orow, int lane) {
    f32x4 v[8]; float s = 0.f;
#pragma unroll
    for (int j = 0; j < 8; ++j) { v[j] = ((const f32x4*)xrow)[64 * j + lane]; s += v[j].x * v[j].x + v[j].y * v[j].y + v[j].z * v[j].z + v[j].w * v[j].w; }
    const float r = rsqrtf(wave_sum(s) * (1.0f / DM) + 1e-6f);
#pragma unroll
    for (int j = 0; j < 8; ++j) { const f32x4 g = ((const f32x4*)gain)[64 * j + lane]; const f32x4 o = v[j] * r * g;
        u32x2 w; w.x = pk2(o.x, o.y); w.y = pk2(o.z, o.w); ((u32x2*)orow)[64 * j + lane] = w; }
}

namespace pg8 {
typedef short bf16x8 __attribute__((ext_vector_type(8)));
constexpr int BM = 256, BK = 64, HALF = 128, HTB = HALF * BK * 2, STAGE_BYTES = 8 * HTB, NXCD = 8, WGM = 8;
__device__ __forceinline__ int lds_byte(int r, int c) { const int st = (r >> 4) * 2 + (c >> 5), rr = r & 15, cc = c & 31, ob = rr * 64 + cc * 2; return st * 1024 + (ob ^ (((ob >> 9) & 1) << 5)); }
__device__ __forceinline__ void stage_rc(int b, int& R, int& C) { const int st = b / 1024, sb = b % 1024, swz = sb ^ (((sb >> 9) & 1) << 5); R = (st >> 1) * 16 + swz / 64; C = (st & 1) * 32 + (swz % 64) / 2; }
__device__ __forceinline__ int perm32(int rho) { const int n = rho >> 4, i = rho & 15; return 8 * (i >> 2) + 4 * n + (i & 3); }

struct Unit { int pm, pn, b; };
struct Gemm { const bf16_t* A; const bf16_t* Bt; int M, N, K, lda, ldb, nb; size_t sA, sB; };

struct Order {
    int nM, nN, nwg, nb, G, c, maxi, base;
    __device__ void init(int M, int N, int nb_, int G_, int c_, int maxi_ = (1 << 30), int base_ = 0) { nM = M / BM; nN = N / BM; nwg = nM * nN; nb = nb_; G = G_; c = c_; maxi = maxi_; base = base_; }
    __device__ bool next(int i, Unit& u) const {
        if (i >= maxi) return false;
        const long L = (long)base + (long)i * G + c; if (L >= (long)nwg * nb) return false;
        u.b = (int)(L / nwg); int wgid = (int)(L % nwg);
        { const int q = nwg / NXCD, r = nwg % NXCD, xcd = wgid % NXCD, off = wgid / NXCD; wgid = (xcd < r ? xcd * (q + 1) : r * (q + 1) + (xcd - r) * q) + off; }
        const int nig = WGM * nN, gid = wgid / nig, fm = gid * WGM, gsz = (nM - fm) < WGM ? (nM - fm) : WGM;
        u.pm = fm + ((wgid % nig) % gsz); u.pn = (wgid % nig) / gsz; return true;
    }
};

template <class Epi>
__device__ __forceinline__ void gemm_phase(LAS unsigned char* lds, const Gemm g, const Order& S, const Epi& E, const int tid) {
    const int wid = __builtin_amdgcn_readfirstlane(tid >> 6), lane = tid & 63, wr = wid >> 2, wc = wid & 3, fr = lane & 15, fq = lane >> 4;
    int K_ = g.K; asm volatile("" : "+s"(K_));
    const int nt = K_ / BK;
    unsigned voffA[2], voffB[2];
#pragma unroll
    for (int i = 0; i < 2; ++i) { int R, C; stage_rc(tid * 16 + i * 8192, R, C); const int Rb = Epi::PERM ? ((R & ~31) + perm32(R & 31)) : R;
        voffA[i] = (unsigned)(R * g.lda + C) * 2u; voffB[i] = (unsigned)(Rb * g.ldb + C) * 2u; }
    const size_t kstep = (size_t)(BK * 2);
    const size_t hstepA = (size_t)HALF * g.lda * 2, tstepA = 2 * hstepA, hstepB = (size_t)HALF * g.ldb * 2, tstepB = 2 * hstepB;
    const unsigned ldsw = (unsigned)wid * 1024u;
    const int aoff = lds_byte(wr * 64 + fr, fq * 8), boff = lds_byte(wc * 32 + fr, fq * 8);
#define PG8_SA(b, h) (((b) * 2 + (h)) * HTB)
#define PG8_SB(b, h) ((4 + (b) * 2 + (h)) * HTB)
#define PG8_STAGE(bufoff, gbase, voff) do { _Pragma("unroll") for (int _i = 0; _i < 2; ++_i) \
        __builtin_amdgcn_global_load_lds((const unsigned*)((const char*)(gbase) + (voff)[_i]), (LAS unsigned*)(lds + (bufoff) + ldsw + _i * 8192), 16, 0, 0); } while (0)
#define PG8_LDA(dst, b, h) do { _Pragma("unroll") for (int m = 0; m < 4; ++m) _Pragma("unroll") for (int k = 0; k < 2; ++k) dst[m][k] = *(const LAS bf16x8*)(lds + PG8_SA(b, h) + aoff + m * 2048 + k * 1024); } while (0)
#define PG8_LDB(dst, b, h) do { _Pragma("unroll") for (int n = 0; n < 2; ++n) _Pragma("unroll") for (int k = 0; k < 2; ++k) dst[n][k] = *(const LAS bf16x8*)(lds + PG8_SB(b, h) + boff + n * 2048 + k * 1024); } while (0)
#define PG8_MMA(ai, bj, At, Bt) do { __builtin_amdgcn_s_setprio(1); _Pragma("unroll") for (int m = 0; m < 4; ++m) _Pragma("unroll") for (int n = 0; n < 2; ++n) _Pragma("unroll") for (int k = 0; k < 2; ++k) \
        acc[ai][bj][m][n] = __builtin_amdgcn_mfma_f32_16x16x32_bf16(Bt[n][k], At[m][k], acc[ai][bj][m][n], 0, 0, 0); __builtin_amdgcn_s_setprio(0); } while (0)
#define PG8_WAIT_V(n) asm volatile("s_waitcnt vmcnt(" #n ")" ::: "memory")
#define PG8_WAIT_L(n) asm volatile("s_waitcnt lgkmcnt(" #n ")" ::: "memory")
#define PG8_BAR __builtin_amdgcn_s_barrier()
#define PG8_SCHED __builtin_amdgcn_sched_barrier(0)
    Unit cur, nxt; int ui = 0;
    if (!S.next(0, cur)) return;
    f32x4 acc[2][2][4][2];
#pragma unroll
    for (int a = 0; a < 2; ++a)
#pragma unroll
        for (int b = 0; b < 2; ++b)
#pragma unroll
            for (int m = 0; m < 4; ++m)
#pragma unroll
                for (int n = 0; n < 2; ++n) acc[a][b][m][n] = (f32x4){0.f, 0.f, 0.f, 0.f};
    bf16x8 At[4][2], B0[2][2], B1[2][2];
    const char* cA = (const char*)g.A + (size_t)cur.b * g.sA * 2 + (size_t)cur.pm * tstepA; const char* cB = (const char*)g.Bt + (size_t)cur.b * g.sB * 2 + (size_t)cur.pn * tstepB;
    PG8_STAGE(PG8_SB(0, 0), cB, voffB); PG8_STAGE(PG8_SB(0, 1), cB + hstepB, voffB); PG8_STAGE(PG8_SA(0, 0), cA, voffA); PG8_STAGE(PG8_SA(0, 1), cA + hstepA, voffA);
    if (wr == 1) PG8_BAR;
    PG8_WAIT_V(2); PG8_BAR;
    PG8_STAGE(PG8_SB(1, 0), cB + kstep, voffB); PG8_STAGE(PG8_SA(1, 0), cA + kstep, voffA); PG8_STAGE(PG8_SB(1, 1), cB + hstepB + kstep, voffB);
    PG8_WAIT_V(6); PG8_BAR;
    for (;;) {
        const bool has_next = S.next(ui + 1, nxt);
        const char* nA = has_next ? (const char*)g.A + (size_t)nxt.b * g.sA * 2 + (size_t)nxt.pm * tstepA : cA;
        const char* nB = has_next ? (const char*)g.Bt + (size_t)nxt.b * g.sB * 2 + (size_t)nxt.pn * tstepB : cB;
        for (int t = 0; t < nt; t += 2) {
            const bool last = (t == nt - 2);
            const char* a1 = cA + (size_t)(t + 1) * kstep;
            const char* a2 = last ? nA : cA + (size_t)(t + 2) * kstep; const char* b2 = last ? nB : cB + (size_t)(t + 2) * kstep;
            const char* a3 = a2 + kstep; const char* b3 = b2 + kstep;
            PG8_LDB(B0, 0, 0); PG8_LDB(B1, 0, 1); PG8_SCHED; PG8_LDA(At, 0, 0); PG8_STAGE(PG8_SA(1, 1), a1 + hstepA, voffA);
            PG8_WAIT_V(8); PG8_WAIT_L(0); PG8_BAR; PG8_MMA(0, 0, At, B0); PG8_MMA(0, 1, At, B1); PG8_BAR; PG8_SCHED;
            PG8_LDA(At, 0, 1); PG8_STAGE(PG8_SB(0, 0), b2, voffB); PG8_STAGE(PG8_SB(0, 1), b2 + hstepB, voffB); PG8_STAGE(PG8_SA(0, 0), a2, voffA);
            PG8_WAIT_V(8); PG8_WAIT_L(0); PG8_BAR; PG8_MMA(1, 0, At, B0); PG8_MMA(1, 1, At, B1); PG8_BAR; PG8_SCHED;
            PG8_LDB(B0, 1, 0); PG8_LDB(B1, 1, 1); PG8_SCHED; PG8_LDA(At, 1, 0); PG8_STAGE(PG8_SA(0, 1), a2 + hstepA, voffA);
            PG8_WAIT_V(8); PG8_WAIT_L(0); PG8_BAR; PG8_MMA(0, 0, At, B0); PG8_MMA(0, 1, At, B1); PG8_BAR; PG8_SCHED;
            PG8_LDA(At, 1, 1); PG8_STAGE(PG8_SB(1, 0), b3, voffB); PG8_STAGE(PG8_SB(1, 1), b3 + hstepB, voffB); PG8_STAGE(PG8_SA(1, 0), a3, voffA);
            PG8_WAIT_V(8); PG8_WAIT_L(0); PG8_BAR; PG8_MMA(1, 0, At, B0); PG8_MMA(1, 1, At, B1); PG8_BAR; PG8_SCHED;
        }
        if (wr == 0) PG8_BAR;
        if constexpr (Epi::FUSED) E.fused(acc, cur, wr, wc, fr, fq); else E(acc, cur, wr, wc, fr, fq);
        if (!has_next) break;
#pragma unroll
        for (int a = 0; a < 2; ++a)
#pragma unroll
            for (int b = 0; b < 2; ++b)
#pragma unroll
                for (int m = 0; m < 4; ++m)
#pragma unroll
                    for (int n = 0; n < 2; ++n) acc[a][b][m][n] = (f32x4){0.f, 0.f, 0.f, 0.f};
        cur = nxt; cA = nA; cB = nB; ++ui;
        if (wr == 1) PG8_BAR;
    }
    PG8_WAIT_V(0);
    PG8_BAR;
#undef PG8_SA
#undef PG8_SB
#undef PG8_STAGE
#undef PG8_LDA
#undef PG8_LDB
#undef PG8_MMA
#undef PG8_WAIT_V
#undef PG8_WAIT_L
#undef PG8_BAR
#undef PG8_SCHED
}
}

#define XB_TMO      128
#define XB_XCNT(j)  (256  + 64 * (j))
#define XB_XSUB(j)  (1280 + 64 * (j))
#define XB_XGEN(j)  (2304 + 64 * (j))
#define XB_TOP      3328
#define XB_TOPGEN   3392
#define XCD_BAR_WORDS 3456
#define XB_SPIN_CAP (1u << 22)
__device__ __forceinline__ unsigned xb_ld(unsigned* p)              { return __hip_atomic_load(p, __ATOMIC_RELAXED, __HIP_MEMORY_SCOPE_AGENT); }
__device__ __forceinline__ unsigned xb_add(unsigned* p, unsigned v) { return __hip_atomic_fetch_add(p, v, __ATOMIC_RELAXED, __HIP_MEMORY_SCOPE_AGENT); }
__device__ __forceinline__ unsigned xb_xcc_id() { return (unsigned)__builtin_amdgcn_s_getreg((3 << 11) | 20) & 0xFu; }
#define XB_SPIN(cond, bar) do { unsigned _sp = 0; while (cond) { __builtin_amdgcn_s_sleep(1); \
    if ((++_sp & 255u) == 0u) { if (xb_ld(&(bar)[XB_TMO])) break; if (_sp > XB_SPIN_CAP) { atomicAdd(&(bar)[XB_TMO], 1u); break; } } } } while (0)
struct XcdBarrier { unsigned* bar; unsigned x; volatile LAS unsigned* st; };
__device__ __forceinline__ XcdBarrier xcd_barrier_post(unsigned* bar, volatile LAS unsigned* st) {
    XcdBarrier b; b.bar = bar; b.x = xb_xcc_id(); b.st = st;
    if (threadIdx.x == 0) (void)xb_add(&bar[XB_XCNT(b.x)], 1u);
    return b;
}
__device__ __forceinline__ void xcd_barrier_complete(unsigned* bar, unsigned x, unsigned& nloc, unsigned& nx) {
    const unsigned G = gridDim.x * gridDim.y * gridDim.z;
    unsigned sum, cnt, mine, sp = 0u;
    for (;;) {
        sum = 0u; cnt = 0u; mine = 0u;
#pragma unroll
        for (unsigned j = 0; j < 16; ++j) { const unsigned c = xb_ld(&bar[XB_XCNT(j)]); sum += c; cnt += (c > 0u) ? 1u : 0u; mine = (j == x) ? c : mine; }
        if (sum == G) break;
        __builtin_amdgcn_s_sleep(1);
        if ((++sp & 255u) == 0u) { if (xb_ld(&bar[XB_TMO])) break; if (sp > XB_SPIN_CAP) { atomicAdd(&bar[XB_TMO], 1u); break; } }
    }
    nloc = mine > 0u ? mine : 1u; nx = cnt > 0u ? cnt : 1u;
}
__device__ __forceinline__ void xcd_barrier(const XcdBarrier& b) {
    asm volatile("s_waitcnt vmcnt(0)" ::: "memory");
    __syncthreads();
    if (threadIdx.x == 0) {
        unsigned* bar = b.bar;
        __builtin_amdgcn_s_waitcnt(0);
        unsigned nloc = b.st[0], nx = b.st[1];
        if (nloc == 0u) { xcd_barrier_complete(bar, b.x, nloc, nx); b.st[0] = nloc; b.st[1] = nx; }
        const unsigned old = xb_add(&bar[XB_XSUB(b.x)], 1u);
        const unsigned gen = old / nloc;
        if (old + 1u == (gen + 1u) * nloc) {
            __builtin_amdgcn_fence(__ATOMIC_RELEASE, "agent");
            asm volatile("s_waitcnt vmcnt(0)" ::: "memory");
            const unsigned og = xb_add(&bar[XB_TOP], 1u);
            const unsigned tg = og / nx;
            if (og + 1u == (tg + 1u) * nx) xb_add(&bar[XB_TOPGEN], 1u);
            else XB_SPIN(xb_ld(&bar[XB_TOPGEN]) == tg, bar);
            __builtin_amdgcn_fence(__ATOMIC_ACQUIRE, "agent");
            xb_add(&bar[XB_XGEN(b.x)], 1u);
            asm volatile("s_waitcnt vmcnt(0)" ::: "memory");
        } else {
            XB_SPIN(xb_ld(&bar[XB_XGEN(b.x)]) == gen, bar);
            __builtin_amdgcn_fence(__ATOMIC_ACQUIRE, "agent");
            asm volatile("s_waitcnt vmcnt(0)" ::: "memory");
        }
    }
    __syncthreads();
}

typedef f32x4 acc_t[2][2][4][2];
#define EPI_ROW(ai, m) (u.pm * 256 + (ai) * 128 + wr * 64 + (m) * 16 + fr)
__device__ __forceinline__ u32x4 pack8(const f32x4 a, const f32x4 b) { u32x4 w; w.x = pk2(a.x, a.y); w.y = pk2(a.z, a.w); w.z = pk2(b.x, b.y); w.w = pk2(b.z, b.w); return w; }
__device__ __forceinline__ f32x4 sig4(const f32x4 v) { f32x4 o; o.x = sigmoidf_(v.x); o.y = sigmoidf_(v.y); o.z = sigmoidf_(v.z); o.w = sigmoidf_(v.w); return o; }

struct EpiZf {
    static constexpr bool PERM = true, FUSED = false;
    bf16_t *q, *k, *vT, *ax, *ga, *gs; const float* rope;
    __device__ __forceinline__ void operator()(const acc_t& acc, const pg8::Unit& u, int wr, int wc, int fr, int fq) const {
        const int pn = u.pn;
#pragma unroll
        for (int ai = 0; ai < 2; ++ai)
#pragma unroll
            for (int m = 0; m < 4; ++m) {
                const int row = EPI_ROW(ai, m);
#pragma unroll
                for (int bj = 0; bj < 2; ++bj) {
                    f32x4 v0 = acc[ai][bj][m][0], v1 = acc[ai][bj][m][1];
                    const int cl = bj * 128 + wc * 32 + 8 * fq;
                    if (pn < 4 || (pn == 4 && bj == 0)) {
                        if ((wc & 1) == 0) {
                            f32x4 p0, p1;
                            p0.x = __shfl_xor(v0.x, 16); p0.y = __shfl_xor(v0.y, 16); p0.z = __shfl_xor(v0.z, 16); p0.w = __shfl_xor(v0.w, 16);
                            p1.x = __shfl_xor(v1.x, 16); p1.y = __shfl_xor(v1.y, 16); p1.z = __shfl_xor(v1.z, 16); p1.w = __shfl_xor(v1.w, 16);
                            if (fq < 2) {
                                const f32x4* rp = (const f32x4*)(rope + (size_t)row * 16);
                                const f32x4 r0 = rp[0], r1 = rp[1], r2 = rp[2], r3 = rp[3];
                                const float sg = (fq == 0) ? -1.f : 1.f;
                                v0.x = v0.x * r0.x + sg * p0.x * r0.y; v0.y = v0.y * r0.z + sg * p0.y * r0.w;
                                v0.z = v0.z * r1.x + sg * p0.z * r1.y; v0.w = v0.w * r1.z + sg * p0.w * r1.w;
                                v1.x = v1.x * r2.x + sg * p1.x * r2.y; v1.y = v1.y * r2.z + sg * p1.y * r2.w;
                                v1.z = v1.z * r3.x + sg * p1.z * r3.y; v1.w = v1.w * r3.z + sg * p1.w * r3.w;
                            }
                        }
                        bf16_t* dst = (pn < 4) ? (q + (size_t)row * 1024 + pn * 256 + cl) : (k + (size_t)row * 128 + cl);
                        *(u32x4*)dst = pack8(v0, v1);
                    } else if (pn == 4) {
                        bf16_t* dst = vT + (size_t)(cl - 128) * SEQ + row;
                        dst[0 * (size_t)SEQ] = (bf16_t)f2bf(v0.x); dst[1 * (size_t)SEQ] = (bf16_t)f2bf(v0.y); dst[2 * (size_t)SEQ] = (bf16_t)f2bf(v0.z); dst[3 * (size_t)SEQ] = (bf16_t)f2bf(v0.w);
                        dst[4 * (size_t)SEQ] = (bf16_t)f2bf(v1.x); dst[5 * (size_t)SEQ] = (bf16_t)f2bf(v1.y); dst[6 * (size_t)SEQ] = (bf16_t)f2bf(v1.z); dst[7 * (size_t)SEQ] = (bf16_t)f2bf(v1.w);
                    } else if (pn < 9) {
                        const int c = (pn - 5) * 256 + cl, g = c >> 4, ci0 = c & 15;
                        *(u32x4*)(ax + ((size_t)g * 512 + (row >> 4)) * 384 + (row & 15) * 16 + ci0) = pack8(v0, v1);
                    } else if (pn < 17) {
                        *(u32x4*)(ga + (size_t)row * 2048 + (pn - 9) * 256 + cl) = pack8(sig4(v0), sig4(v1));
                    } else {
                        *(u32x4*)(gs + (size_t)row * 2048 + (pn - 17) * 256 + cl) = pack8(sig4(v0), sig4(v1));
                    }
                }
            }
    }
};
struct EpiSf {
    static constexpr bool PERM = false, FUSED = false; float* S;
    __device__ __forceinline__ void operator()(const acc_t& acc, const pg8::Unit& u, int wr, int wc, int fr, int fq) const {
#pragma unroll
        for (int ai = 0; ai < 2; ++ai)
#pragma unroll
            for (int m = 0; m < 4; ++m) { const int row = EPI_ROW(ai, m);
#pragma unroll
                for (int n = 0; n < 2; ++n) *(f32x4*)(S + ((size_t)u.b * 512 + row) * 128 + wc * 32 + 16 * n + 4 * fq) = acc[ai][0][m][n]; }
    }
};
struct EpiYf {
    static constexpr bool PERM = true, FUSED = false; bf16_t* y;
    __device__ __forceinline__ void operator()(const acc_t& acc, const pg8::Unit& u, int wr, int wc, int fr, int fq) const {
#pragma unroll
        for (int ai = 0; ai < 2; ++ai)
#pragma unroll
            for (int m = 0; m < 4; ++m) { const int row = EPI_ROW(ai, m);
#pragma unroll
                for (int bj = 0; bj < 2; ++bj) { const int c = bj * 128 + wc * 32 + 8 * fq, t = c >> 4, co0 = c & 15;
                    const f32x4 a0 = acc[ai][bj][m][0], a1 = acc[ai][bj][m][1];
                    u32x4 w; w.x = pk2(gelu_tanh(a0.x), gelu_tanh(a0.y)); w.y = pk2(gelu_tanh(a0.z), gelu_tanh(a0.w)); w.z = pk2(gelu_tanh(a1.x), gelu_tanh(a1.y)); w.w = pk2(gelu_tanh(a1.z), gelu_tanh(a1.w));
                    *(u32x4*)(y + (unsigned)((row * 16 + t) * 1024 + u.b * 16 + co0)) = w;
                    asm volatile("" ::: "memory"); } }
    }
};
struct EpiGLUf {
    static constexpr bool PERM = true, FUSED = false; bf16_t* o;
    __device__ __forceinline__ void operator()(const acc_t& acc, const pg8::Unit& u, int wr, int wc, int fr, int fq) const {
#pragma unroll
        for (int ai = 0; ai < 2; ++ai)
#pragma unroll
            for (int m = 0; m < 4; ++m) { const int row = EPI_ROW(ai, m);
                const f32x4 v0 = acc[ai][0][m][0] * sig4(acc[ai][1][m][0]), v1 = acc[ai][0][m][1] * sig4(acc[ai][1][m][1]);
                *(u32x4*)(o + (size_t)row * 1024 + u.pn * 128 + wc * 32 + 8 * fq) = pack8(v0, v1); }
    }
};
__device__ __forceinline__ f32x4 ld_bf4(const bf16_t* p) { const u32x2 w = *(const u32x2*)p; f32x4 o; o.x = bf2f(w.x & 0xffffu); o.y = bf2f(w.x >> 16); o.z = bf2f(w.y & 0xffffu); o.w = bf2f(w.y >> 16); return o; }
__device__ __forceinline__ void ld_bf8(const bf16_t* p, f32x4& lo, f32x4& hi) { const u32x4 w = *(const u32x4*)p;
    lo.x = bf2f(w.x & 0xffffu); lo.y = bf2f(w.x >> 16); lo.z = bf2f(w.y & 0xffffu); lo.w = bf2f(w.y >> 16); hi.x = bf2f(w.z & 0xffffu); hi.y = bf2f(w.z >> 16); hi.z = bf2f(w.w & 0xffffu); hi.w = bf2f(w.w >> 16); }
struct EpiT1f {
    static constexpr bool PERM = true, FUSED = false; f32x4* t1; const bf16_t* ga; int tid;
    __device__ __forceinline__ void operator()(const acc_t& acc, const pg8::Unit& u, int wr, int wc, int fr, int fq) const {
        f32x4* base = t1 + (size_t)(u.pm * 8 + u.pn) * 32 * 512 + tid;
#pragma unroll
        for (int ai = 0; ai < 2; ++ai)
#pragma unroll
            for (int m = 0; m < 4; ++m) { const int row = EPI_ROW(ai, m);
#pragma unroll
                for (int bj = 0; bj < 2; ++bj) { const int col = u.pn * 256 + bj * 128 + wc * 32 + 8 * fq; f32x4 g0, g1; ld_bf8(ga + (size_t)row * 2048 + col, g0, g1);
                    base[(((ai * 2 + bj) * 4 + m) * 2 + 0) * 512] = g0 * acc[ai][bj][m][0]; base[(((ai * 2 + bj) * 4 + m) * 2 + 1) * 512] = g1 * acc[ai][bj][m][1]; } }
    }
};
struct EpiMf {
    static constexpr bool PERM = true, FUSED = false; const f32x4* t1; const bf16_t* gs; bf16_t* mo; int tid;
    __device__ __forceinline__ void operator()(const acc_t& acc, const pg8::Unit& u, int wr, int wc, int fr, int fq) const {
        const f32x4* base = t1 + (size_t)(u.pm * 8 + u.pn) * 32 * 512 + tid;
#pragma unroll
        for (int ai = 0; ai < 2; ++ai)
#pragma unroll
            for (int m = 0; m < 4; ++m) { const int row = EPI_ROW(ai, m);
#pragma unroll
                for (int bj = 0; bj < 2; ++bj) { const int col = u.pn * 256 + bj * 128 + wc * 32 + 8 * fq; f32x4 g0, g1; ld_bf8(gs + (size_t)row * 2048 + col, g0, g1);
                    const f32x4 v0 = base[(((ai * 2 + bj) * 4 + m) * 2 + 0) * 512] + g0 * acc[ai][bj][m][0], v1 = base[(((ai * 2 + bj) * 4 + m) * 2 + 1) * 512] + g1 * acc[ai][bj][m][1];
                    *(u32x4*)(mo + (size_t)row * 2048 + col) = pack8(v0, v1); } }
    }
};
struct EpiF32f {
    static constexpr bool PERM = false, FUSED = false; float* o;
    __device__ __forceinline__ void operator()(const acc_t& acc, const pg8::Unit& u, int wr, int wc, int fr, int fq) const {
#pragma unroll
        for (int ai = 0; ai < 2; ++ai)
#pragma unroll
            for (int m = 0; m < 4; ++m) { const int row = EPI_ROW(ai, m);
#pragma unroll
                for (int bj = 0; bj < 2; ++bj)
#pragma unroll
                    for (int n = 0; n < 2; ++n) *(f32x4*)(o + (size_t)row * 2048 + u.pn * 256 + bj * 128 + wc * 32 + 16 * n + 4 * fq) = acc[ai][bj][m][n]; }
    }
};
struct EpiUpf {
    static constexpr bool PERM = true, FUSED = false; bf16_t* a; const float* part2;
    __device__ __forceinline__ void operator()(const acc_t& acc, const pg8::Unit& u, int wr, int wc, int fr, int fq) const {
#pragma unroll
        for (int ai = 0; ai < 2; ++ai)
#pragma unroll
            for (int m = 0; m < 4; ++m) { const int row = EPI_ROW(ai, m);
                const f32x4* pp = (const f32x4*)(part2 + (size_t)row * 32 + fq * 8); const f32x4 pa = pp[0], pb = pp[1];
                float ss = ((pa.x + pa.y) + (pa.z + pa.w)) + ((pb.x + pb.y) + (pb.z + pb.w)); ss += __shfl_xor(ss, 16); ss += __shfl_xor(ss, 32);
                const float ri = rsqrtf(ss * (1.0f / DM) + 1e-6f);
#pragma unroll
                for (int bj = 0; bj < 2; ++bj) {
                    f32x4 v0 = acc[ai][bj][m][0] * ri, v1 = acc[ai][bj][m][1] * ri;
                    v0.x = fmaxf(v0.x, 0.f); v0.y = fmaxf(v0.y, 0.f); v0.z = fmaxf(v0.z, 0.f); v0.w = fmaxf(v0.w, 0.f);
                    v1.x = fmaxf(v1.x, 0.f); v1.y = fmaxf(v1.y, 0.f); v1.z = fmaxf(v1.z, 0.f); v1.w = fmaxf(v1.w, 0.f);
                    *(u32x4*)(a + (size_t)row * DFF + u.pn * 256 + bj * 128 + wc * 32 + 8 * fq) = pack8(v0 * v0, v1 * v1); } }
    }
};

__device__ __forceinline__ void row_partials(const acc_t& acc, float* part, const pg8::Unit& u, int wr, int wc, int fr, int fq) {
#pragma unroll
    for (int ai = 0; ai < 2; ++ai)
#pragma unroll
        for (int m = 0; m < 4; ++m) {
            float s = 0.f;
#pragma unroll
            for (int bj = 0; bj < 2; ++bj)
#pragma unroll
                for (int n = 0; n < 2; ++n) { const f32x4 v = acc[ai][bj][m][n]; s += (v.x * v.x + v.y * v.y) + (v.z * v.z + v.w * v.w); }
            s += __shfl_xor(s, 16); s += __shfl_xor(s, 32);
            if (fq == 0) part[(size_t)EPI_ROW(ai, m) * 32 + u.pn * 4 + wc] = s;
        }
}
__device__ __forceinline__ void row_rinv(const float* part, float (&rinv)[2][4], const pg8::Unit& u, int wr, int fr, int fq) {
#pragma unroll
    for (int ai = 0; ai < 2; ++ai)
#pragma unroll
        for (int m = 0; m < 4; ++m) {
            const f32x4* pp = (const f32x4*)(part + (size_t)EPI_ROW(ai, m) * 32 + fq * 8);
            const f32x4 a = pp[0], b = pp[1];
            float s = ((a.x + a.y) + (a.z + a.w)) + ((b.x + b.y) + (b.z + b.w));
            s += __shfl_xor(s, 16); s += __shfl_xor(s, 32);
            rinv[ai][m] = rsqrtf(s * (1.0f / DM) + 1e-6f);
        }
}
struct EpiOutNormF {
    static constexpr bool PERM = true, FUSED = true;
    const float* x; const float* g1; const float* g2; float* x1; bf16_t* h2; float* part1; float* part2; XcdBarrier xb;
    __device__ __forceinline__ void fused(acc_t& acc, const pg8::Unit& u, int wr, int wc, int fr, int fq) const {
        float rinv[2][4];
        row_partials(acc, part1, u, wr, wc, fr, fq);
        xcd_barrier(xb);
        row_rinv(part1, rinv, u, wr, fr, fq);
#pragma unroll
        for (int bj = 0; bj < 2; ++bj) { const int col = u.pn * 256 + bj * 128 + wc * 32 + 8 * fq;
            const f32x4 ga0 = *(const f32x4*)(g1 + col), ga1 = *(const f32x4*)(g1 + col + 4), gb0 = *(const f32x4*)(g2 + col), gb1 = *(const f32x4*)(g2 + col + 4);
#pragma unroll
            for (int ai = 0; ai < 2; ++ai)
#pragma unroll
              for (int mh = 0; mh < 2; ++mh) {
                f32x4 xv[2][2];
#pragma unroll
                for (int mm = 0; mm < 2; ++mm) { const unsigned o = (unsigned)(EPI_ROW(ai, 2 * mh + mm) * DM + col); xv[mm][0] = *(const f32x4*)(x + o); xv[mm][1] = *(const f32x4*)(x + o + 4); }
#pragma unroll
                for (int mm = 0; mm < 2; ++mm) { const int m = 2 * mh + mm; const unsigned o = (unsigned)(EPI_ROW(ai, m) * DM + col);
                    const f32x4 v0 = xv[mm][0] + acc[ai][bj][m][0] * rinv[ai][m] * ga0, v1 = xv[mm][1] + acc[ai][bj][m][1] * rinv[ai][m] * ga1;
                    acc[ai][bj][m][0] = v0; acc[ai][bj][m][1] = v1; *(f32x4*)(x1 + o) = v0; *(f32x4*)(x1 + o + 4) = v1; *(u32x4*)(h2 + o) = pack8(v0 * gb0, v1 * gb1); }
#pragma unroll
                for (int mm = 0; mm < 2; ++mm) asm volatile("" : "+v"(acc[ai][bj][2 * mh + mm][0]), "+v"(acc[ai][bj][2 * mh + mm][1]));
                asm volatile("" ::: "memory"); } }
        row_partials(acc, part2, u, wr, wc, fr, fq);
    }
};
struct EpiDownNormF {
    static constexpr bool PERM = true, FUSED = true;
    const float* g; float* x1; float* part; XcdBarrier xb;
    __device__ __forceinline__ void fused(acc_t& acc, const pg8::Unit& u, int wr, int wc, int fr, int fq) const {
        float rinv[2][4];
        row_partials(acc, part, u, wr, wc, fr, fq);
        xcd_barrier(xb);
        row_rinv(part, rinv, u, wr, fr, fq);
#pragma unroll
        for (int bj = 0; bj < 2; ++bj) { const int col = u.pn * 256 + bj * 128 + wc * 32 + 8 * fq;
            const f32x4 g0 = *(const f32x4*)(g + col), g1 = *(const f32x4*)(g + col + 4);
#pragma unroll
            for (int ai = 0; ai < 2; ++ai)
#pragma unroll
                for (int m = 0; m < 4; ++m) { float* o = x1 + (unsigned)(EPI_ROW(ai, m) * DM + col);
                    const f32x4 a0 = *(const f32x4*)o, a1 = *(const f32x4*)(o + 4);
                    *(f32x4*)o = a0 + acc[ai][bj][m][0] * rinv[ai][m] * g0; *(f32x4*)(o + 4) = a1 + acc[ai][bj][m][1] * rinv[ai][m] * g1; } }
    }
};

typedef float f32x16 __attribute__((ext_vector_type(16)));
typedef short s16x8 __attribute__((ext_vector_type(8)));
constexpr int ATT_KROW = 144, ATT_VROW = 336, ATT_VOFF = 160 * ATT_KROW;
__device__ __forceinline__ void attn_stage(LAS unsigned char* lds, const bf16_t* Kb, const bf16_t* VT, const int q0, const int hk, const int tid) {
    for (int c = tid; c < 1280; c += 512) {
        const int row = c >> 3, ch = c & 7, key = q0 - 128 + row;
        u32x4 v = {0u, 0u, 0u, 0u}; if (key >= 0) v = *(const u32x4*)(Kb + (size_t)key * 128 + hk * 64 + ch * 8);
        *(LAS u32x4*)(lds + row * ATT_KROW + ch * 16) = v;
        const int d = c / 20, cc = c % 20, k0 = q0 - 128 + cc * 8;
        u32x4 w = {0u, 0u, 0u, 0u}; if (k0 >= 0) w = *(const u32x4*)(VT + (size_t)(hk * 64 + d) * SEQ + k0);
        *(LAS u32x4*)(lds + ATT_VOFF + d * ATT_VROW + cc * 16) = w;
    }
}
__device__ __forceinline__ void attn_item(LAS unsigned char* lds, const bf16_t* Q, bf16_t* O, const float sink, const int q0, const int h, const int lane) {
    const int r = lane & 31, hf = lane >> 5;
    s16x8 qf[4];
#pragma unroll
    for (int kk = 0; kk < 4; ++kk) qf[kk] = *(const s16x8*)(Q + (size_t)(q0 + r) * 1024 + h * 64 + 16 * kk + 8 * hf);
    f32x16 st[5];
#pragma unroll
    for (int kt = 0; kt < 5; ++kt) {
        f32x16 a = {0.f, 0.f, 0.f, 0.f, 0.f, 0.f, 0.f, 0.f, 0.f, 0.f, 0.f, 0.f, 0.f, 0.f, 0.f, 0.f};
#pragma unroll
        for (int kk = 0; kk < 4; ++kk) {
            const s16x8 kf = *(const LAS s16x8*)(lds + (32 * kt + r) * ATT_KROW + (16 * kk + 8 * hf) * 2);
            a = __builtin_amdgcn_mfma_f32_32x32x16_bf16(kf, qf[kk], a, 0, 0, 0);
        }
        st[kt] = a;
    }
    float mx = sink;
#pragma unroll
    for (int kt = 0; kt < 5; ++kt)
#pragma unroll
        for (int e = 0; e < 16; ++e) {
            const int kofs = -128 + 32 * kt + (e & 3) + 8 * (e >> 2) + 4 * hf;
            const int diff = r - kofs;
            const bool ok = (diff >= 0) && (diff < 128) && (q0 + kofs >= 0);
            const float sv = ok ? st[kt][e] * 0.125f : -1e30f;
            st[kt][e] = sv; mx = fmaxf(mx, sv);
        }
    mx = fmaxf(mx, __shfl_xor(mx, 32));
    float sum = 0.f;
#pragma unroll
    for (int kt = 0; kt < 5; ++kt)
#pragma unroll
        for (int e = 0; e < 16; ++e) { const float pv = (st[kt][e] > -1e29f) ? __expf(st[kt][e] - mx) : 0.f; st[kt][e] = pv; sum += pv; }
    sum += __shfl_xor(sum, 32);
    sum += __expf(sink - mx);
    const float inv = 1.0f / sum;
    f32x16 o0 = {0.f, 0.f, 0.f, 0.f, 0.f, 0.f, 0.f, 0.f, 0.f, 0.f, 0.f, 0.f, 0.f, 0.f, 0.f, 0.f}, o1 = o0;
#pragma unroll
    for (int kt = 0; kt < 5; ++kt)
#pragma unroll
        for (int s = 0; s < 2; ++s) {
            u32x4 pw; pw.x = pk2(st[kt][8 * s + 0], st[kt][8 * s + 1]); pw.y = pk2(st[kt][8 * s + 2], st[kt][8 * s + 3]);
            pw.z = pk2(st[kt][8 * s + 4], st[kt][8 * s + 5]); pw.w = pk2(st[kt][8 * s + 6], st[kt][8 * s + 7]);
            const s16x8 pf = __builtin_bit_cast(s16x8, pw);
#pragma unroll
            for (int dt = 0; dt < 2; ++dt) {
                const LAS unsigned char* vp = lds + ATT_VOFF + (32 * dt + r) * ATT_VROW + (32 * kt + 16 * s + 4 * hf) * 2;
                const u32x2 a0 = *(const LAS u32x2*)vp, a1 = *(const LAS u32x2*)(vp + 16);
                u32x4 vw; vw.x = a0.x; vw.y = a0.y; vw.z = a1.x; vw.w = a1.y;
                const s16x8 vf = __builtin_bit_cast(s16x8, vw);
                if (dt == 0) o0 = __builtin_amdgcn_mfma_f32_32x32x16_bf16(vf, pf, o0, 0, 0, 0);
                else o1 = __builtin_amdgcn_mfma_f32_32x32x16_bf16(vf, pf, o1, 0, 0, 0);
            }
        }
    bf16_t* op = O + (size_t)(q0 + r) * 1024 + h * 64 + 4 * hf;
#pragma unroll
    for (int i = 0; i < 4; ++i) {
        u32x2 w; w.x = pk2(o0[4 * i] * inv, o0[4 * i + 1] * inv); w.y = pk2(o0[4 * i + 2] * inv, o0[4 * i + 3] * inv); *(u32x2*)(op + 8 * i) = w;
        u32x2 w1; w1.x = pk2(o1[4 * i] * inv, o1[4 * i + 1] * inv); w1.y = pk2(o1[4 * i + 2] * inv, o1[4 * i + 3] * inv); *(u32x2*)(op + 32 + 8 * i) = w1;
    }
}

constexpr int NPHASE = 10;

#ifndef PROBE_PH
#define PROBE_PH -1
#endif
template <int PH, int REP = 1>
__device__ __forceinline__ void run_phase(const P& p, LAS unsigned char* lds, const XcdBarrier& xb) {
    int tid_ = threadIdx.x; asm volatile("" : "+v"(tid_));
    const int tid = tid_, lane = tid & 63, wave = tid >> 6;
    int bid_ = blockIdx.x; asm volatile("" : "+s"(bid_));
    const int bid = bid_;
    const int G = gridDim.x, gw = bid * 8 + wave, NGW = G * 8;
    const size_t gt = (size_t)bid * 512 + tid, NGT = (size_t)G * 512;
    unsigned char* ws = p.ws; unsigned char* dout = (unsigned char*)p.out;
    asm volatile("" : "+s"(ws), "+s"(dout));
    float* PART1 = (float*)(ws + WS_PART1); float* PART2 = (float*)(ws + WS_PART2);
    float2* AP = (float2*)(ws + WS_AP); float2* BBAR = (float2*)(ws + WS_BBAR); float2* ROPE = (float2*)(ws + WS_ROPE);
    bf16_t* WUP = (bf16_t*)(ws + WS_WUP); bf16_t* WDN = (bf16_t*)(ws + WS_WDN); bf16_t* WIN = (bf16_t*)(ws + WS_WIN); bf16_t* WGLU = (bf16_t*)(ws + WS_WGLU);
    bf16_t* WBRA = (bf16_t*)(ws + WS_WBRA); bf16_t* WBRS = (bf16_t*)(ws + WS_WBRS); bf16_t* WOUT = (bf16_t*)(ws + WS_WOUT);
    bf16_t* H = (bf16_t*)(ws + WS_H); bf16_t* OATT = (bf16_t*)(ws + WS_OATT); bf16_t* Q = (bf16_t*)(ws + WS_Q); bf16_t* OSSM = (bf16_t*)(ws + WS_OSSM);
    bf16_t* Kb = (bf16_t*)(ws + WS_K); bf16_t* VT = (bf16_t*)(ws + WS_VT); bf16_t* AX = (bf16_t*)(ws + WS_AX); bf16_t* Y = (bf16_t*)(ws + WS_Y);
    bf16_t* Mb = (bf16_t*)(ws + WS_M); bf16_t* GA = (bf16_t*)(ws + WS_GA); bf16_t* GS = (bf16_t*)(ws + WS_GS); float* MIXED = (float*)(ws + WS_MIXED);
    bf16_t* H2 = (bf16_t*)(ws + WS_H2); bf16_t* Ab = (bf16_t*)(ws + WS_A); float* DN = (float*)(ws + WS_DN);
    float* S = (float*)(dout + DO_S); float* KTAB = (float*)(dout + DO_KTAB); bf16_t* BC = (bf16_t*)(dout + DO_BC); bf16_t* YB = (bf16_t*)(dout + DO_YB);
    float* T1 = (float*)dout; float* X1 = (float*)dout;
    const float* x = p.in[0];

    if constexpr (PH == 0) {
        LAS float* scr = (LAS float*)(lds + wave * 16384);
        transpose_items(p, gw, TI_P0, NGW, scr, lane);
        if (gw < SEQ) {
            f32x4 v[8];
#pragma unroll
            for (int j = 0; j < 8; ++j) v[j] = ((const f32x4*)(x + (size_t)gw * DM))[64 * j + lane];
            for (int m = gw; m < SEQ; m += NGW) {
                const bool more = m + NGW < SEQ; f32x4 nv[8];
                if (more) {
#pragma unroll
                    for (int j = 0; j < 8; ++j) nv[j] = ((const f32x4*)(x + (size_t)(m + NGW) * DM))[64 * j + lane]; }
                float ss = 0.f;
#pragma unroll
                for (int j = 0; j < 8; ++j) ss += v[j].x * v[j].x + v[j].y * v[j].y + v[j].z * v[j].z + v[j].w * v[j].w;
                const float rr = rsqrtf(wave_sum(ss) * (1.0f / DM) + 1e-6f);
#pragma unroll
                for (int j = 0; j < 8; ++j) { const f32x4 g = ((const f32x4*)p.in[1])[64 * j + lane]; const f32x4 o = v[j] * rr * g;
                    u32x2 w; w.x = pk2(o.x, o.y); w.y = pk2(o.z, o.w); ((u32x2*)(H + (size_t)m * DM))[64 * j + lane] = w; }
                if (more) {
#pragma unroll
                    for (int j = 0; j < 8; ++j) v[j] = nv[j]; }
            }
        }
        for (size_t e = gt; e < (size_t)NG * SP * NAP; e += NGT) {
            const int i = (int)(e / NAP), n = (int)(e % NAP), g = i / SP;
            const double dt = exp((double)p.in[9][g]), lr = (double)p.in[7][i], li = (double)p.in[8][i];
            const double pw = (n == 17) ? 1024.0 : (double)n;
            const float mag = (float)exp(pw * lr * dt); float sn, cs; sincos_d(pw * li * dt, sn, cs);
            AP[((size_t)g * NAP + n) * SP + (i % SP)] = make_float2(mag * cs, mag * sn);
        }
        for (size_t e = gt; e < (size_t)NG * SP * GC; e += NGT) {
            const int i = (int)(e >> 4), g = i / SP;
            const double dt = exp((double)p.in[9][g]), lr = (double)p.in[7][i], li = (double)p.in[8][i];
            float s1, c1; sincos_d(li * dt, s1, c1);
            const double mag1 = exp(lr * dt), are = mag1 * (double)c1, aim = mag1 * (double)s1;
            const double nr = are - 1.0, ni = aim, den = lr * lr + li * li;
            const double cre = (nr * lr + ni * li) / den, cim = (ni * lr - nr * li) / den;
            const double br = (double)p.in[10][e], bi = (double)p.in[11][e];
            BBAR[e] = make_float2((float)(cre * br - cim * bi), (float)(cre * bi + cim * br));
        }
        for (size_t i = gt; i < (size_t)SEQ * 8; i += NGT) {
            const int pos = (int)(i >> 3), k = (int)(i & 7);
            const double inv = exp(-(double)k * 0.125 * 13.122363377404328);
            float s, c; sincos_d((double)pos * inv, s, c);
            ROPE[i] = make_float2(c, s);
        }
        }
    if constexpr (PH == 1) {
        { pg8::Gemm g{H, WIN, SEQ, INW, DM, DM, DM, 1, 0, 0}; pg8::Order S; S.init(SEQ, INW, 1, G, bid, 3);
          EpiZf E{Q, Kb, VT, AX, GA, GS, (const float*)ROPE}; pg8::gemm_phase(lds, g, S, E, tid); }
        for (size_t e = gt; e < (size_t)NG * 256 * 32; e += NGT) {
            const int g = (int)(e >> 13), r = (int)(e >> 5) & 255, k8 = (int)e & 31, s_ = k8 >> 1, ci0 = (k8 & 1) * 8;
            u32x4 w = {0u, 0u, 0u, 0u};
            if (r < 128) { const int pp = r & 63; const float2 a = AP[((size_t)g * NAP + 15 - s_) * SP + pp];
                const f32x4* bp = (const f32x4*)(BBAR + ((size_t)g * SP + pp) * GC + ci0); const f32x4 b0 = bp[0], b1 = bp[1], b2 = bp[2], b3 = bp[3];
                if (r >> 6) { w.x = pk2(a.x * b0.y + a.y * b0.x, a.x * b0.w + a.y * b0.z); w.y = pk2(a.x * b1.y + a.y * b1.x, a.x * b1.w + a.y * b1.z);
                              w.z = pk2(a.x * b2.y + a.y * b2.x, a.x * b2.w + a.y * b2.z); w.w = pk2(a.x * b3.y + a.y * b3.x, a.x * b3.w + a.y * b3.z); }
                else {        w.x = pk2(a.x * b0.x - a.y * b0.y, a.x * b0.z - a.y * b0.w); w.y = pk2(a.x * b1.x - a.y * b1.y, a.x * b1.z - a.y * b1.w);
                              w.z = pk2(a.x * b2.x - a.y * b2.y, a.x * b2.z - a.y * b2.w); w.w = pk2(a.x * b3.x - a.y * b3.y, a.x * b3.z - a.y * b3.w); } }
            *(u32x4*)(BC + e * 8) = w;
        }
        for (size_t e = gt; e < (size_t)NG * 256 * 16; e += NGT) {
            const int g = (int)(e >> 12), row = (int)(e >> 4) & 255, r0 = ((int)e & 15) * 8, t = row >> 4, co = row & 15, pp0 = r0 & 63;
            const f32x4* ap = (const f32x4*)(AP + ((size_t)g * NAP + t + 1) * SP + pp0); const f32x4 a0 = ap[0], a1 = ap[1], a2 = ap[2], a3 = ap[3];
            const f32x4* crp = (const f32x4*)(p.in[12] + ((size_t)g * GC + co) * SP + pp0); const f32x4* cip = (const f32x4*)(p.in[13] + ((size_t)g * GC + co) * SP + pp0);
            const f32x4 cr0 = crp[0], cr1 = crp[1], ci0 = cip[0], ci1 = cip[1];
            u32x4 w;
            if (r0 >> 6) { w.x = pk2(-(cr0.x * a0.y + ci0.x * a0.x), -(cr0.y * a0.w + ci0.y * a0.z)); w.y = pk2(-(cr0.z * a1.y + ci0.z * a1.x), -(cr0.w * a1.w + ci0.w * a1.z));
                           w.z = pk2(-(cr1.x * a2.y + ci1.x * a2.x), -(cr1.y * a2.w + ci1.y * a2.z)); w.w = pk2(-(cr1.z * a3.y + ci1.z * a3.x), -(cr1.w * a3.w + ci1.w * a3.z)); }
            else {         w.x = pk2(cr0.x * a0.x - ci0.x * a0.y, cr0.y * a0.z - ci0.y * a0.w); w.y = pk2(cr0.z * a1.x - ci0.z * a1.y, cr0.w * a1.z - ci0.w * a1.w);
                           w.z = pk2(cr1.x * a2.x - ci1.x * a2.y, cr1.y * a2.z - ci1.y * a2.w); w.w = pk2(cr1.z * a3.x - ci1.z * a3.y, cr1.w * a3.z - ci1.w * a3.w); }
            *(u32x4*)(YB + ((size_t)g * 256 + row) * 384 + 256 + r0) = w;
        }
        {
            LAS float* Cre = (LAS float*)lds; LAS float* Cim = Cre + 16 * 65; LAS float* APr = Cim + 16 * 65; LAS float* APi = APr + 256; LAS float* Bbr = APi + 256; LAS float* Bbi = Bbr + 1024;
            for (int item = bid; item < NG * 4; item += G) {
                const int g = item >> 2, tq = item & 3;
                __syncthreads();
                for (int i = tid; i < 1024; i += 512) { Cre[(i >> 6) * 65 + (i & 63)] = p.in[12][(size_t)g * 1024 + i]; Cim[(i >> 6) * 65 + (i & 63)] = p.in[13][(size_t)g * 1024 + i];
                    const float2 b = BBAR[(size_t)g * 1024 + i]; Bbr[i] = b.x; Bbi[i] = b.y; }
                if (tid < 256) { const float2 a = AP[((size_t)g * NAP + 4 * tq + (tid >> 6)) * SP + (tid & 63)]; APr[tid] = a.x; APi[tid] = a.y; }
                __syncthreads();
#pragma unroll
                for (int rr = 0; rr < 2; ++rr) {
                    const int idx = tid + 512 * rr, tl = idx >> 8, co = (idx >> 4) & 15, ci = idx & 15;
                    float acc = 0.f;
#pragma unroll 8
                    for (int pp = 0; pp < SP; ++pp) {
                        const float cr = Cre[co * 65 + pp], cim = Cim[co * 65 + pp], ax = APr[tl * 64 + pp], ay = APi[tl * 64 + pp];
                        const float wre = cr * ax - cim * ay, wim = cr * ay + cim * ax;
                        acc += wre * Bbr[pp * 16 + ci] - wim * Bbi[pp * 16 + ci];
                    }
                    const int tau = 4 * tq + tl;
                    if (tau == 0 && co == ci) acc += p.in[14][g * GC + co];
                    KTAB[(((size_t)g * 16 + tau) * 16 + co) * 16 + ci] = acc;
                }
            }
            __syncthreads();
        }
        }
    if constexpr (PH == 2) {
        { pg8::Gemm g{AX, BC, 512, 256, 256, 384, 256, NG, (size_t)512 * 384, (size_t)256 * 256}; pg8::Order S_; S_.init(512, 256, NG, G, bid);
          EpiSf E{S}; pg8::gemm_phase(lds, g, S_, E, tid); }
        for (size_t e = gt; e < (size_t)NG * 256 * 32; e += NGT) {
            const int g = (int)(e >> 13), row = (int)(e >> 5) & 255, k8 = (int)e & 31, s_ = k8 >> 1, ci0 = (k8 & 1) * 8, t = row >> 4, co = row & 15;
            u32x4 w = {0u, 0u, 0u, 0u};
            if (t >= s_) { const f32x4* kp = (const f32x4*)(KTAB + (((size_t)g * 16 + (t - s_)) * 16 + co) * 16 + ci0); w = pack8(kp[0], kp[1]); }
            *(u32x4*)(YB + ((size_t)g * 256 + row) * 384 + 8 * k8) = w;
        }
        for (int item = bid; item < 512; item += G) {
            const int hk = item & 1, q0 = (item >> 1) * 32, h = hk * 8 + wave;
            __syncthreads();
            attn_stage(lds, Kb, VT, q0, hk, tid);
            __syncthreads();
            attn_item(lds, Q, (PROBE_PH == 2 && REP == 0) ? Y : OATT, p.in[6][h], q0, h, lane);
        }
    }
    if constexpr (PH == 3) {
        if (bid >= 96) {
            LAS float* scr = (LAS float*)(lds + wave * 16384);
            transpose_items(p, TI_P0 + (bid - 96) * 8 + wave, TI_ALL, (G - 96) * 8, scr, lane);
        } else if (bid >= 64) {
            pg8::Gemm g{H, WIN, SEQ, INW, DM, DM, DM, 1, 0, 0}; pg8::Order S_; S_.init(SEQ, INW, 1, 1 << 20, bid - 64, 1, 768);
            EpiZf E{Q, Kb, VT, AX, GA, GS, (const float*)ROPE}; pg8::gemm_phase(lds, g, S_, E, tid);
        } else {
        LAS float* Elr = (LAS float*)lds; LAS float* Eli = Elr + 512;
        if (bid < NG) { const int g = bid;
            const int pp = tid & 63, seg = tid >> 6;
            const float2 A16 = AP[((size_t)g * NAP + 16) * SP + pp], A1k = AP[((size_t)g * NAP + 17) * SP + pp];
            const float* Sg = S + (size_t)g * 512 * 128;
            float lre = 0.f, lim = 0.f;
            for (int j0 = seg * 64; j0 < seg * 64 + 64; j0 += 16) {
                float sr[16], si[16];
#pragma unroll
                for (int q = 0; q < 16; ++q) { sr[q] = Sg[(j0 + q) * 128 + pp]; si[q] = Sg[(j0 + q) * 128 + 64 + pp]; }
#pragma unroll
                for (int q = 0; q < 16; ++q) { const float nr = A16.x * lre - A16.y * lim + sr[q], ni = A16.x * lim + A16.y * lre + si[q]; lre = nr; lim = ni; }
            }
            __syncthreads();
            Elr[seg * 64 + pp] = lre; Eli[seg * 64 + pp] = lim;
            __syncthreads();
            float cre = 0.f, cim = 0.f;
            for (int s2 = 0; s2 < seg; ++s2) { const float2 e = make_float2(Elr[s2 * 64 + pp], Eli[s2 * 64 + pp]);
                const float nr = A1k.x * cre - A1k.y * cim + e.x, ni = A1k.x * cim + A1k.y * cre + e.y; cre = nr; cim = ni; }
            for (int j0 = seg * 64; j0 < seg * 64 + 64; j0 += 16) {
                float sr[16], si[16];
#pragma unroll
                for (int q = 0; q < 16; ++q) { sr[q] = Sg[(j0 + q) * 128 + pp]; si[q] = Sg[(j0 + q) * 128 + 64 + pp]; }
#pragma unroll
                for (int q = 0; q < 16; ++q) {
                    bf16_t* axr = AX + ((size_t)g * 512 + j0 + q) * 384 + 256;
                    axr[pp] = (bf16_t)f2bf(cre); axr[64 + pp] = (bf16_t)f2bf(cim);
                    const float nr = A16.x * cre - A16.y * cim + sr[q], ni = A16.x * cim + A16.y * cre + si[q]; cre = nr; cim = ni; }
            }
        }
                }
    }
    if constexpr (PH == 4) { pg8::Gemm g{AX, YB, 512, 256, 384, 384, 384, NG, (size_t)512 * 384, (size_t)256 * 384}; pg8::Order S_; S_.init(512, 256, NG, G, bid);
        EpiYf E{Y}; pg8::gemm_phase(lds, g, S_, E, tid); }
    if constexpr (PH == 5) { pg8::Gemm g{Y, WGLU, SEQ, 2048, 1024, 1024, 1024, 1, 0, 0}; pg8::Order S_; S_.init(SEQ, 2048, 1, G, bid);
        EpiGLUf E{OSSM}; pg8::gemm_phase(lds, g, S_, E, tid); }
    if constexpr (PH == 6) {
        { pg8::Gemm g{OATT, WBRA, SEQ, 2048, 1024, 1024, 1024, 1, 0, 0}; pg8::Order S_; S_.init(SEQ, 2048, 1, G, bid);
          EpiT1f E{(f32x4*)T1, GA, tid}; pg8::gemm_phase(lds, g, S_, E, tid); }
        { pg8::Gemm g{OSSM, WBRS, SEQ, 2048, 1024, 1024, 1024, 1, 0, 0}; pg8::Order S_; S_.init(SEQ, 2048, 1, G, bid);
          EpiMf E{(const f32x4*)T1, GS, Mb, tid}; pg8::gemm_phase(lds, g, S_, E, tid); }
    }
    if constexpr (PH == 7) { pg8::Gemm g{Mb, WOUT, SEQ, 2048, 2048, 2048, 2048, 1, 0, 0}; pg8::Order S_; S_.init(SEQ, 2048, 1, G, bid);
        EpiOutNormF E{x, p.in[2], p.in[3], X1, H2, PART1, PART2, xb}; pg8::gemm_phase(lds, g, S_, E, tid); }
    if constexpr (PH == 8) { pg8::Gemm g{H2, WUP, SEQ, DFF, DM, DM, DM, 1, 0, 0}; pg8::Order S_; S_.init(SEQ, DFF, 1, G, bid);
        EpiUpf E{Ab, PART2}; pg8::gemm_phase(lds, g, S_, E, tid); }
    if constexpr (PH == 9) { pg8::Gemm g{Ab, WDN, SEQ, DM, DFF, DFF, DFF, 1, 0, 0}; pg8::Order S_; S_.init(SEQ, DM, 1, G, bid);
        EpiDownNormF E{p.in[4], X1, PART1, xb}; pg8::gemm_phase(lds, g, S_, E, tid); }
}

constexpr int LDS_BYTES = 147456;

#ifndef TPROBE
#define TPROBE -1
#endif
template <int PH>
__device__ __forceinline__ void run_all(const P& p, LAS unsigned char* lds, cg::grid_group& grid, const XcdBarrier& xb, volatile LAS unsigned* misc) {
    if constexpr (PH == PROBE_PH) { run_phase<PH, 0>(p, lds, xb); xcd_barrier(xb); }
    run_phase<PH>(p, lds, xb);
    if constexpr (PH + 1 < NPHASE) {
        if constexpr (PH == 0) { if (p.use_cg_sync) grid.sync(); else xcd_barrier(xb); } else xcd_barrier(xb);
        if constexpr (TPROBE >= 0) { if (blockIdx.x == 0 && threadIdx.x == 0) misc[4 + PH + 1] = (unsigned)__builtin_amdgcn_s_memrealtime(); }
        run_all<PH + 1>(p, lds, grid, xb, misc);
    }
}
__global__ void __launch_bounds__(512, 2) k_all(P p) {
    extern __shared__ __attribute__((aligned(16))) unsigned char lds_raw[];
    cg::grid_group grid = cg::this_grid();
    LAS unsigned char* lds = (LAS unsigned char*)lds_raw;
    volatile LAS unsigned* misc = (volatile LAS unsigned*)(lds + 131072);
    if (threadIdx.x < 2) misc[threadIdx.x] = 0u;
    __syncthreads();
    const XcdBarrier xb = xcd_barrier_post((unsigned*)(p.ws + WS_CTL), misc);
    if constexpr (TPROBE >= 0) { if (blockIdx.x == 0 && threadIdx.x == 0) misc[4] = (unsigned)__builtin_amdgcn_s_memrealtime(); }
    run_all<0>(p, lds, grid, xb, misc);
    if constexpr (TPROBE >= 0) {
        if (blockIdx.x == 0 && threadIdx.x == 0) {
            const unsigned now = (unsigned)__builtin_amdgcn_s_memrealtime(); misc[4 + NPHASE] = now;
            const unsigned d = misc[4 + TPROBE + 1] - misc[4 + TPROBE];
            while ((unsigned)__builtin_amdgcn_s_memrealtime() - now < 8u * d) __builtin_amdgcn_s_sleep(8);
        }
    }
}

extern "C" void kernel_launch(void* const* d_in, const int* in_sizes, int n_in, void* d_out, int out_size, void* d_ws, size_t ws_size, hipStream_t stream) {
    static int grid = 0;
    if (grid == 0) {
        if (n_in != 20 || out_size != SEQ * DM || ws_size < WS_END) { fprintf(stderr, "kernel_launch: unexpected shapes (n_in %d out %d ws %zu)\n", n_in, out_size, ws_size); grid = -1; return; }
        int dev = 0, cus = 0;
        (void)hipGetDevice(&dev); (void)hipDeviceGetAttribute(&cus, hipDeviceAttributeMultiprocessorCount, dev);
        (void)hipFuncSetAttribute((const void*)k_all, hipFuncAttributeMaxDynamicSharedMemorySize, LDS_BYTES);
        int per_cu = 0;
        (void)hipOccupancyMaxActiveBlocksPerMultiprocessor(&per_cu, (const void*)k_all, 512, LDS_BYTES);
        if (per_cu < 1) fprintf(stderr, "kernel_launch: occupancy query says %d blocks/CU\n", per_cu);
        (void)hipGetLastError();
        if (cus != 256) { fprintf(stderr, "kernel_launch: built for a 256-CU device (one 512-thread workgroup per CU, one 256x256 tile per workgroup in the fused-norm GEMM phases); found %d CUs\n", cus); grid = -1; return; }
        grid = cus;
    }
    if (grid < 0) return;
    P p{};
    for (int i = 0; i < 20; ++i) p.in[i] = (const float*)d_in[i];
    p.out = (float*)d_out; p.ws = (unsigned char*)d_ws;
    (void)hipMemsetAsync((char*)d_ws + WS_CTL, 0, CTL_BYTES, stream);
    void* args[] = {&p};
    hipError_t e = hipLaunchCooperativeKernel((const void*)k_all, dim3(grid), dim3(512), args, LDS_BYTES, stream);
    if (e != hipSuccess) fprintf(stderr, "cooperative launch failed: %s (grid %d)\n", hipGetErrorString(e), grid);
}
```

```cpp
#include <hip/hip_runtime.h>
#include <hip/hip_cooperative_groups.h>
#include <cstdio>
#include <cstdint>
namespace cg = cooperative_groups;


typedef unsigned short bf16_t;
typedef float f32x4 __attribute__((ext_vector_type(4)));
typedef unsigned u32x2 __attribute__((ext_vector_type(2)));
typedef unsigned u32x4 __attribute__((ext_vector_type(4)));
#define LAS __attribute__((address_space(3)))

constexpr int SEQ = 8192, DM = 2048, INW = 6400, QW = 1024, SSMW = 1024, DFF = 8192;
constexpr int NG = 64, GC = 16, SP = 64, NH = 16;
constexpr size_t MiB = 1u << 20;
constexpr size_t WS_AP = 0, WS_BBAR = 1 * MiB, WS_ROPE = 1 * MiB + 512 * 1024, WS_CTL = 2 * MiB, CTL_BYTES = 16384, WS_PART1 = 3 * MiB, WS_PART2 = 0;
constexpr size_t WS_WUP = 4 * MiB, WS_WDN = 36 * MiB, WS_WIN = 68 * MiB, WS_WGLU = 93 * MiB, WS_WBRA = 97 * MiB, WS_WBRS = 101 * MiB, WS_WOUT = 105 * MiB;
constexpr size_t WS_H = 113 * MiB, WS_OSSM = 113 * MiB  , WS_Q = 145 * MiB, WS_OATT = 145 * MiB  , WS_K = 161 * MiB, WS_VT = 163 * MiB, WS_AX = 165 * MiB, WS_Y = 189 * MiB;
constexpr size_t WS_M = 161 * MiB, WS_GA = 205 * MiB, WS_GS = 237 * MiB, WS_MIXED = 205 * MiB, WS_H2 = 68 * MiB, WS_A = 141 * MiB, WS_DN = 68 * MiB, WS_END = 269 * MiB;
constexpr size_t DO_S = 0, DO_KTAB = 16 * MiB, DO_BC = 17 * MiB, DO_YB = 25 * MiB;
constexpr int NAP = 18;

struct P {
    const float* in[20];
    float* out;
    unsigned char* ws;
    unsigned long long use_cg_sync;
};

__device__ __forceinline__ float bf2f(unsigned v) { return __uint_as_float(v << 16); }
__device__ __forceinline__ unsigned f2bf(float f) { unsigned u = __float_as_uint(f); return (u + 0x7fffu + ((u >> 16) & 1u)) >> 16; }
__device__ __forceinline__ unsigned pk2(float lo, float hi) { return f2bf(lo) | (f2bf(hi) << 16); }
__device__ __forceinline__ float wave_sum(float v) {
#pragma unroll
    for (int o = 1; o < 64; o <<= 1) v += __shfl_xor(v, o);
    return v;
}
__device__ __forceinline__ float wave_max(float v) {
#pragma unroll
    for (int o = 1; o < 64; o <<= 1) v = fmaxf(v, __shfl_xor(v, o));
    return v;
}
__device__ __forceinline__ float sigmoidf_(float v) { return __builtin_amdgcn_rcpf(1.0f + __expf(-v)); }
__device__ __forceinline__ float gelu_tanh(float v) {
    const float z2 = 1.5957691216057308f * (v + 0.044715f * v * v * v);
    return v * __builtin_amdgcn_rcpf(1.0f + __expf(-z2));
}
__device__ __forceinline__ void sincos_d(double ang, float& s, float& c) {
    double rev = ang * 0.15915494309189535; rev -= rint(rev);
    const double q4 = rev * 4.0, qr = rint(q4); const int q = ((int)qr) & 3;
    const double th = (q4 - qr) * 1.5707963267948966, t2 = th * th;
    const double sn = th * (1.0 + t2 * (-1.0 / 6 + t2 * (1.0 / 120 + t2 * (-1.0 / 5040 + t2 * (1.0 / 362880 + t2 * (-1.0 / 39916800 + t2 * (1.0 / 6227020800.0)))))));
    const double cs = 1.0 + t2 * (-0.5 + t2 * (1.0 / 24 + t2 * (-1.0 / 720 + t2 * (1.0 / 40320 + t2 * (-1.0 / 3628800 + t2 * (1.0 / 479001600.0 + t2 * (-1.0 / 87178291200.0)))))));
    const double so = (q == 0) ? sn : (q == 1) ? cs : (q == 2) ? -sn : -cs;
    const double co = (q == 0) ? cs : (q == 1) ? -sn : (q == 2) ? -cs : sn;
    s = (float)so; c = (float)co;
}

struct TItem { const float* W; bf16_t* WT; int N, ldk, k0, n0, drow0; };
constexpr int TI_IN = 32 * 200, TI_GLU = 16 * 64, TI_BR = 16 * 64, TI_OUT = 32 * 64, TI_UP = 32 * 256, TI_DN = 128 * 64;
constexpr int TI_P0 = TI_IN + TI_GLU + 2 * TI_BR + TI_OUT, TI_ALL = TI_P0 + TI_UP + TI_DN;
__device__ __forceinline__ TItem titem(const P& p, int r) {
    unsigned char* ws = p.ws; TItem t;
    if (r < TI_IN) { const int nb = r % 200, kb = r / 200; t = TItem{p.in[5], (bf16_t*)(ws + WS_WIN), INW, 2048, 64 * kb, 32 * nb, 32 * nb}; return t; } r -= TI_IN;
    if (r < TI_GLU) { const int nb = r % 64, kb = r / 64, n0 = 32 * nb, bj = n0 >> 10, j = n0 & 1023, tt = j >> 7, jj = j & 127;
        t = TItem{p.in[15], (bf16_t*)(ws + WS_WGLU), 2048, 1024, 64 * kb, n0, 256 * tt + 128 * bj + jj}; return t; } r -= TI_GLU;
    if (r < TI_BR) { const int nb = r % 64, kb = r / 64; t = TItem{p.in[16], (bf16_t*)(ws + WS_WBRA), 2048, 1024, 64 * kb, 32 * nb, 32 * nb}; return t; } r -= TI_BR;
    if (r < TI_BR) { const int nb = r % 64, kb = r / 64; t = TItem{p.in[16] + (size_t)1024 * 2048, (bf16_t*)(ws + WS_WBRS), 2048, 1024, 64 * kb, 32 * nb, 32 * nb}; return t; } r -= TI_BR;
    if (r < TI_OUT) { const int nb = r % 64, kb = r / 64; t = TItem{p.in[17], (bf16_t*)(ws + WS_WOUT), 2048, 2048, 64 * kb, 32 * nb, 32 * nb}; return t; } r -= TI_OUT;
    if (r < TI_UP) { const int nb = r % 256, kb = r / 256; t = TItem{p.in[18], (bf16_t*)(ws + WS_WUP), DFF, 2048, 64 * kb, 32 * nb, 32 * nb}; return t; } r -= TI_UP;
    { const int nb = r % 64, kb = r / 64; t = TItem{p.in[19], (bf16_t*)(ws + WS_WDN), 2048, DFF, 64 * kb, 32 * nb, 32 * nb}; return t; }
}
__device__ __forceinline__ void titem_load(const TItem& t, f32x4 (&v)[8], int lane) {
#pragma unroll
    for (int i = 0; i < 8; ++i) v[i] = *(const f32x4*)(t.W + (size_t)(t.k0 + 8 * i + (lane >> 3)) * t.N + t.n0 + (lane & 7) * 4);
}
__device__ __forceinline__ void transpose_items(const P& p, int it0, int it1, int step, LAS float* scr, int lane) {
    if (it0 >= it1) return;
    TItem cur = titem(p, it0); f32x4 v[8]; titem_load(cur, v, lane);
    for (int it = it0; it < it1; it += step) {
        const bool more = it + step < it1;
        TItem nxt = cur; f32x4 nv[8];
        if (more) { nxt = titem(p, it + step); titem_load(nxt, nv, lane); }
#pragma unroll
        for (int i = 0; i < 8; ++i) { LAS float* d = scr + (8 * i + (lane >> 3)) * 33 + (lane & 7) * 4; d[0] = v[i].x; d[1] = v[i].y; d[2] = v[i].z; d[3] = v[i].w; }
        asm volatile("s_waitcnt lgkmcnt(0)" ::: "memory");
        const int c = lane & 7;
#pragma unroll
        for (int j = 0; j < 4; ++j) { const int n = (lane >> 3) + 8 * j; const LAS float* sp = scr + (8 * c) * 33 + n;
            u32x4 o; o.x = pk2(sp[0 * 33], sp[1 * 33]); o.y = pk2(sp[2 * 33], sp[3 * 33]); o.z = pk2(sp[4 * 33], sp[5 * 33]); o.w = pk2(sp[6 * 33], sp[7 * 33]);
            *(u32x4*)(cur.WT + (size_t)(cur.drow0 + n) * cur.ldk + cur.k0 + 8 * c) = o; }
        asm volatile("s_waitcnt lgkmcnt(0)" ::: "memory");
        if (more) { cur = nxt;
#pragma unroll
            for (int i = 0; i < 8; ++i) v[i] = nv[i]; }
    }
}
__device__ __forceinline__ int titem_fetch(unsigned* ctr, int base) {
    unsigned v = 0u; if ((threadIdx.x & 63) == 0) v = __hip_atomic_fetch_add(ctr, 1u, __ATOMIC_RELAXED, __HIP_MEMORY_SCOPE_AGENT);
    return base + (int)__builtin_amdgcn_readfirstlane(v);
}
__device__ __forceinline__ void transpose_items_dyn(const P& p, unsigned* ctr, int base, int it1, LAS float* scr, int lane) {
    int it = titem_fetch(ctr, base);
    if (it >= it1) return;
    TItem cur = titem(p, it); f32x4 v[8]; titem_load(cur, v, lane);
    for (;;) {
        const int nit = titem_fetch(ctr, base); const bool more = nit < it1;
        TItem nxt = cur; f32x4 nv[8];
        if (more) { nxt = titem(p, nit); titem_load(nxt, nv, lane); }
#pragma unroll
        for (int i = 0; i < 8; ++i) { LAS float* d = scr + (8 * i + (lane >> 3)) * 33 + (lane & 7) * 4; d[0] = v[i].x; d[1] = v[i].y; d[2] = v[i].z; d[3] = v[i].w; }
        asm volatile("s_waitcnt lgkmcnt(0)" ::: "memory");
        const int c = lane & 7;
#pragma unroll
        for (int j = 0; j < 4; ++j) { const int n = (lane >> 3) + 8 * j; const LAS float* sp = scr + (8 * c) * 33 + n;
            u32x4 o; o.x = pk2(sp[0 * 33], sp[1 * 33]); o.y = pk2(sp[2 * 33], sp[3 * 33]); o.z = pk2(sp[4 * 33], sp[5 * 33]); o.w = pk2(sp[6 * 33], sp[7 * 33]);
            *(u32x4*)(cur.WT + (size_t)(cur.drow0 + n) * cur.ldk + cur.k0 + 8 * c) = o; }
        asm volatile("s_waitcnt lgkmcnt(0)" ::: "memory");
        if (!more) break;
        cur = nxt;
#pragma unroll
        for (int i = 0; i < 8; ++i) v[i] = nv[i];
    }
}
__device__ __forceinline__ void rms_row_bf16(const float* xrow, const float* gain, bf16_t* orow, int lane) {
    f32x4 v[8]; float s = 0.f;
#pragma unroll
    for (int j = 0; j < 8; ++j) { v[j] = ((const f32x4*)xrow)[64 * j + lane]; s += v[j].x * v[j].x + v[j].y * v[j].y + v[j].z * v[j].z + v[j].w * v[j].w; }
    const float r = rsqrtf(wave_sum(s) * (1.0f / DM) + 1e-6f);
#pragma unroll
    for (int j = 0; j < 8; ++j) { const f32x4 g = ((const f32x4*)gain)[64 * j + lane]; const f32x4 o = v[j] * r * g;
        u32x2 w; w.x = pk2(o.x, o.y); w.y = pk2(o.z, o.w); ((u32x2*)orow)[64 * j + lane] = w; }
}

namespace pg8 {
typedef short bf16x8 __attribute__((ext_vector_type(8)));
constexpr int BM = 256, BK = 64, HALF = 128, HTB = HALF * BK * 2, STAGE_BYTES = 8 * HTB, NXCD = 8, WGM = 8;
__device__ __forceinline__ int lds_byte(int r, int c) { const int st = (r >> 4) * 2 + (c >> 5), rr = r & 15, cc = c & 31, ob = rr * 64 + cc * 2; return st * 1024 + (ob ^ (((ob >> 9) & 1) << 5)); }
__device__ __forceinline__ void stage_rc(int b, int& R, int& C) { const int st = b / 1024, sb = b % 1024, swz = sb ^ (((sb >> 9) & 1) << 5); R = (st >> 1) * 16 + swz / 64; C = (st & 1) * 32 + (swz % 64) / 2; }
__device__ __forceinline__ int perm32(int rho) { const int n = rho >> 4, i = rho & 15; return 8 * (i >> 2) + 4 * n + (i & 3); }

struct Unit { int pm, pn, b; };
struct Gemm { const bf16_t* A; const bf16_t* Bt; int M, N, K, lda, ldb, nb; size_t sA, sB; };

struct Order {
    int nM, nN, nwg, nb, G, c, maxi, base;
    __device__ void init(int M, int N, int nb_, int G_, int c_, int maxi_ = (1 << 30), int base_ = 0) { nM = M / BM; nN = N / BM; nwg = nM * nN; nb = nb_; G = G_; c = c_; maxi = maxi_; base = base_; }
    __device__ bool next(int i, Unit& u) const {
        if (i >= maxi) return false;
        const long L = (long)base + (long)i * G + c; if (L >= (long)nwg * nb) return false;
        u.b = (int)(L / nwg); int wgid = (int)(L % nwg);
        { const int q = nwg / NXCD, r = nwg % NXCD, xcd = wgid % NXCD, off = wgid / NXCD; wgid = (xcd < r ? xcd * (q + 1) : r * (q + 1) + (xcd - r) * q) + off; }
        const int nig = WGM * nN, gid = wgid / nig, fm = gid * WGM, gsz = (nM - fm) < WGM ? (nM - fm) : WGM;
        u.pm = fm + ((wgid % nig) % gsz); u.pn = (wgid % nig) / gsz; return true;
    }
};

template <class Epi>
__device__ __forceinline__ void gemm_phase(LAS unsigned char* lds, const Gemm g, const Order& S, const Epi& E, const int tid) {
    const int wid = __builtin_amdgcn_readfirstlane(tid >> 6), lane = tid & 63, wr = wid >> 2, wc = wid & 3, fr = lane & 15, fq = lane >> 4;
    int K_ = g.K; asm volatile("" : "+s"(K_));
    const int nt = K_ / BK;
    unsigned voffA[2], voffB[2];
#pragma unroll
    for (int i = 0; i < 2; ++i) { int R, C; stage_rc(tid * 16 + i * 8192, R, C); const int Rb = Epi::PERM ? ((R & ~31) + perm32(R & 31)) : R;
        voffA[i] = (unsigned)(R * g.lda + C) * 2u; voffB[i] = (unsigned)(Rb * g.ldb + C) * 2u; }
    const size_t kstep = (size_t)(BK * 2);
    const size_t hstepA = (size_t)HALF * g.lda * 2, tstepA = 2 * hstepA, hstepB = (size_t)HALF * g.ldb * 2, tstepB = 2 * hstepB;
    const unsigned ldsw = (unsigned)wid * 1024u;
    const int aoff = lds_byte(wr * 64 + fr, fq * 8), boff = lds_byte(wc * 32 + fr, fq * 8);
#define PG8_SA(b, h) (((b) * 2 + (h)) * HTB)
#define PG8_SB(b, h) ((4 + (b) * 2 + (h)) * HTB)
#define PG8_STAGE(bufoff, gbase, voff) do { _Pragma("unroll") for (int _i = 0; _i < 2; ++_i) \
        __builtin_amdgcn_global_load_lds((const unsigned*)((const char*)(gbase) + (voff)[_i]), (LAS unsigned*)(lds + (bufoff) + ldsw + _i * 8192), 16, 0, 0); } while (0)
#define PG8_LDA(dst, b, h) do { _Pragma("unroll") for (int m = 0; m < 4; ++m) _Pragma("unroll") for (int k = 0; k < 2; ++k) dst[m][k] = *(const LAS bf16x8*)(lds + PG8_SA(b, h) + aoff + m * 2048 + k * 1024); } while (0)
#define PG8_LDB(dst, b, h) do { _Pragma("unroll") for (int n = 0; n < 2; ++n) _Pragma("unroll") for (int k = 0; k < 2; ++k) dst[n][k] = *(const LAS bf16x8*)(lds + PG8_SB(b, h) + boff + n * 2048 + k * 1024); } while (0)
#define PG8_MMA(ai, bj, At, Bt) do { __builtin_amdgcn_s_setprio(1); _Pragma("unroll") for (int m = 0; m < 4; ++m) _Pragma("unroll") for (int n = 0; n < 2; ++n) _Pragma("unroll") for (int k = 0; k < 2; ++k) \
        acc[ai][bj][m][n] = __builtin_amdgcn_mfma_f32_16x16x32_bf16(Bt[n][k], At[m][k], acc[ai][bj][m][n], 0, 0, 0); __builtin_amdgcn_s_setprio(0); } while (0)
#define PG8_WAIT_V(n) asm volatile("s_waitcnt vmcnt(" #n ")" ::: "memory")
#define PG8_WAIT_L(n) asm volatile("s_waitcnt lgkmcnt(" #n ")" ::: "memory")
#define PG8_BAR __builtin_amdgcn_s_barrier()
#define PG8_SCHED __builtin_amdgcn_sched_barrier(0)
    Unit cur, nxt; int ui = 0;
    if (!S.next(0, cur)) return;
    f32x4 acc[2][2][4][2];
#pragma unroll
    for (int a = 0; a < 2; ++a)
#pragma unroll
        for (int b = 0; b < 2; ++b)
#pragma unroll
            for (int m = 0; m < 4; ++m)
#pragma unroll
                for (int n = 0; n < 2; ++n) acc[a][b][m][n] = (f32x4){0.f, 0.f, 0.f, 0.f};
    bf16x8 At[4][2], B0[2][2], B1[2][2];
    const char* cA = (const char*)g.A + (size_t)cur.b * g.sA * 2 + (size_t)cur.pm * tstepA; const char* cB = (const char*)g.Bt + (size_t)cur.b * g.sB * 2 + (size_t)cur.pn * tstepB;
    PG8_STAGE(PG8_SB(0, 0), cB, voffB); PG8_STAGE(PG8_SB(0, 1), cB + hstepB, voffB); PG8_STAGE(PG8_SA(0, 0), cA, voffA); PG8_STAGE(PG8_SA(0, 1), cA + hstepA, voffA);
    if (wr == 1) PG8_BAR;
    PG8_WAIT_V(2); PG8_BAR;
    PG8_STAGE(PG8_SB(1, 0), cB + kstep, voffB); PG8_STAGE(PG8_SA(1, 0), cA + kstep, voffA); PG8_STAGE(PG8_SB(1, 1), cB + hstepB + kstep, voffB);
    PG8_WAIT_V(6); PG8_BAR;
    for (;;) {
        const bool has_next = S.next(ui + 1, nxt);
        const char* nA = has_next ? (const char*)g.A + (size_t)nxt.b * g.sA * 2 + (size_t)nxt.pm * tstepA : cA;
        const char* nB = has_next ? (const char*)g.Bt + (size_t)nxt.b * g.sB * 2 + (size_t)nxt.pn * tstepB : cB;
        for (int t = 0; t < nt; t += 2) {
            const bool last = (t == nt - 2);
            const char* a1 = cA + (size_t)(t + 1) * kstep;
            const char* a2 = last ? nA : cA + (size_t)(t + 2) * kstep; const char* b2 = last ? nB : cB + (size_t)(t + 2) * kstep;
            const char* a3 = a2 + kstep; const char* b3 = b2 + kstep;
            PG8_LDB(B0, 0, 0); PG8_LDB(B1, 0, 1); PG8_SCHED; PG8_LDA(At, 0, 0); PG8_STAGE(PG8_SA(1, 1), a1 + hstepA, voffA);
            PG8_WAIT_V(8); PG8_WAIT_L(0); PG8_BAR; PG8_MMA(0, 0, At, B0); PG8_MMA(0, 1, At, B1); PG8_BAR; PG8_SCHED;
            PG8_LDA(At, 0, 1); PG8_STAGE(PG8_SB(0, 0), b2, voffB); PG8_STAGE(PG8_SB(0, 1), b2 + hstepB, voffB); PG8_STAGE(PG8_SA(0, 0), a2, voffA);
            PG8_WAIT_V(8); PG8_WAIT_L(0); PG8_BAR; PG8_MMA(1, 0, At, B0); PG8_MMA(1, 1, At, B1); PG8_BAR; PG8_SCHED;
            PG8_LDB(B0, 1, 0); PG8_LDB(B1, 1, 1); PG8_SCHED; PG8_LDA(At, 1, 0); PG8_STAGE(PG8_SA(0, 1), a2 + hstepA, voffA);
            PG8_WAIT_V(8); PG8_WAIT_L(0); PG8_BAR; PG8_MMA(0, 0, At, B0); PG8_MMA(0, 1, At, B1); PG8_BAR; PG8_SCHED;
            PG8_LDA(At, 1, 1); PG8_STAGE(PG8_SB(1, 0), b3, voffB); PG8_STAGE(PG8_SB(1, 1), b3 + hstepB, voffB); PG8_STAGE(PG8_SA(1, 0), a3, voffA);
            PG8_WAIT_V(8); PG8_WAIT_L(0); PG8_BAR; PG8_MMA(1, 0, At, B0); PG8_MMA(1, 1, At, B1); PG8_BAR; PG8_SCHED;
        }
        if (wr == 0) PG8_BAR;
        if constexpr (Epi::FUSED) E.fused(acc, cur, wr, wc, fr, fq); else E(acc, cur, wr, wc, fr, fq);
        if (!has_next) break;
        if (!(Epi::CHAIN && cur.b == 0)) {
#pragma unroll
        for (int a = 0; a < 2; ++a)
#pragma unroll
            for (int b = 0; b < 2; ++b)
#pragma unroll
                for (int m = 0; m < 4; ++m)
#pragma unroll
                    for (int n = 0; n < 2; ++n) acc[a][b][m][n] = (f32x4){0.f, 0.f, 0.f, 0.f};
        }
        cur = nxt; cA = nA; cB = nB; ++ui;
        if (wr == 1) PG8_BAR;
    }
    PG8_WAIT_V(0);
    PG8_BAR;
#undef PG8_SA
#undef PG8_SB
#undef PG8_STAGE
#undef PG8_LDA
#undef PG8_LDB
#undef PG8_MMA
#undef PG8_WAIT_V
#undef PG8_WAIT_L
#undef PG8_BAR
#undef PG8_SCHED
}
}

#define XB_TMO      128
#define XB_XCNT(j)  (256  + 64 * (j))
#define XB_XSUB(j)  (1280 + 64 * (j))
#define XB_XGEN(j)  (2304 + 64 * (j))
#define XB_TOP      3328
#define XB_TOPGEN   3392
#define XCD_BAR_WORDS 3456
#define XB_SPIN_CAP (1u << 22)
__device__ __forceinline__ unsigned xb_ld(unsigned* p)              { return __hip_atomic_load(p, __ATOMIC_RELAXED, __HIP_MEMORY_SCOPE_AGENT); }
__device__ __forceinline__ unsigned xb_add(unsigned* p, unsigned v) { return __hip_atomic_fetch_add(p, v, __ATOMIC_RELAXED, __HIP_MEMORY_SCOPE_AGENT); }
__device__ __forceinline__ unsigned xb_xcc_id() { return (unsigned)__builtin_amdgcn_s_getreg((3 << 11) | 20) & 0xFu; }
#define XB_SPIN(cond, bar) do { unsigned _sp = 0; while (cond) { __builtin_amdgcn_s_sleep(1); \
    if ((++_sp & 255u) == 0u) { if (xb_ld(&(bar)[XB_TMO])) break; if (_sp > XB_SPIN_CAP) { atomicAdd(&(bar)[XB_TMO], 1u); break; } } } } while (0)
struct XcdBarrier { unsigned* bar; unsigned x; volatile LAS unsigned* st; };
__device__ __forceinline__ XcdBarrier xcd_barrier_post(unsigned* bar, volatile LAS unsigned* st) {
    XcdBarrier b; b.bar = bar; b.x = xb_xcc_id(); b.st = st;
    if (threadIdx.x == 0) (void)xb_add(&bar[XB_XCNT(b.x)], 1u);
    return b;
}
__device__ __forceinline__ void xcd_barrier_complete(unsigned* bar, unsigned x, unsigned& nloc, unsigned& nx) {
    const unsigned G = gridDim.x * gridDim.y * gridDim.z;
    unsigned sum, cnt, mine, sp = 0u;
    for (;;) {
        sum = 0u; cnt = 0u; mine = 0u;
#pragma unroll
        for (unsigned j = 0; j < 16; ++j) { const unsigned c = xb_ld(&bar[XB_XCNT(j)]); sum += c; cnt += (c > 0u) ? 1u : 0u; mine = (j == x) ? c : mine; }
        if (sum == G) break;
        __builtin_amdgcn_s_sleep(1);
        if ((++sp & 255u) == 0u) { if (xb_ld(&bar[XB_TMO])) break; if (sp > XB_SPIN_CAP) { atomicAdd(&bar[XB_TMO], 1u); break; } }
    }
    nloc = mine > 0u ? mine : 1u; nx = cnt > 0u ? cnt : 1u;
}
__device__ __forceinline__ void xcd_barrier(const XcdBarrier& b) {
    asm volatile("s_waitcnt vmcnt(0)" ::: "memory");
    __syncthreads();
    if (threadIdx.x == 0) {
        unsigned* bar = b.bar;
        __builtin_amdgcn_s_waitcnt(0);
        unsigned nloc = b.st[0], nx = b.st[1];
        if (nloc == 0u) { xcd_barrier_complete(bar, b.x, nloc, nx); b.st[0] = nloc; b.st[1] = nx; }
        const unsigned old = xb_add(&bar[XB_XSUB(b.x)], 1u);
        const unsigned gen = old / nloc;
        if (old + 1u == (gen + 1u) * nloc) {
            __builtin_amdgcn_fence(__ATOMIC_RELEASE, "agent");
            asm volatile("s_waitcnt vmcnt(0)" ::: "memory");
            const unsigned og = xb_add(&bar[XB_TOP], 1u);
            const unsigned tg = og / nx;
            if (og + 1u == (tg + 1u) * nx) xb_add(&bar[XB_TOPGEN], 1u);
            else XB_SPIN(xb_ld(&bar[XB_TOPGEN]) == tg, bar);
            __builtin_amdgcn_fence(__ATOMIC_ACQUIRE, "agent");
            xb_add(&bar[XB_XGEN(b.x)], 1u);
            asm volatile("s_waitcnt vmcnt(0)" ::: "memory");
        } else {
            XB_SPIN(xb_ld(&bar[XB_XGEN(b.x)]) == gen, bar);
            __builtin_amdgcn_fence(__ATOMIC_ACQUIRE, "agent");
            asm volatile("s_waitcnt vmcnt(0)" ::: "memory");
        }
    }
    __syncthreads();
}

typedef f32x4 acc_t[2][2][4][2];
#define EPI_ROW(ai, m) (u.pm * 256 + (ai) * 128 + wr * 64 + (m) * 16 + fr)
__device__ __forceinline__ u32x4 pack8(const f32x4 a, const f32x4 b) { u32x4 w; w.x = pk2(a.x, a.y); w.y = pk2(a.z, a.w); w.z = pk2(b.x, b.y); w.w = pk2(b.z, b.w); return w; }
__device__ __forceinline__ f32x4 sig4(const f32x4 v) { f32x4 o; o.x = sigmoidf_(v.x); o.y = sigmoidf_(v.y); o.z = sigmoidf_(v.z); o.w = sigmoidf_(v.w); return o; }

struct EpiZf {
    static constexpr bool PERM = true, FUSED = false, CHAIN = false;
    bf16_t *q, *k, *vT, *ax, *ga, *gs; const float* rope;
    __device__ __forceinline__ void operator()(const acc_t& acc, const pg8::Unit& u, int wr, int wc, int fr, int fq) const {
        const int pn = u.pn;
#pragma unroll
        for (int ai = 0; ai < 2; ++ai)
#pragma unroll
            for (int m = 0; m < 4; ++m) {
                const int row = EPI_ROW(ai, m);
#pragma unroll
                for (int bj = 0; bj < 2; ++bj) {
                    f32x4 v0 = acc[ai][bj][m][0], v1 = acc[ai][bj][m][1];
                    const int cl = bj * 128 + wc * 32 + 8 * fq;
                    if (pn < 4 || (pn == 4 && bj == 0)) {
                        if ((wc & 1) == 0) {
                            f32x4 p0, p1;
                            p0.x = __shfl_xor(v0.x, 16); p0.y = __shfl_xor(v0.y, 16); p0.z = __shfl_xor(v0.z, 16); p0.w = __shfl_xor(v0.w, 16);
                            p1.x = __shfl_xor(v1.x, 16); p1.y = __shfl_xor(v1.y, 16); p1.z = __shfl_xor(v1.z, 16); p1.w = __shfl_xor(v1.w, 16);
                            if (fq < 2) {
                                const f32x4* rp = (const f32x4*)(rope + (size_t)row * 16);
                                const f32x4 r0 = rp[0], r1 = rp[1], r2 = rp[2], r3 = rp[3];
                                const float sg = (fq == 0) ? -1.f : 1.f;
                                v0.x = v0.x * r0.x + sg * p0.x * r0.y; v0.y = v0.y * r0.z + sg * p0.y * r0.w;
                                v0.z = v0.z * r1.x + sg * p0.z * r1.y; v0.w = v0.w * r1.z + sg * p0.w * r1.w;
                                v1.x = v1.x * r2.x + sg * p1.x * r2.y; v1.y = v1.y * r2.z + sg * p1.y * r2.w;
                                v1.z = v1.z * r3.x + sg * p1.z * r3.y; v1.w = v1.w * r3.z + sg * p1.w * r3.w;
                            }
                        }
                        bf16_t* dst = (pn < 4) ? (q + (size_t)row * 1024 + pn * 256 + cl) : (k + (size_t)row * 128 + cl);
                        *(u32x4*)dst = pack8(v0, v1);
                    } else if (pn == 4) {
                        bf16_t* dst = vT + (size_t)(cl - 128) * SEQ + row;
                        dst[0 * (size_t)SEQ] = (bf16_t)f2bf(v0.x); dst[1 * (size_t)SEQ] = (bf16_t)f2bf(v0.y); dst[2 * (size_t)SEQ] = (bf16_t)f2bf(v0.z); dst[3 * (size_t)SEQ] = (bf16_t)f2bf(v0.w);
                        dst[4 * (size_t)SEQ] = (bf16_t)f2bf(v1.x); dst[5 * (size_t)SEQ] = (bf16_t)f2bf(v1.y); dst[6 * (size_t)SEQ] = (bf16_t)f2bf(v1.z); dst[7 * (size_t)SEQ] = (bf16_t)f2bf(v1.w);
                    } else if (pn < 9) {
                        const int c = (pn - 5) * 256 + cl, g = c >> 4, ci0 = c & 15;
                        *(u32x4*)(ax + ((size_t)g * 512 + (row >> 4)) * 384 + (row & 15) * 16 + ci0) = pack8(v0, v1);
                    } else if (pn < 17) {
                        *(u32x4*)(ga + (size_t)row * 2048 + (pn - 9) * 256 + cl) = pack8(sig4(v0), sig4(v1));
                    } else {
                        *(u32x4*)(gs + (size_t)row * 2048 + (pn - 17) * 256 + cl) = pack8(sig4(v0), sig4(v1));
                    }
                }
            }
    }
};
struct EpiSf {
    static constexpr bool PERM = false, FUSED = false, CHAIN = false; float* S;
    __device__ __forceinline__ void operator()(const acc_t& acc, const pg8::Unit& u, int wr, int wc, int fr, int fq) const {
#pragma unroll
        for (int ai = 0; ai < 2; ++ai)
#pragma unroll
            for (int m = 0; m < 4; ++m) { const int row = EPI_ROW(ai, m);
#pragma unroll
                for (int n = 0; n < 2; ++n) *(f32x4*)(S + ((size_t)u.b * 512 + row) * 128 + wc * 32 + 16 * n + 4 * fq) = acc[ai][0][m][n]; }
    }
};
struct EpiYf {
    static constexpr bool PERM = true, FUSED = false, CHAIN = false; bf16_t* y;
    __device__ __forceinline__ void operator()(const acc_t& acc, const pg8::Unit& u, int wr, int wc, int fr, int fq) const {
#pragma unroll
        for (int ai = 0; ai < 2; ++ai)
#pragma unroll
            for (int m = 0; m < 4; ++m) { const int row = EPI_ROW(ai, m);
#pragma unroll
                for (int bj = 0; bj < 2; ++bj) { const int c = bj * 128 + wc * 32 + 8 * fq, t = c >> 4, co0 = c & 15;
                    const f32x4 a0 = acc[ai][bj][m][0], a1 = acc[ai][bj][m][1];
                    u32x4 w; w.x = pk2(gelu_tanh(a0.x), gelu_tanh(a0.y)); w.y = pk2(gelu_tanh(a0.z), gelu_tanh(a0.w)); w.z = pk2(gelu_tanh(a1.x), gelu_tanh(a1.y)); w.w = pk2(gelu_tanh(a1.z), gelu_tanh(a1.w));
                    *(u32x4*)(y + (unsigned)((row * 16 + t) * 1024 + u.b * 16 + co0)) = w;
                    asm volatile("" ::: "memory"); } }
    }
};
struct EpiGLUf {
    static constexpr bool PERM = true, FUSED = false, CHAIN = false; bf16_t* o;
    __device__ __forceinline__ void operator()(const acc_t& acc, const pg8::Unit& u, int wr, int wc, int fr, int fq) const {
#pragma unroll
        for (int ai = 0; ai < 2; ++ai)
#pragma unroll
            for (int m = 0; m < 4; ++m) { const int row = EPI_ROW(ai, m);
                const f32x4 v0 = acc[ai][0][m][0] * sig4(acc[ai][1][m][0]), v1 = acc[ai][0][m][1] * sig4(acc[ai][1][m][1]);
                *(u32x4*)(o + (size_t)row * 1024 + u.pn * 128 + wc * 32 + 8 * fq) = pack8(v0, v1); }
    }
};
__device__ __forceinline__ f32x4 ld_bf4(const bf16_t* p) { const u32x2 w = *(const u32x2*)p; f32x4 o; o.x = bf2f(w.x & 0xffffu); o.y = bf2f(w.x >> 16); o.z = bf2f(w.y & 0xffffu); o.w = bf2f(w.y >> 16); return o; }
__device__ __forceinline__ void ld_bf8(const bf16_t* p, f32x4& lo, f32x4& hi) { const u32x4 w = *(const u32x4*)p;
    lo.x = bf2f(w.x & 0xffffu); lo.y = bf2f(w.x >> 16); lo.z = bf2f(w.y & 0xffffu); lo.w = bf2f(w.y >> 16); hi.x = bf2f(w.z & 0xffffu); hi.y = bf2f(w.z >> 16); hi.z = bf2f(w.w & 0xffffu); hi.w = bf2f(w.w >> 16); }
struct EpiBrF {
    static constexpr bool PERM = true, FUSED = true, CHAIN = true; const bf16_t* ga; const bf16_t* gs; bf16_t* mo;
    __device__ __forceinline__ void fused(acc_t& acc, const pg8::Unit& u, int wr, int wc, int fr, int fq) const {
#pragma unroll
        for (int ai = 0; ai < 2; ++ai)
#pragma unroll
            for (int m = 0; m < 4; ++m) { const int row = EPI_ROW(ai, m);
#pragma unroll
                for (int bj = 0; bj < 2; ++bj) { const unsigned o = (unsigned)(row * 2048 + u.pn * 256 + bj * 128 + wc * 32 + 8 * fq); f32x4 s0, s1; ld_bf8(gs + o, s0, s1);
                    if (u.b == 0) { f32x4 a0, a1; ld_bf8(ga + o, a0, a1);
                        f32x4 r0, r1; r0.x = a0.x * __builtin_amdgcn_rcpf(fmaxf(s0.x, 1e-30f)); r0.y = a0.y * __builtin_amdgcn_rcpf(fmaxf(s0.y, 1e-30f)); r0.z = a0.z * __builtin_amdgcn_rcpf(fmaxf(s0.z, 1e-30f)); r0.w = a0.w * __builtin_amdgcn_rcpf(fmaxf(s0.w, 1e-30f));
                        r1.x = a1.x * __builtin_amdgcn_rcpf(fmaxf(s1.x, 1e-30f)); r1.y = a1.y * __builtin_amdgcn_rcpf(fmaxf(s1.y, 1e-30f)); r1.z = a1.z * __builtin_amdgcn_rcpf(fmaxf(s1.z, 1e-30f)); r1.w = a1.w * __builtin_amdgcn_rcpf(fmaxf(s1.w, 1e-30f));
                        acc[ai][bj][m][0] = acc[ai][bj][m][0] * r0; acc[ai][bj][m][1] = acc[ai][bj][m][1] * r1; }
                    else *(u32x4*)(mo + o) = pack8(acc[ai][bj][m][0] * s0, acc[ai][bj][m][1] * s1); } }
    }
};
struct EpiT1f {
    static constexpr bool PERM = true, FUSED = false, CHAIN = false; f32x4* t1; const bf16_t* ga; int tid;
    __device__ __forceinline__ void operator()(const acc_t& acc, const pg8::Unit& u, int wr, int wc, int fr, int fq) const {
        f32x4* base = t1 + (size_t)(u.pm * 8 + u.pn) * 32 * 512 + tid;
#pragma unroll
        for (int ai = 0; ai < 2; ++ai)
#pragma unroll
            for (int m = 0; m < 4; ++m) { const int row = EPI_ROW(ai, m);
#pragma unroll
                for (int bj = 0; bj < 2; ++bj) { const int col = u.pn * 256 + bj * 128 + wc * 32 + 8 * fq; f32x4 g0, g1; ld_bf8(ga + (size_t)row * 2048 + col, g0, g1);
                    base[(((ai * 2 + bj) * 4 + m) * 2 + 0) * 512] = g0 * acc[ai][bj][m][0]; base[(((ai * 2 + bj) * 4 + m) * 2 + 1) * 512] = g1 * acc[ai][bj][m][1]; } }
    }
};
struct EpiMf {
    static constexpr bool PERM = true, FUSED = false, CHAIN = false; const f32x4* t1; const bf16_t* gs; bf16_t* mo; int tid;
    __device__ __forceinline__ void operator()(const acc_t& acc, const pg8::Unit& u, int wr, int wc, int fr, int fq) const {
        const f32x4* base = t1 + (size_t)(u.pm * 8 + u.pn) * 32 * 512 + tid;
#pragma unroll
        for (int ai = 0; ai < 2; ++ai)
#pragma unroll
            for (int m = 0; m < 4; ++m) { const int row = EPI_ROW(ai, m);
#pragma unroll
                for (int bj = 0; bj < 2; ++bj) { const int col = u.pn * 256 + bj * 128 + wc * 32 + 8 * fq; f32x4 g0, g1; ld_bf8(gs + (size_t)row * 2048 + col, g0, g1);
                    const f32x4 v0 = base[(((ai * 2 + bj) * 4 + m) * 2 + 0) * 512] + g0 * acc[ai][bj][m][0], v1 = base[(((ai * 2 + bj) * 4 + m) * 2 + 1) * 512] + g1 * acc[ai][bj][m][1];
                    *(u32x4*)(mo + (size_t)row * 2048 + col) = pack8(v0, v1); } }
    }
};
struct EpiF32f {
    static constexpr bool PERM = false, FUSED = false, CHAIN = false; float* o;
    __device__ __forceinline__ void operator()(const acc_t& acc, const pg8::Unit& u, int wr, int wc, int fr, int fq) const {
#pragma unroll
        for (int ai = 0; ai < 2; ++ai)
#pragma unroll
            for (int m = 0; m < 4; ++m) { const int row = EPI_ROW(ai, m);
#pragma unroll
                for (int bj = 0; bj < 2; ++bj)
#pragma unroll
                    for (int n = 0; n < 2; ++n) *(f32x4*)(o + (size_t)row * 2048 + u.pn * 256 + bj * 128 + wc * 32 + 16 * n + 4 * fq) = acc[ai][bj][m][n]; }
    }
};
struct EpiUpf {
    static constexpr bool PERM = true, FUSED = false, CHAIN = false; bf16_t* a; const float* part2;
    __device__ __forceinline__ void operator()(const acc_t& acc, const pg8::Unit& u, int wr, int wc, int fr, int fq) const {
#pragma unroll
        for (int ai = 0; ai < 2; ++ai)
#pragma unroll
            for (int m = 0; m < 4; ++m) { const int row = EPI_ROW(ai, m);
                const f32x4* pp = (const f32x4*)(part2 + (size_t)row * 32 + fq * 8); const f32x4 pa = pp[0], pb = pp[1];
                float ss = ((pa.x + pa.y) + (pa.z + pa.w)) + ((pb.x + pb.y) + (pb.z + pb.w)); ss += __shfl_xor(ss, 16); ss += __shfl_xor(ss, 32);
                const float ri = rsqrtf(ss * (1.0f / DM) + 1e-6f);
#pragma unroll
                for (int bj = 0; bj < 2; ++bj) {
                    f32x4 v0 = acc[ai][bj][m][0] * ri, v1 = acc[ai][bj][m][1] * ri;
                    v0.x = fmaxf(v0.x, 0.f); v0.y = fmaxf(v0.y, 0.f); v0.z = fmaxf(v0.z, 0.f); v0.w = fmaxf(v0.w, 0.f);
                    v1.x = fmaxf(v1.x, 0.f); v1.y = fmaxf(v1.y, 0.f); v1.z = fmaxf(v1.z, 0.f); v1.w = fmaxf(v1.w, 0.f);
                    *(u32x4*)(a + (size_t)row * DFF + u.pn * 256 + bj * 128 + wc * 32 + 8 * fq) = pack8(v0 * v0, v1 * v1); } }
    }
};

__device__ __forceinline__ void row_partials(const acc_t& acc, float* part, const pg8::Unit& u, int wr, int wc, int fr, int fq) {
#pragma unroll
    for (int ai = 0; ai < 2; ++ai)
#pragma unroll
        for (int m = 0; m < 4; ++m) {
            float s = 0.f;
#pragma unroll
            for (int bj = 0; bj < 2; ++bj)
#pragma unroll
                for (int n = 0; n < 2; ++n) { const f32x4 v = acc[ai][bj][m][n]; s += (v.x * v.x + v.y * v.y) + (v.z * v.z + v.w * v.w); }
            s += __shfl_xor(s, 16); s += __shfl_xor(s, 32);
            if (fq == 0) part[(size_t)EPI_ROW(ai, m) * 32 + u.pn * 4 + wc] = s;
        }
}
__device__ __forceinline__ void row_rinv(const float* part, float (&rinv)[2][4], const pg8::Unit& u, int wr, int fr, int fq) {
#pragma unroll
    for (int ai = 0; ai < 2; ++ai)
#pragma unroll
        for (int m = 0; m < 4; ++m) {
            const f32x4* pp = (const f32x4*)(part + (size_t)EPI_ROW(ai, m) * 32 + fq * 8);
            const f32x4 a = pp[0], b = pp[1];
            float s = ((a.x + a.y) + (a.z + a.w)) + ((b.x + b.y) + (b.z + b.w));
            s += __shfl_xor(s, 16); s += __shfl_xor(s, 32);
            rinv[ai][m] = rsqrtf(s * (1.0f / DM) + 1e-6f);
        }
}
struct EpiOutNormF {
    static constexpr bool PERM = true, FUSED = true, CHAIN = false;
    const float* x; const float* g1; const float* g2; float* x1; bf16_t* h2; float* part1; float* part2; XcdBarrier xb;
    __device__ __forceinline__ void fused(acc_t& acc, const pg8::Unit& u, int wr, int wc, int fr, int fq) const {
        float rinv[2][4];
        row_partials(acc, part1, u, wr, wc, fr, fq);
        xcd_barrier(xb);
        row_rinv(part1, rinv, u, wr, fr, fq);
#pragma unroll
        for (int bj = 0; bj < 2; ++bj) { const int col = u.pn * 256 + bj * 128 + wc * 32 + 8 * fq;
            const f32x4 ga0 = *(const f32x4*)(g1 + col), ga1 = *(const f32x4*)(g1 + col + 4), gb0 = *(const f32x4*)(g2 + col), gb1 = *(const f32x4*)(g2 + col + 4);
#pragma unroll
            for (int ai = 0; ai < 2; ++ai)
#pragma unroll
              for (int mh = 0; mh < 2; ++mh) {
                f32x4 xv[2][2];
#pragma unroll
                for (int mm = 0; mm < 2; ++mm) { const unsigned o = (unsigned)(EPI_ROW(ai, 2 * mh + mm) * DM + col); xv[mm][0] = *(const f32x4*)(x + o); xv[mm][1] = *(const f32x4*)(x + o + 4); }
#pragma unroll
                for (int mm = 0; mm < 2; ++mm) { const int m = 2 * mh + mm; const unsigned o = (unsigned)(EPI_ROW(ai, m) * DM + col);
                    const f32x4 v0 = xv[mm][0] + acc[ai][bj][m][0] * rinv[ai][m] * ga0, v1 = xv[mm][1] + acc[ai][bj][m][1] * rinv[ai][m] * ga1;
                    acc[ai][bj][m][0] = v0; acc[ai][bj][m][1] = v1; *(f32x4*)(x1 + o) = v0; *(f32x4*)(x1 + o + 4) = v1; *(u32x4*)(h2 + o) = pack8(v0 * gb0, v1 * gb1); }
#pragma unroll
                for (int mm = 0; mm < 2; ++mm) asm volatile("" : "+v"(acc[ai][bj][2 * mh + mm][0]), "+v"(acc[ai][bj][2 * mh + mm][1]));
                asm volatile("" ::: "memory"); } }
        row_partials(acc, part2, u, wr, wc, fr, fq);
    }
};
struct EpiDownNormF {
    static constexpr bool PERM = true, FUSED = true, CHAIN = false;
    const float* g; float* x1; float* part; XcdBarrier xb;
    __device__ __forceinline__ void fused(acc_t& acc, const pg8::Unit& u, int wr, int wc, int fr, int fq) const {
        float rinv[2][4];
        row_partials(acc, part, u, wr, wc, fr, fq);
        xcd_barrier(xb);
        row_rinv(part, rinv, u, wr, fr, fq);
#pragma unroll
        for (int bj = 0; bj < 2; ++bj) { const int col = u.pn * 256 + bj * 128 + wc * 32 + 8 * fq;
            const f32x4 g0 = *(const f32x4*)(g + col), g1 = *(const f32x4*)(g + col + 4);
#pragma unroll
            for (int ai = 0; ai < 2; ++ai)
#pragma unroll
                for (int m = 0; m < 4; ++m) { float* o = x1 + (unsigned)(EPI_ROW(ai, m) * DM + col);
                    const f32x4 a0 = *(const f32x4*)o, a1 = *(const f32x4*)(o + 4);
                    *(f32x4*)o = a0 + acc[ai][bj][m][0] * rinv[ai][m] * g0; *(f32x4*)(o + 4) = a1 + acc[ai][bj][m][1] * rinv[ai][m] * g1; } }
    }
};

typedef float f32x16 __attribute__((ext_vector_type(16)));
typedef short s16x8 __attribute__((ext_vector_type(8)));
constexpr int ATT_KROW = 144, ATT_VROW = 336, ATT_VOFF = 160 * ATT_KROW;
__device__ __forceinline__ void attn_stage(LAS unsigned char* lds, const bf16_t* Kb, const bf16_t* VT, const int q0, const int hk, const int tid) {
    for (int c = tid; c < 1280; c += 512) {
        const int row = c >> 3, ch = c & 7, key = q0 - 128 + row;
        u32x4 v = {0u, 0u, 0u, 0u}; if (key >= 0) v = *(const u32x4*)(Kb + (size_t)key * 128 + hk * 64 + ch * 8);
        *(LAS u32x4*)(lds + row * ATT_KROW + ch * 16) = v;
        const int d = c / 20, cc = c % 20, k0 = q0 - 128 + cc * 8;
        u32x4 w = {0u, 0u, 0u, 0u}; if (k0 >= 0) w = *(const u32x4*)(VT + (size_t)(hk * 64 + d) * SEQ + k0);
        *(LAS u32x4*)(lds + ATT_VOFF + d * ATT_VROW + cc * 16) = w;
    }
}
__device__ __forceinline__ void attn_item(LAS unsigned char* lds, const bf16_t* Q, bf16_t* O, const float sink, const int q0, const int h, const int lane) {
    const int r = lane & 31, hf = lane >> 5;
    s16x8 qf[4];
#pragma unroll
    for (int kk = 0; kk < 4; ++kk) qf[kk] = *(const s16x8*)(Q + (size_t)(q0 + r) * 1024 + h * 64 + 16 * kk + 8 * hf);
    f32x16 st[5];
#pragma unroll
    for (int kt = 0; kt < 5; ++kt) {
        f32x16 a = {0.f, 0.f, 0.f, 0.f, 0.f, 0.f, 0.f, 0.f, 0.f, 0.f, 0.f, 0.f, 0.f, 0.f, 0.f, 0.f};
#pragma unroll
        for (int kk = 0; kk < 4; ++kk) {
            const s16x8 kf = *(const LAS s16x8*)(lds + (32 * kt + r) * ATT_KROW + (16 * kk + 8 * hf) * 2);
            a = __builtin_amdgcn_mfma_f32_32x32x16_bf16(kf, qf[kk], a, 0, 0, 0);
        }
        st[kt] = a;
    }
    float mx = sink;
#pragma unroll
    for (int kt = 0; kt < 5; ++kt)
#pragma unroll
        for (int e = 0; e < 16; ++e) {
            const int kofs = -128 + 32 * kt + (e & 3) + 8 * (e >> 2) + 4 * hf;
            const int diff = r - kofs;
            const bool ok = (diff >= 0) && (diff < 128) && (q0 + kofs >= 0);
            const float sv = ok ? st[kt][e] * 0.125f : -1e30f;
            st[kt][e] = sv; mx = fmaxf(mx, sv);
        }
    mx = fmaxf(mx, __shfl_xor(mx, 32));
    float sum = 0.f;
#pragma unroll
    for (int kt = 0; kt < 5; ++kt)
#pragma unroll
        for (int e = 0; e < 16; ++e) { const float pv = (st[kt][e] > -1e29f) ? __expf(st[kt][e] - mx) : 0.f; st[kt][e] = pv; sum += pv; }
    sum += __shfl_xor(sum, 32);
    sum += __expf(sink - mx);
    const float inv = 1.0f / sum;
    f32x16 o0 = {0.f, 0.f, 0.f, 0.f, 0.f, 0.f, 0.f, 0.f, 0.f, 0.f, 0.f, 0.f, 0.f, 0.f, 0.f, 0.f}, o1 = o0;
#pragma unroll
    for (int kt = 0; kt < 5; ++kt)
#pragma unroll
        for (int s = 0; s < 2; ++s) {
            u32x4 pw; pw.x = pk2(st[kt][8 * s + 0], st[kt][8 * s + 1]); pw.y = pk2(st[kt][8 * s + 2], st[kt][8 * s + 3]);
            pw.z = pk2(st[kt][8 * s + 4], st[kt][8 * s + 5]); pw.w = pk2(st[kt][8 * s + 6], st[kt][8 * s + 7]);
            const s16x8 pf = __builtin_bit_cast(s16x8, pw);
#pragma unroll
            for (int dt = 0; dt < 2; ++dt) {
                const LAS unsigned char* vp = lds + ATT_VOFF + (32 * dt + r) * ATT_VROW + (32 * kt + 16 * s + 4 * hf) * 2;
                const u32x2 a0 = *(const LAS u32x2*)vp, a1 = *(const LAS u32x2*)(vp + 16);
                u32x4 vw; vw.x = a0.x; vw.y = a0.y; vw.z = a1.x; vw.w = a1.y;
                const s16x8 vf = __builtin_bit_cast(s16x8, vw);
                if (dt == 0) o0 = __builtin_amdgcn_mfma_f32_32x32x16_bf16(vf, pf, o0, 0, 0, 0);
                else o1 = __builtin_amdgcn_mfma_f32_32x32x16_bf16(vf, pf, o1, 0, 0, 0);
            }
        }
    bf16_t* op = O + (size_t)(q0 + r) * 1024 + h * 64 + 4 * hf;
#pragma unroll
    for (int i = 0; i < 4; ++i) {
        u32x2 w; w.x = pk2(o0[4 * i] * inv, o0[4 * i + 1] * inv); w.y = pk2(o0[4 * i + 2] * inv, o0[4 * i + 3] * inv); *(u32x2*)(op + 8 * i) = w;
        u32x2 w1; w1.x = pk2(o1[4 * i] * inv, o1[4 * i + 1] * inv); w1.y = pk2(o1[4 * i + 2] * inv, o1[4 * i + 3] * inv); *(u32x2*)(op + 32 + 8 * i) = w1;
    }
}

constexpr int NPHASE = 8;

#ifndef PROBE_PH
#define PROBE_PH -1
#endif
template <int PH, int REP = 1>
__device__ __forceinline__ void run_phase(const P& p, LAS unsigned char* lds, const XcdBarrier& xb) {
    int tid_ = threadIdx.x; asm volatile("" : "+v"(tid_));
    const int tid = tid_, lane = tid & 63, wave = tid >> 6;
    int bid_ = blockIdx.x; asm volatile("" : "+s"(bid_));
    const int bid = bid_;
    const int G = gridDim.x, gw = bid * 8 + wave, NGW = G * 8;
    const size_t gt = (size_t)bid * 512 + tid, NGT = (size_t)G * 512;
    unsigned char* ws = p.ws; unsigned char* dout = (unsigned char*)p.out;
    asm volatile("" : "+s"(ws), "+s"(dout));
    float* PART1 = (float*)(ws + WS_PART1); float* PART2 = (float*)(ws + WS_PART2);
    float2* AP = (float2*)(ws + WS_AP); float2* BBAR = (float2*)(ws + WS_BBAR); float2* ROPE = (float2*)(ws + WS_ROPE);
    bf16_t* WUP = (bf16_t*)(ws + WS_WUP); bf16_t* WDN = (bf16_t*)(ws + WS_WDN); bf16_t* WIN = (bf16_t*)(ws + WS_WIN); bf16_t* WGLU = (bf16_t*)(ws + WS_WGLU);
    bf16_t* WBRA = (bf16_t*)(ws + WS_WBRA); bf16_t* WBRS = (bf16_t*)(ws + WS_WBRS); bf16_t* WOUT = (bf16_t*)(ws + WS_WOUT);
    bf16_t* H = (bf16_t*)(ws + WS_H); bf16_t* OATT = (bf16_t*)(ws + WS_OATT); bf16_t* Q = (bf16_t*)(ws + WS_Q); bf16_t* OSSM = (bf16_t*)(ws + WS_OSSM);
    bf16_t* Kb = (bf16_t*)(ws + WS_K); bf16_t* VT = (bf16_t*)(ws + WS_VT); bf16_t* AX = (bf16_t*)(ws + WS_AX); bf16_t* Y = (bf16_t*)(ws + WS_Y);
    bf16_t* Mb = (bf16_t*)(ws + WS_M); bf16_t* GA = (bf16_t*)(ws + WS_GA); bf16_t* GS = (bf16_t*)(ws + WS_GS); float* MIXED = (float*)(ws + WS_MIXED);
    bf16_t* H2 = (bf16_t*)(ws + WS_H2); bf16_t* Ab = (bf16_t*)(ws + WS_A); float* DN = (float*)(ws + WS_DN);
    float* S = (float*)(dout + DO_S); float* KTAB = (float*)(dout + DO_KTAB); bf16_t* BC = (bf16_t*)(dout + DO_BC); bf16_t* YB = (bf16_t*)(dout + DO_YB);
    float* T1 = (float*)dout; float* X1 = (float*)dout;
    const float* x = p.in[0];

    if constexpr (PH == 0) {
        LAS float* scr = (LAS float*)(lds + wave * 16384);
        transpose_items(p, gw, TI_IN, NGW, scr, lane);
        if (gw < SEQ) {
            f32x4 v[8];
#pragma unroll
            for (int j = 0; j < 8; ++j) v[j] = ((const f32x4*)(x + (size_t)gw * DM))[64 * j + lane];
            for (int m = gw; m < SEQ; m += NGW) {
                const bool more = m + NGW < SEQ; f32x4 nv[8];
                if (more) {
#pragma unroll
                    for (int j = 0; j < 8; ++j) nv[j] = ((const f32x4*)(x + (size_t)(m + NGW) * DM))[64 * j + lane]; }
                float ss = 0.f;
#pragma unroll
                for (int j = 0; j < 8; ++j) ss += v[j].x * v[j].x + v[j].y * v[j].y + v[j].z * v[j].z + v[j].w * v[j].w;
                const float rr = rsqrtf(wave_sum(ss) * (1.0f / DM) + 1e-6f);
#pragma unroll
                for (int j = 0; j < 8; ++j) { const f32x4 g = ((const f32x4*)p.in[1])[64 * j + lane]; const f32x4 o = v[j] * rr * g;
                    u32x2 w; w.x = pk2(o.x, o.y); w.y = pk2(o.z, o.w); ((u32x2*)(H + (size_t)m * DM))[64 * j + lane] = w; }
                if (more) {
#pragma unroll
                    for (int j = 0; j < 8; ++j) v[j] = nv[j]; }
            }
        }
        for (size_t e = gt; e < (size_t)NG * SP * NAP; e += NGT) {
            const int i = (int)(e / NAP), n = (int)(e % NAP), g = i / SP;
            const double dt = exp((double)p.in[9][g]), lr = (double)p.in[7][i], li = (double)p.in[8][i];
            const double pw = (n == 17) ? 1024.0 : (double)n;
            const float mag = (float)exp(pw * lr * dt); float sn, cs; sincos_d(pw * li * dt, sn, cs);
            AP[((size_t)g * NAP + n) * SP + (i % SP)] = make_float2(mag * cs, mag * sn);
        }
        for (size_t e = gt; e < (size_t)NG * SP * GC; e += NGT) {
            const int i = (int)(e >> 4), g = i / SP;
            const double dt = exp((double)p.in[9][g]), lr = (double)p.in[7][i], li = (double)p.in[8][i];
            float s1, c1; sincos_d(li * dt, s1, c1);
            const double mag1 = exp(lr * dt), are = mag1 * (double)c1, aim = mag1 * (double)s1;
            const double nr = are - 1.0, ni = aim, den = lr * lr + li * li;
            const double cre = (nr * lr + ni * li) / den, cim = (ni * lr - nr * li) / den;
            const double br = (double)p.in[10][e], bi = (double)p.in[11][e];
            BBAR[e] = make_float2((float)(cre * br - cim * bi), (float)(cre * bi + cim * br));
        }
        for (size_t i = gt; i < (size_t)SEQ * 8; i += NGT) {
            const int pos = (int)(i >> 3), k = (int)(i & 7);
            const double inv = exp(-(double)k * 0.125 * 13.122363377404328);
            float s, c; sincos_d((double)pos * inv, s, c);
            ROPE[i] = make_float2(c, s);
        }
        }
    if constexpr (PH == 1) {
        { pg8::Gemm g{H, WIN, SEQ, INW, DM, DM, DM, 1, 0, 0}; pg8::Order S; S.init(SEQ, INW, 1, G, bid, 3);
          EpiZf E{Q, Kb, VT, AX, GA, GS, (const float*)ROPE}; pg8::gemm_phase(lds, g, S, E, tid); }
        for (size_t e = gt; e < (size_t)NG * 256 * 32; e += NGT) {
            const int g = (int)(e >> 13), r = (int)(e >> 5) & 255, k8 = (int)e & 31, s_ = k8 >> 1, ci0 = (k8 & 1) * 8;
            u32x4 w = {0u, 0u, 0u, 0u};
            if (r < 128) { const int pp = r & 63; const float2 a = AP[((size_t)g * NAP + 15 - s_) * SP + pp];
                const f32x4* bp = (const f32x4*)(BBAR + ((size_t)g * SP + pp) * GC + ci0); const f32x4 b0 = bp[0], b1 = bp[1], b2 = bp[2], b3 = bp[3];
                if (r >> 6) { w.x = pk2(a.x * b0.y + a.y * b0.x, a.x * b0.w + a.y * b0.z); w.y = pk2(a.x * b1.y + a.y * b1.x, a.x * b1.w + a.y * b1.z);
                              w.z = pk2(a.x * b2.y + a.y * b2.x, a.x * b2.w + a.y * b2.z); w.w = pk2(a.x * b3.y + a.y * b3.x, a.x * b3.w + a.y * b3.z); }
                else {        w.x = pk2(a.x * b0.x - a.y * b0.y, a.x * b0.z - a.y * b0.w); w.y = pk2(a.x * b1.x - a.y * b1.y, a.x * b1.z - a.y * b1.w);
                              w.z = pk2(a.x * b2.x - a.y * b2.y, a.x * b2.z - a.y * b2.w); w.w = pk2(a.x * b3.x - a.y * b3.y, a.x * b3.z - a.y * b3.w); } }
            *(u32x4*)(BC + e * 8) = w;
        }
        for (size_t e = gt; e < (size_t)NG * 256 * 16; e += NGT) {
            const int g = (int)(e >> 12), row = (int)(e >> 4) & 255, r0 = ((int)e & 15) * 8, t = row >> 4, co = row & 15, pp0 = r0 & 63;
            const f32x4* ap = (const f32x4*)(AP + ((size_t)g * NAP + t + 1) * SP + pp0); const f32x4 a0 = ap[0], a1 = ap[1], a2 = ap[2], a3 = ap[3];
            const f32x4* crp = (const f32x4*)(p.in[12] + ((size_t)g * GC + co) * SP + pp0); const f32x4* cip = (const f32x4*)(p.in[13] + ((size_t)g * GC + co) * SP + pp0);
            const f32x4 cr0 = crp[0], cr1 = crp[1], ci0 = cip[0], ci1 = cip[1];
            u32x4 w;
            if (r0 >> 6) { w.x = pk2(-(cr0.x * a0.y + ci0.x * a0.x), -(cr0.y * a0.w + ci0.y * a0.z)); w.y = pk2(-(cr0.z * a1.y + ci0.z * a1.x), -(cr0.w * a1.w + ci0.w * a1.z));
                           w.z = pk2(-(cr1.x * a2.y + ci1.x * a2.x), -(cr1.y * a2.w + ci1.y * a2.z)); w.w = pk2(-(cr1.z * a3.y + ci1.z * a3.x), -(cr1.w * a3.w + ci1.w * a3.z)); }
            else {         w.x = pk2(cr0.x * a0.x - ci0.x * a0.y, cr0.y * a0.z - ci0.y * a0.w); w.y = pk2(cr0.z * a1.x - ci0.z * a1.y, cr0.w * a1.z - ci0.w * a1.w);
                           w.z = pk2(cr1.x * a2.x - ci1.x * a2.y, cr1.y * a2.z - ci1.y * a2.w); w.w = pk2(cr1.z * a3.x - ci1.z * a3.y, cr1.w * a3.z - ci1.w * a3.w); }
            *(u32x4*)(YB + ((size_t)g * 256 + row) * 384 + 256 + r0) = w;
        }
        {
            LAS float* Cre = (LAS float*)lds; LAS float* Cim = Cre + 16 * 65; LAS float* APr = Cim + 16 * 65; LAS float* APi = APr + 256; LAS float* Bbr = APi + 256; LAS float* Bbi = Bbr + 1024;
            for (int item = bid; item < NG * 4; item += G) {
                const int g = item >> 2, tq = item & 3;
                __syncthreads();
                for (int i = tid; i < 1024; i += 512) { Cre[(i >> 6) * 65 + (i & 63)] = p.in[12][(size_t)g * 1024 + i]; Cim[(i >> 6) * 65 + (i & 63)] = p.in[13][(size_t)g * 1024 + i];
                    const float2 b = BBAR[(size_t)g * 1024 + i]; Bbr[i] = b.x; Bbi[i] = b.y; }
                if (tid < 256) { const float2 a = AP[((size_t)g * NAP + 4 * tq + (tid >> 6)) * SP + (tid & 63)]; APr[tid] = a.x; APi[tid] = a.y; }
                __syncthreads();
#pragma unroll
                for (int rr = 0; rr < 2; ++rr) {
                    const int idx = tid + 512 * rr, tl = idx >> 8, co = (idx >> 4) & 15, ci = idx & 15;
                    float acc = 0.f;
#pragma unroll 8
                    for (int pp = 0; pp < SP; ++pp) {
                        const float cr = Cre[co * 65 + pp], cim = Cim[co * 65 + pp], ax = APr[tl * 64 + pp], ay = APi[tl * 64 + pp];
                        const float wre = cr * ax - cim * ay, wim = cr * ay + cim * ax;
                        acc += wre * Bbr[pp * 16 + ci] - wim * Bbi[pp * 16 + ci];
                    }
                    const int tau = 4 * tq + tl;
                    if (tau == 0 && co == ci) acc += p.in[14][g * GC + co];
                    KTAB[(((size_t)g * 16 + tau) * 16 + co) * 16 + ci] = acc;
                }
            }
            __syncthreads();
        }
        }
    if constexpr (PH == 2) {
        if (bid < NG) {
            const int g = bid;
            for (int e = tid; e < 256 * 32; e += 512) {
                const int row = e >> 5, k8 = e & 31, s_ = k8 >> 1, ci0 = (k8 & 1) * 8, t = row >> 4, co = row & 15;
                u32x4 w = {0u, 0u, 0u, 0u};
                if (t >= s_) { const f32x4* kp = (const f32x4*)(KTAB + (((size_t)g * 16 + (t - s_)) * 16 + co) * 16 + ci0); w = pack8(kp[0], kp[1]); }
                *(u32x4*)(YB + ((size_t)g * 256 + row) * 384 + 8 * k8) = w;
            }
            { pg8::Gemm gm{AX, BC, 512, 256, 256, 384, 256, NG, (size_t)512 * 384, (size_t)256 * 256}; pg8::Order S_; S_.init(512, 256, NG, 1, 0, 2, 2 * g);
              EpiSf E{S}; pg8::gemm_phase(lds, gm, S_, E, tid); }
            asm volatile("s_waitcnt vmcnt(0)" ::: "memory"); __syncthreads();
        LAS float* Elr = (LAS float*)lds; LAS float* Eli = Elr + 512;
        {
            const int pp = tid & 63, seg = tid >> 6;
            const float2 A16 = AP[((size_t)g * NAP + 16) * SP + pp], A1k = AP[((size_t)g * NAP + 17) * SP + pp];
            const float* Sg = S + (size_t)g * 512 * 128;
            float lre = 0.f, lim = 0.f;
            for (int j0 = seg * 64; j0 < seg * 64 + 64; j0 += 16) {
                float sr[16], si[16];
#pragma unroll
                for (int q = 0; q < 16; ++q) { sr[q] = Sg[(j0 + q) * 128 + pp]; si[q] = Sg[(j0 + q) * 128 + 64 + pp]; }
#pragma unroll
                for (int q = 0; q < 16; ++q) { const float nr = A16.x * lre - A16.y * lim + sr[q], ni = A16.x * lim + A16.y * lre + si[q]; lre = nr; lim = ni; }
            }
            __syncthreads();
            Elr[seg * 64 + pp] = lre; Eli[seg * 64 + pp] = lim;
            __syncthreads();
            float cre = 0.f, cim = 0.f;
            for (int s2 = 0; s2 < seg; ++s2) { const float2 e = make_float2(Elr[s2 * 64 + pp], Eli[s2 * 64 + pp]);
                const float nr = A1k.x * cre - A1k.y * cim + e.x, ni = A1k.x * cim + A1k.y * cre + e.y; cre = nr; cim = ni; }
            for (int j0 = seg * 64; j0 < seg * 64 + 64; j0 += 16) {
                float sr[16], si[16];
#pragma unroll
                for (int q = 0; q < 16; ++q) { sr[q] = Sg[(j0 + q) * 128 + pp]; si[q] = Sg[(j0 + q) * 128 + 64 + pp]; }
#pragma unroll
                for (int q = 0; q < 16; ++q) {
                    bf16_t* axr = AX + ((size_t)g * 512 + j0 + q) * 384 + 256;
                    axr[pp] = (bf16_t)f2bf(cre); axr[64 + pp] = (bf16_t)f2bf(cim);
                    const float nr = A16.x * cre - A16.y * cim + sr[q], ni = A16.x * cim + A16.y * cre + si[q]; cre = nr; cim = ni; }
            }
            }
            asm volatile("s_waitcnt vmcnt(0)" ::: "memory"); __syncthreads();
            { pg8::Gemm gm{AX, YB, 512, 256, 384, 384, 384, NG, (size_t)512 * 384, (size_t)256 * 384}; pg8::Order S_; S_.init(512, 256, NG, 1, 0, 2, 2 * g);
              EpiYf E{Y}; pg8::gemm_phase(lds, gm, S_, E, tid); }
        } else if (bid < 96) {
            pg8::Gemm gm{H, WIN, SEQ, INW, DM, DM, DM, 1, 0, 0}; pg8::Order S_; S_.init(SEQ, INW, 1, 1 << 20, bid - 64, 1, 768);
            EpiZf E{Q, Kb, VT, AX, GA, GS, (const float*)ROPE}; pg8::gemm_phase(lds, gm, S_, E, tid);
        } else {
            for (int item = bid - 96; item < 512; item += G - 96) {
                const int hk = item & 1, q0 = (item >> 1) * 32, h = hk * 8 + wave;
                __syncthreads();
                attn_stage(lds, Kb, VT, q0, hk, tid);
                __syncthreads();
                attn_item(lds, Q, OATT, p.in[6][h], q0, h, lane);
            }
        }
        {
            unsigned* ctr = (unsigned*)(ws + WS_CTL + 14336); volatile LAS int* slot = (volatile LAS int*)(lds + 131072 + 64);
            for (;;) {
                __syncthreads();
                if (tid == 0) slot[0] = TI_IN + (int)__hip_atomic_fetch_add(ctr, 32u, __ATOMIC_RELAXED, __HIP_MEMORY_SCOPE_AGENT);
                __syncthreads();
                const int base = slot[0];
                if (base >= TI_ALL) break;
                const int i0 = base + wave * 4, i1 = (i0 + 4 < TI_ALL) ? i0 + 4 : TI_ALL;
                transpose_items(p, i0, i1, 1, (LAS float*)(lds + wave * 16384), lane);
            }
        }
    }
    if constexpr (PH == 3) { pg8::Gemm g{Y, WGLU, SEQ, 2048, 1024, 1024, 1024, 1, 0, 0}; pg8::Order S_; S_.init(SEQ, 2048, 1, G, bid);
        EpiGLUf E{OSSM}; pg8::gemm_phase(lds, g, S_, E, tid); }
    if constexpr (PH == 4) {
        pg8::Gemm g{OATT, WBRA, SEQ, 2048, 1024, 1024, 1024, 2, (size_t)(OSSM - OATT), (size_t)(WBRS - WBRA)}; pg8::Order S_; S_.init(SEQ, 2048, 2, G, bid);
        EpiBrF E{GA, GS, Mb}; pg8::gemm_phase(lds, g, S_, E, tid);
    }
    if constexpr (PH == 5) { pg8::Gemm g{Mb, WOUT, SEQ, 2048, 2048, 2048, 2048, 1, 0, 0}; pg8::Order S_; S_.init(SEQ, 2048, 1, G, bid);
        EpiOutNormF E{x, p.in[2], p.in[3], X1, H2, PART1, PART2, xb}; pg8::gemm_phase(lds, g, S_, E, tid); }
    if constexpr (PH == 6) { pg8::Gemm g{H2, WUP, SEQ, DFF, DM, DM, DM, 1, 0, 0}; pg8::Order S_; S_.init(SEQ, DFF, 1, G, bid);
        EpiUpf E{Ab, PART2}; pg8::gemm_phase(lds, g, S_, E, tid); }
    if constexpr (PH == 7) { pg8::Gemm g{Ab, WDN, SEQ, DM, DFF, DFF, DFF, 1, 0, 0}; pg8::Order S_; S_.init(SEQ, DM, 1, G, bid);
        EpiDownNormF E{p.in[4], X1, PART1, xb}; pg8::gemm_phase(lds, g, S_, E, tid); }
}

constexpr int LDS_BYTES = 147456;

#ifndef TPROBE
#define TPROBE -1
#endif
template <int PH>
__device__ __forceinline__ void run_all(const P& p, LAS unsigned char* lds, cg::grid_group& grid, const XcdBarrier& xb, volatile LAS unsigned* misc) {
    if constexpr (PH == PROBE_PH) { run_phase<PH, 0>(p, lds, xb); xcd_barrier(xb); }
    run_phase<PH>(p, lds, xb);
    if constexpr (PH + 1 < NPHASE) {
        if constexpr (PH == 0) { if (p.use_cg_sync) grid.sync(); else xcd_barrier(xb); } else xcd_barrier(xb);
        if constexpr (TPROBE >= 0) { if (blockIdx.x == 0 && threadIdx.x == 0) misc[4 + PH + 1] = (unsigned)__builtin_amdgcn_s_memrealtime(); }
        run_all<PH + 1>(p, lds, grid, xb, misc);
    }
}
__global__ void __launch_bounds__(512, 2) k_all(P p) {
    extern __shared__ __attribute__((aligned(16))) unsigned char lds_raw[];
    cg::grid_group grid = cg::this_grid();
    LAS unsigned char* lds = (LAS unsigned char*)lds_raw;
    volatile LAS unsigned* misc = (volatile LAS unsigned*)(lds + 131072);
    if (threadIdx.x < 2) misc[threadIdx.x] = 0u;
    __syncthreads();
    const XcdBarrier xb = xcd_barrier_post((unsigned*)(p.ws + WS_CTL), misc);
    if constexpr (TPROBE >= 0) { if (blockIdx.x == 0 && threadIdx.x == 0) misc[4] = (unsigned)__builtin_amdgcn_s_memrealtime(); }
    run_all<0>(p, lds, grid, xb, misc);
    if constexpr (TPROBE >= 0) {
        if (blockIdx.x == 0 && threadIdx.x == 0) {
            const unsigned now = (unsigned)__builtin_amdgcn_s_memrealtime(); misc[4 + NPHASE] = now;
            const unsigned d = misc[4 + TPROBE + 1] - misc[4 + TPROBE];
            while ((unsigned)__builtin_amdgcn_s_memrealtime() - now < 8u * d) __builtin_amdgcn_s_sleep(8);
        }
    }
}

extern "C" void kernel_launch(void* const* d_in, const int* in_sizes, int n_in, void* d_out, int out_size, void* d_ws, size_t ws_size, hipStream_t stream) {
    static int grid = 0;
    if (grid == 0) {
        if (n_in != 20 || out_size != SEQ * DM || ws_size < WS_END) { fprintf(stderr, "kernel_launch: unexpected shapes (n_in %d out %d ws %zu)\n", n_in, out_size, ws_size); grid = -1; return; }
        int dev = 0, cus = 0;
        (void)hipGetDevice(&dev); (void)hipDeviceGetAttribute(&cus, hipDeviceAttributeMultiprocessorCount, dev);
        (void)hipFuncSetAttribute((const void*)k_all, hipFuncAttributeMaxDynamicSharedMemorySize, LDS_BYTES);
        int per_cu = 0;
        (void)hipOccupancyMaxActiveBlocksPerMultiprocessor(&per_cu, (const void*)k_all, 512, LDS_BYTES);
        if (per_cu < 1) fprintf(stderr, "kernel_launch: occupancy query says %d blocks/CU\n", per_cu);
        (void)hipGetLastError();
        if (cus != 256) { fprintf(stderr, "kernel_launch: built for a 256-CU device (one 512-thread workgroup per CU, one 256x256 tile per workgroup in the fused-norm GEMM phases); found %d CUs\n", cus); grid = -1; return; }
        grid = cus;
    }
    if (grid < 0) return;
    P p{};
    for (int i = 0; i < 20; ++i) p.in[i] = (const float*)d_in[i];
    p.out = (float*)d_out; p.ws = (unsigned char*)d_ws;
    (void)hipMemsetAsync((char*)d_ws + WS_CTL, 0, CTL_BYTES, stream);
    void* args[] = {&p};
    hipError_t e = hipLaunchCooperativeKernel((const void*)k_all, dim3(grid), dim3(512), args, LDS_BYTES, stream);
    if (e != hipSuccess) fprintf(stderr, "cooperative launch failed: %s (grid %d)\n", hipGetErrorString(e), grid);
}
```

```cpp
#include <hip/hip_runtime.h>
#include <hip/hip_cooperative_groups.h>
#include <cstdio>
#include <cstdint>
namespace cg = cooperative_groups;


typedef unsigned short bf16_t;
typedef float f32x4 __attribute__((ext_vector_type(4)));
typedef unsigned u32x2 __attribute__((ext_vector_type(2)));
typedef unsigned u32x4 __attribute__((ext_vector_type(4)));
#define LAS __attribute__((address_space(3)))

constexpr int SEQ = 8192, DM = 2048, INW = 6400, QW = 1024, SSMW = 1024, DFF = 8192;
constexpr int NG = 64, GC = 16, SP = 64, NH = 16;
constexpr size_t MiB = 1u << 20;
constexpr size_t WS_AP = 0, WS_BBAR = 1 * MiB, WS_ROPE = 1 * MiB + 512 * 1024, WS_CTL = 2 * MiB, CTL_BYTES = 16384, WS_PART1 = 3 * MiB, WS_PART2 = 0;
constexpr size_t WS_WUP = 4 * MiB, WS_WDN = 36 * MiB, WS_WIN = 68 * MiB, WS_WGLU = 93 * MiB, WS_WBRA = 97 * MiB, WS_WBRS = 101 * MiB, WS_WOUT = 105 * MiB;
constexpr size_t WS_H = 113 * MiB, WS_OSSM = 113 * MiB  , WS_Q = 145 * MiB, WS_OATT = 145 * MiB  , WS_K = 161 * MiB, WS_VT = 163 * MiB, WS_AX = 165 * MiB, WS_Y = 189 * MiB;
constexpr size_t WS_M = 161 * MiB, WS_GA = 205 * MiB, WS_GS = 237 * MiB, WS_MIXED = 205 * MiB, WS_H2 = 68 * MiB, WS_A = 141 * MiB, WS_DN = 68 * MiB, WS_END = 269 * MiB;
constexpr size_t DO_S = 0, DO_KTAB = 16 * MiB, DO_BC = 17 * MiB, DO_YB = 25 * MiB;
constexpr int NAP = 18;

struct P {
    const float* in[20];
    float* out;
    unsigned char* ws;
    unsigned long long use_cg_sync;
};

__device__ __forceinline__ float bf2f(unsigned v) { return __uint_as_float(v << 16); }
__device__ __forceinline__ unsigned f2bf(float f) { unsigned u = __float_as_uint(f); return (u + 0x7fffu + ((u >> 16) & 1u)) >> 16; }
__device__ __forceinline__ unsigned pk2(float lo, float hi) { return f2bf(lo) | (f2bf(hi) << 16); }
__device__ __forceinline__ float wave_sum(float v) {
#pragma unroll
    for (int o = 1; o < 64; o <<= 1) v += __shfl_xor(v, o);
    return v;
}
__device__ __forceinline__ float wave_max(float v) {
#pragma unroll
    for (int o = 1; o < 64; o <<= 1) v = fmaxf(v, __shfl_xor(v, o));
    return v;
}
__device__ __forceinline__ float sigmoidf_(float v) { return __builtin_amdgcn_rcpf(1.0f + __expf(-v)); }
__device__ __forceinline__ float gelu_tanh(float v) {
    const float z2 = 1.5957691216057308f * (v + 0.044715f * v * v * v);
    return v * __builtin_amdgcn_rcpf(1.0f + __expf(-z2));
}
__device__ __forceinline__ void sincos_d(double ang, float& s, float& c) {
    double rev = ang * 0.15915494309189535; rev -= rint(rev);
    const double q4 = rev * 4.0, qr = rint(q4); const int q = ((int)qr) & 3;
    const double th = (q4 - qr) * 1.5707963267948966, t2 = th * th;
    const double sn = th * (1.0 + t2 * (-1.0 / 6 + t2 * (1.0 / 120 + t2 * (-1.0 / 5040 + t2 * (1.0 / 362880 + t2 * (-1.0 / 39916800 + t2 * (1.0 / 6227020800.0)))))));
    const double cs = 1.0 + t2 * (-0.5 + t2 * (1.0 / 24 + t2 * (-1.0 / 720 + t2 * (1.0 / 40320 + t2 * (-1.0 / 3628800 + t2 * (1.0 / 479001600.0 + t2 * (-1.0 / 87178291200.0)))))));
    const double so = (q == 0) ? sn : (q == 1) ? cs : (q == 2) ? -sn : -cs;
    const double co = (q == 0) ? cs : (q == 1) ? -sn : (q == 2) ? -cs : sn;
    s = (float)so; c = (float)co;
}

struct TItem { const float* W; bf16_t* WT; int N, ldk, k0, n0, drow0; };
constexpr int TI_IN = 32 * 200, TI_GLU = 16 * 64, TI_BR = 16 * 64, TI_OUT = 32 * 64, TI_UP = 32 * 256, TI_DN = 128 * 64;
constexpr int TI_P0 = TI_IN + TI_GLU + 2 * TI_BR + TI_OUT, TI_ALL = TI_P0 + TI_UP + TI_DN;
__device__ __forceinline__ void tdecode(int r, int ncols, int& kb, int& nb) { const int st = r >> 5, c = r & 31, sn = ncols >> 8; kb = 4 * (st / sn) + (c & 3); nb = 8 * (st % sn) + (c >> 2); }
__device__ __forceinline__ TItem titem(const P& p, int r) {
    unsigned char* ws = p.ws; TItem t; int kb, nb;
    if (r < TI_IN) { tdecode(r, INW, kb, nb); t = TItem{p.in[5], (bf16_t*)(ws + WS_WIN), INW, 2048, 64 * kb, 32 * nb, 32 * nb}; return t; } r -= TI_IN;
    if (r < TI_GLU) { tdecode(r, 2048, kb, nb); const int n0 = 32 * nb, bj = n0 >> 10, j = n0 & 1023, tt = j >> 7, jj = j & 127;
        t = TItem{p.in[15], (bf16_t*)(ws + WS_WGLU), 2048, 1024, 64 * kb, n0, 256 * tt + 128 * bj + jj}; return t; } r -= TI_GLU;
    if (r < TI_BR) { tdecode(r, 2048, kb, nb); t = TItem{p.in[16], (bf16_t*)(ws + WS_WBRA), 2048, 1024, 64 * kb, 32 * nb, 32 * nb}; return t; } r -= TI_BR;
    if (r < TI_BR) { tdecode(r, 2048, kb, nb); t = TItem{p.in[16] + (size_t)1024 * 2048, (bf16_t*)(ws + WS_WBRS), 2048, 1024, 64 * kb, 32 * nb, 32 * nb}; return t; } r -= TI_BR;
    if (r < TI_OUT) { tdecode(r, 2048, kb, nb); t = TItem{p.in[17], (bf16_t*)(ws + WS_WOUT), 2048, 2048, 64 * kb, 32 * nb, 32 * nb}; return t; } r -= TI_OUT;
    if (r < TI_UP) { tdecode(r, DFF, kb, nb); t = TItem{p.in[18], (bf16_t*)(ws + WS_WUP), DFF, 2048, 64 * kb, 32 * nb, 32 * nb}; return t; } r -= TI_UP;
    { tdecode(r, 2048, kb, nb); t = TItem{p.in[19], (bf16_t*)(ws + WS_WDN), 2048, DFF, 64 * kb, 32 * nb, 32 * nb}; return t; }
}
__device__ __forceinline__ void titem_load(const TItem& t, f32x4 (&v)[8], int lane) {
#pragma unroll
    for (int i = 0; i < 8; ++i) v[i] = *(const f32x4*)(t.W + (size_t)(t.k0 + 8 * i + (lane >> 3)) * t.N + t.n0 + (lane & 7) * 4);
}
__device__ __forceinline__ void transpose_items(const P& p, int it0, int it1, int step, LAS float* scr, int lane) {
    if (it0 >= it1) return;
    TItem cur = titem(p, it0); f32x4 v[8]; titem_load(cur, v, lane);
    for (int it = it0; it < it1; it += step) {
        const bool more = it + step < it1;
        TItem nxt = cur; f32x4 nv[8];
        if (more) { nxt = titem(p, it + step); titem_load(nxt, nv, lane); }
#pragma unroll
        for (int i = 0; i < 8; ++i) { LAS float* d = scr + (8 * i + (lane >> 3)) * 33 + (lane & 7) * 4; d[0] = v[i].x; d[1] = v[i].y; d[2] = v[i].z; d[3] = v[i].w; }
        asm volatile("s_waitcnt lgkmcnt(0)" ::: "memory");
        const int c = lane & 7;
#pragma unroll
        for (int j = 0; j < 4; ++j) { const int n = (lane >> 3) + 8 * j; const LAS float* sp = scr + (8 * c) * 33 + n;
            u32x4 o; o.x = pk2(sp[0 * 33], sp[1 * 33]); o.y = pk2(sp[2 * 33], sp[3 * 33]); o.z = pk2(sp[4 * 33], sp[5 * 33]); o.w = pk2(sp[6 * 33], sp[7 * 33]);
            *(u32x4*)(cur.WT + (size_t)(cur.drow0 + n) * cur.ldk + cur.k0 + 8 * c) = o; }
        asm volatile("s_waitcnt lgkmcnt(0)" ::: "memory");
        if (more) { cur = nxt;
#pragma unroll
            for (int i = 0; i < 8; ++i) v[i] = nv[i]; }
    }
}
__device__ __forceinline__ int titem_fetch(unsigned* ctr, int base) {
    unsigned v = 0u; if ((threadIdx.x & 63) == 0) v = __hip_atomic_fetch_add(ctr, 1u, __ATOMIC_RELAXED, __HIP_MEMORY_SCOPE_AGENT);
    return base + (int)__builtin_amdgcn_readfirstlane(v);
}
__device__ __forceinline__ void transpose_items_dyn(const P& p, unsigned* ctr, int base, int it1, LAS float* scr, int lane) {
    int it = titem_fetch(ctr, base);
    if (it >= it1) return;
    TItem cur = titem(p, it); f32x4 v[8]; titem_load(cur, v, lane);
    for (;;) {
        const int nit = titem_fetch(ctr, base); const bool more = nit < it1;
        TItem nxt = cur; f32x4 nv[8];
        if (more) { nxt = titem(p, nit); titem_load(nxt, nv, lane); }
#pragma unroll
        for (int i = 0; i < 8; ++i) { LAS float* d = scr + (8 * i + (lane >> 3)) * 33 + (lane & 7) * 4; d[0] = v[i].x; d[1] = v[i].y; d[2] = v[i].z; d[3] = v[i].w; }
        asm volatile("s_waitcnt lgkmcnt(0)" ::: "memory");
        const int c = lane & 7;
#pragma unroll
        for (int j = 0; j < 4; ++j) { const int n = (lane >> 3) + 8 * j; const LAS float* sp = scr + (8 * c) * 33 + n;
            u32x4 o; o.x = pk2(sp[0 * 33], sp[1 * 33]); o.y = pk2(sp[2 * 33], sp[3 * 33]); o.z = pk2(sp[4 * 33], sp[5 * 33]); o.w = pk2(sp[6 * 33], sp[7 * 33]);
            *(u32x4*)(cur.WT + (size_t)(cur.drow0 + n) * cur.ldk + cur.k0 + 8 * c) = o; }
        asm volatile("s_waitcnt lgkmcnt(0)" ::: "memory");
        if (!more) break;
        cur = nxt;
#pragma unroll
        for (int i = 0; i < 8; ++i) v[i] = nv[i];
    }
}
__device__ __forceinline__ void transpose_quad(const P& p, int i0, LAS float* scr, int lane) {
    TItem t[4]; f32x4 v[4][8];
#pragma unroll
    for (int q = 0; q < 4; ++q) { t[q] = titem(p, i0 + q); titem_load(t[q], v[q], lane); }
#pragma unroll
    for (int q = 0; q < 4; ++q) {
#pragma unroll
        for (int i = 0; i < 8; ++i) { LAS float* d = scr + (8 * i + (lane >> 3)) * 33 + (lane & 7) * 4; d[0] = v[q][i].x; d[1] = v[q][i].y; d[2] = v[q][i].z; d[3] = v[q][i].w; }
        asm volatile("s_waitcnt lgkmcnt(0)" ::: "memory");
        const int c = lane & 7;
#pragma unroll
        for (int j = 0; j < 4; ++j) { const int n = (lane >> 3) + 8 * j; const LAS float* sp = scr + (8 * c) * 33 + n;
            u32x4 o; o.x = pk2(sp[0 * 33], sp[1 * 33]); o.y = pk2(sp[2 * 33], sp[3 * 33]); o.z = pk2(sp[4 * 33], sp[5 * 33]); o.w = pk2(sp[6 * 33], sp[7 * 33]);
            *(u32x4*)(t[q].WT + (size_t)(t[q].drow0 + n) * t[q].ldk + t[q].k0 + 8 * c) = o; }
        asm volatile("s_waitcnt lgkmcnt(0)" ::: "memory");
    }
}
__device__ __forceinline__ void rms_row_bf16(const float* xrow, const float* gain, bf16_t* orow, int lane) {
    f32x4 v[8]; float s = 0.f;
#pragma unroll
    for (int j = 0; j < 8; ++j) { v[j] = ((const f32x4*)xrow)[64 * j + lane]; s += v[j].x * v[j].x + v[j].y * v[j].y + v[j].z * v[j].z + v[j].w * v[j].w; }
    const float r = rsqrtf(wave_sum(s) * (1.0f / DM) + 1e-6f);
#pragma unroll
    for (int j = 0; j < 8; ++j) { const f32x4 g = ((const f32x4*)gain)[64 * j + lane]; const f32x4 o = v[j] * r * g;
        u32x2 w; w.x = pk2(o.x, o.y); w.y = pk2(o.z, o.w); ((u32x2*)orow)[64 * j + lane] = w; }
}

namespace pg8 {
typedef short bf16x8 __attribute__((ext_vector_type(8)));
constexpr int BM = 256, BK = 64, HALF = 128, HTB = HALF * BK * 2, STAGE_BYTES = 8 * HTB, NXCD = 8, WGM = 8;
__device__ __forceinline__ int lds_byte(int r, int c) { const int st = (r >> 4) * 2 + (c >> 5), rr = r & 15, cc = c & 31, ob = rr * 64 + cc * 2; return st * 1024 + (ob ^ (((ob >> 9) & 1) << 5)); }
__device__ __forceinline__ void stage_rc(int b, int& R, int& C) { const int st = b / 1024, sb = b % 1024, swz = sb ^ (((sb >> 9) & 1) << 5); R = (st >> 1) * 16 + swz / 64; C = (st & 1) * 32 + (swz % 64) / 2; }
__device__ __forceinline__ int perm32(int rho) { const int n = rho >> 4, i = rho & 15; return 8 * (i >> 2) + 4 * n + (i & 3); }

struct Unit { int pm, pn, b; };
struct Gemm { const bf16_t* A; const bf16_t* Bt; int M, N, K, lda, ldb, nb; size_t sA, sB; };

struct Order {
    int nM, nN, nwg, nb, G, c, maxi, base;
    __device__ void init(int M, int N, int nb_, int G_, int c_, int maxi_ = (1 << 30), int base_ = 0) { nM = M / BM; nN = N / BM; nwg = nM * nN; nb = nb_; G = G_; c = c_; maxi = maxi_; base = base_; }
    __device__ bool next(int i, Unit& u) const {
        if (i >= maxi) return false;
        const long L = (long)base + (long)i * G + c; if (L >= (long)nwg * nb) return false;
        u.b = (int)(L / nwg); int wgid = (int)(L % nwg);
        { const int q = nwg / NXCD, r = nwg % NXCD, xcd = wgid % NXCD, off = wgid / NXCD; wgid = (xcd < r ? xcd * (q + 1) : r * (q + 1) + (xcd - r) * q) + off; }
        const int nig = WGM * nN, gid = wgid / nig, fm = gid * WGM, gsz = (nM - fm) < WGM ? (nM - fm) : WGM;
        u.pm = fm + ((wgid % nig) % gsz); u.pn = (wgid % nig) / gsz; return true;
    }
};

template <class Epi>
__device__ __forceinline__ void gemm_phase(LAS unsigned char* lds, const Gemm g, const Order& S, const Epi& E, const int tid) {
    const int wid = __builtin_amdgcn_readfirstlane(tid >> 6), lane = tid & 63, wr = wid >> 2, wc = wid & 3, fr = lane & 15, fq = lane >> 4;
    int K_ = g.K; asm volatile("" : "+s"(K_));
    const int nt = K_ / BK;
    unsigned voffA[2], voffB[2];
#pragma unroll
    for (int i = 0; i < 2; ++i) { int R, C; stage_rc(tid * 16 + i * 8192, R, C); const int Rb = Epi::PERM ? ((R & ~31) + perm32(R & 31)) : R;
        voffA[i] = (unsigned)(R * g.lda + C) * 2u; voffB[i] = (unsigned)(Rb * g.ldb + C) * 2u; }
    const size_t kstep = (size_t)(BK * 2);
    const size_t hstepA = (size_t)HALF * g.lda * 2, tstepA = 2 * hstepA, hstepB = (size_t)HALF * g.ldb * 2, tstepB = 2 * hstepB;
    const unsigned ldsw = (unsigned)wid * 1024u;
    const int aoff = lds_byte(wr * 64 + fr, fq * 8), boff = lds_byte(wc * 32 + fr, fq * 8);
#define PG8_SA(b, h) (((b) * 2 + (h)) * HTB)
#define PG8_SB(b, h) ((4 + (b) * 2 + (h)) * HTB)
#define PG8_STAGE(bufoff, gbase, voff) do { _Pragma("unroll") for (int _i = 0; _i < 2; ++_i) \
        __builtin_amdgcn_global_load_lds((const unsigned*)((const char*)(gbase) + (voff)[_i]), (LAS unsigned*)(lds + (bufoff) + ldsw + _i * 8192), 16, 0, 0); } while (0)
#define PG8_LDA(dst, b, h) do { _Pragma("unroll") for (int m = 0; m < 4; ++m) _Pragma("unroll") for (int k = 0; k < 2; ++k) dst[m][k] = *(const LAS bf16x8*)(lds + PG8_SA(b, h) + aoff + m * 2048 + k * 1024); } while (0)
#define PG8_LDB(dst, b, h) do { _Pragma("unroll") for (int n = 0; n < 2; ++n) _Pragma("unroll") for (int k = 0; k < 2; ++k) dst[n][k] = *(const LAS bf16x8*)(lds + PG8_SB(b, h) + boff + n * 2048 + k * 1024); } while (0)
#define PG8_MMA(ai, bj, At, Bt) do { __builtin_amdgcn_s_setprio(1); _Pragma("unroll") for (int m = 0; m < 4; ++m) _Pragma("unroll") for (int n = 0; n < 2; ++n) _Pragma("unroll") for (int k = 0; k < 2; ++k) \
        acc[ai][bj][m][n] = __builtin_amdgcn_mfma_f32_16x16x32_bf16(Bt[n][k], At[m][k], acc[ai][bj][m][n], 0, 0, 0); __builtin_amdgcn_s_setprio(0); } while (0)
#define PG8_WAIT_V(n) asm volatile("s_waitcnt vmcnt(" #n ")" ::: "memory")
#define PG8_WAIT_L(n) asm volatile("s_waitcnt lgkmcnt(" #n ")" ::: "memory")
#define PG8_BAR __builtin_amdgcn_s_barrier()
#define PG8_SCHED __builtin_amdgcn_sched_barrier(0)
    Unit cur, nxt; int ui = 0;
    if (!S.next(0, cur)) return;
    f32x4 acc[2][2][4][2];
#pragma unroll
    for (int a = 0; a < 2; ++a)
#pragma unroll
        for (int b = 0; b < 2; ++b)
#pragma unroll
            for (int m = 0; m < 4; ++m)
#pragma unroll
                for (int n = 0; n < 2; ++n) acc[a][b][m][n] = (f32x4){0.f, 0.f, 0.f, 0.f};
    bf16x8 At[4][2], B0[2][2], B1[2][2];
    const char* cA = (const char*)g.A + (size_t)cur.b * g.sA * 2 + (size_t)cur.pm * tstepA; const char* cB = (const char*)g.Bt + (size_t)cur.b * g.sB * 2 + (size_t)cur.pn * tstepB;
    PG8_STAGE(PG8_SB(0, 0), cB, voffB); PG8_STAGE(PG8_SB(0, 1), cB + hstepB, voffB); PG8_STAGE(PG8_SA(0, 0), cA, voffA); PG8_STAGE(PG8_SA(0, 1), cA + hstepA, voffA);
    if (wr == 1) PG8_BAR;
    PG8_WAIT_V(2); PG8_BAR;
    PG8_STAGE(PG8_SB(1, 0), cB + kstep, voffB); PG8_STAGE(PG8_SA(1, 0), cA + kstep, voffA); PG8_STAGE(PG8_SB(1, 1), cB + hstepB + kstep, voffB);
    PG8_WAIT_V(6); PG8_BAR;
    for (;;) {
        const bool has_next = S.next(ui + 1, nxt);
        const char* nA = has_next ? (const char*)g.A + (size_t)nxt.b * g.sA * 2 + (size_t)nxt.pm * tstepA : cA;
        const char* nB = has_next ? (const char*)g.Bt + (size_t)nxt.b * g.sB * 2 + (size_t)nxt.pn * tstepB : cB;
        for (int t = 0; t < nt; t += 2) {
            const bool last = (t == nt - 2);
            const char* a1 = cA + (size_t)(t + 1) * kstep;
            const char* a2 = last ? nA : cA + (size_t)(t + 2) * kstep; const char* b2 = last ? nB : cB + (size_t)(t + 2) * kstep;
            const char* a3 = a2 + kstep; const char* b3 = b2 + kstep;
            PG8_LDB(B0, 0, 0); PG8_LDB(B1, 0, 1); PG8_SCHED; PG8_LDA(At, 0, 0); PG8_STAGE(PG8_SA(1, 1), a1 + hstepA, voffA);
            PG8_WAIT_V(8); PG8_WAIT_L(0); PG8_BAR; PG8_MMA(0, 0, At, B0); PG8_MMA(0, 1, At, B1); PG8_BAR; PG8_SCHED;
            PG8_LDA(At, 0, 1); PG8_STAGE(PG8_SB(0, 0), b2, voffB); PG8_STAGE(PG8_SB(0, 1), b2 + hstepB, voffB); PG8_STAGE(PG8_SA(0, 0), a2, voffA);
            PG8_WAIT_V(8); PG8_WAIT_L(0); PG8_BAR; PG8_MMA(1, 0, At, B0); PG8_MMA(1, 1, At, B1); PG8_BAR; PG8_SCHED;
            PG8_LDB(B0, 1, 0); PG8_LDB(B1, 1, 1); PG8_SCHED; PG8_LDA(At, 1, 0); PG8_STAGE(PG8_SA(0, 1), a2 + hstepA, voffA);
            PG8_WAIT_V(8); PG8_WAIT_L(0); PG8_BAR; PG8_MMA(0, 0, At, B0); PG8_MMA(0, 1, At, B1); PG8_BAR; PG8_SCHED;
            PG8_LDA(At, 1, 1); PG8_STAGE(PG8_SB(1, 0), b3, voffB); PG8_STAGE(PG8_SB(1, 1), b3 + hstepB, voffB); PG8_STAGE(PG8_SA(1, 0), a3, voffA);
            PG8_WAIT_V(8); PG8_WAIT_L(0); PG8_BAR; PG8_MMA(1, 0, At, B0); PG8_MMA(1, 1, At, B1); PG8_BAR; PG8_SCHED;
        }
        if (wr == 0) PG8_BAR;
        if constexpr (Epi::FUSED) E.fused(acc, cur, wr, wc, fr, fq); else E(acc, cur, wr, wc, fr, fq);
        if (!has_next) break;
        if (!(Epi::CHAIN && cur.b == 0)) {
#pragma unroll
        for (int a = 0; a < 2; ++a)
#pragma unroll
            for (int b = 0; b < 2; ++b)
#pragma unroll
                for (int m = 0; m < 4; ++m)
#pragma unroll
                    for (int n = 0; n < 2; ++n) acc[a][b][m][n] = (f32x4){0.f, 0.f, 0.f, 0.f};
        }
        cur = nxt; cA = nA; cB = nB; ++ui;
        if (wr == 1) PG8_BAR;
    }
    PG8_WAIT_V(0);
    PG8_BAR;
#undef PG8_SA
#undef PG8_SB
#undef PG8_STAGE
#undef PG8_LDA
#undef PG8_LDB
#undef PG8_MMA
#undef PG8_WAIT_V
#undef PG8_WAIT_L
#undef PG8_BAR
#undef PG8_SCHED
}
}

#define XB_TMO      128
#define XB_XCNT(j)  (256  + 64 * (j))
#define XB_XSUB(j)  (1280 + 64 * (j))
#define XB_XGEN(j)  (2304 + 64 * (j))
#define XB_TOP      3328
#define XB_TOPGEN   3392
#define XCD_BAR_WORDS 3456
#define XB_SPIN_CAP (1u << 22)
__device__ __forceinline__ unsigned xb_ld(unsigned* p)              { return __hip_atomic_load(p, __ATOMIC_RELAXED, __HIP_MEMORY_SCOPE_AGENT); }
__device__ __forceinline__ unsigned xb_add(unsigned* p, unsigned v) { return __hip_atomic_fetch_add(p, v, __ATOMIC_RELAXED, __HIP_MEMORY_SCOPE_AGENT); }
__device__ __forceinline__ unsigned xb_xcc_id() { return (unsigned)__builtin_amdgcn_s_getreg((3 << 11) | 20) & 0xFu; }
#define XB_SPIN(cond, bar) do { unsigned _sp = 0; while (cond) { __builtin_amdgcn_s_sleep(1); \
    if ((++_sp & 255u) == 0u) { if (xb_ld(&(bar)[XB_TMO])) break; if (_sp > XB_SPIN_CAP) { atomicAdd(&(bar)[XB_TMO], 1u); break; } } } } while (0)
struct XcdBarrier { unsigned* bar; unsigned x; volatile LAS unsigned* st; };
__device__ __forceinline__ XcdBarrier xcd_barrier_post(unsigned* bar, volatile LAS unsigned* st) {
    XcdBarrier b; b.bar = bar; b.x = xb_xcc_id(); b.st = st;
    if (threadIdx.x == 0) (void)xb_add(&bar[XB_XCNT(b.x)], 1u);
    return b;
}
__device__ __forceinline__ void xcd_barrier_complete(unsigned* bar, unsigned x, unsigned& nloc, unsigned& nx) {
    const unsigned G = gridDim.x * gridDim.y * gridDim.z;
    unsigned sum, cnt, mine, sp = 0u;
    for (;;) {
        sum = 0u; cnt = 0u; mine = 0u;
#pragma unroll
        for (unsigned j = 0; j < 16; ++j) { const unsigned c = xb_ld(&bar[XB_XCNT(j)]); sum += c; cnt += (c > 0u) ? 1u : 0u; mine = (j == x) ? c : mine; }
        if (sum == G) break;
        __builtin_amdgcn_s_sleep(1);
        if ((++sp & 255u) == 0u) { if (xb_ld(&bar[XB_TMO])) break; if (sp > XB_SPIN_CAP) { atomicAdd(&bar[XB_TMO], 1u); break; } }
    }
    nloc = mine > 0u ? mine : 1u; nx = cnt > 0u ? cnt : 1u;
}
__device__ __forceinline__ void xcd_barrier(const XcdBarrier& b) {
    asm volatile("s_waitcnt vmcnt(0)" ::: "memory");
    __syncthreads();
    if (threadIdx.x == 0) {
        unsigned* bar = b.bar;
        __builtin_amdgcn_s_waitcnt(0);
        unsigned nloc = b.st[0], nx = b.st[1];
        if (nloc == 0u) { xcd_barrier_complete(bar, b.x, nloc, nx); b.st[0] = nloc; b.st[1] = nx; }
        const unsigned old = xb_add(&bar[XB_XSUB(b.x)], 1u);
        const unsigned gen = old / nloc;
        if (old + 1u == (gen + 1u) * nloc) {
            __builtin_amdgcn_fence(__ATOMIC_RELEASE, "agent");
            asm volatile("s_waitcnt vmcnt(0)" ::: "memory");
            const unsigned og = xb_add(&bar[XB_TOP], 1u);
            const unsigned tg = og / nx;
            if (og + 1u == (tg + 1u) * nx) xb_add(&bar[XB_TOPGEN], 1u);
            else XB_SPIN(xb_ld(&bar[XB_TOPGEN]) == tg, bar);
            __builtin_amdgcn_fence(__ATOMIC_ACQUIRE, "agent");
            xb_add(&bar[XB_XGEN(b.x)], 1u);
            asm volatile("s_waitcnt vmcnt(0)" ::: "memory");
        } else {
            XB_SPIN(xb_ld(&bar[XB_XGEN(b.x)]) == gen, bar);
            __builtin_amdgcn_fence(__ATOMIC_ACQUIRE, "agent");
            asm volatile("s_waitcnt vmcnt(0)" ::: "memory");
        }
    }
    __syncthreads();
}

typedef f32x4 acc_t[2][2][4][2];
#define EPI_ROW(ai, m) (u.pm * 256 + (ai) * 128 + wr * 64 + (m) * 16 + fr)
__device__ __forceinline__ u32x4 pack8(const f32x4 a, const f32x4 b) { u32x4 w; w.x = pk2(a.x, a.y); w.y = pk2(a.z, a.w); w.z = pk2(b.x, b.y); w.w = pk2(b.z, b.w); return w; }
__device__ __forceinline__ f32x4 sig4(const f32x4 v) { f32x4 o; o.x = sigmoidf_(v.x); o.y = sigmoidf_(v.y); o.z = sigmoidf_(v.z); o.w = sigmoidf_(v.w); return o; }

struct EpiZf {
    static constexpr bool PERM = true, FUSED = false, CHAIN = false;
    bf16_t *q, *k, *vT, *ax, *ga, *gs; const float* rope;
    __device__ __forceinline__ void operator()(const acc_t& acc, const pg8::Unit& u, int wr, int wc, int fr, int fq) const {
        const int pn = u.pn;
#pragma unroll
        for (int ai = 0; ai < 2; ++ai)
#pragma unroll
            for (int m = 0; m < 4; ++m) {
                const int row = EPI_ROW(ai, m);
#pragma unroll
                for (int bj = 0; bj < 2; ++bj) {
                    f32x4 v0 = acc[ai][bj][m][0], v1 = acc[ai][bj][m][1];
                    const int cl = bj * 128 + wc * 32 + 8 * fq;
                    if (pn < 4 || (pn == 4 && bj == 0)) {
                        if ((wc & 1) == 0) {
                            f32x4 p0, p1;
                            p0.x = __shfl_xor(v0.x, 16); p0.y = __shfl_xor(v0.y, 16); p0.z = __shfl_xor(v0.z, 16); p0.w = __shfl_xor(v0.w, 16);
                            p1.x = __shfl_xor(v1.x, 16); p1.y = __shfl_xor(v1.y, 16); p1.z = __shfl_xor(v1.z, 16); p1.w = __shfl_xor(v1.w, 16);
                            if (fq < 2) {
                                const f32x4* rp = (const f32x4*)(rope + (size_t)row * 16);
                                const f32x4 r0 = rp[0], r1 = rp[1], r2 = rp[2], r3 = rp[3];
                                const float sg = (fq == 0) ? -1.f : 1.f;
                                v0.x = v0.x * r0.x + sg * p0.x * r0.y; v0.y = v0.y * r0.z + sg * p0.y * r0.w;
                                v0.z = v0.z * r1.x + sg * p0.z * r1.y; v0.w = v0.w * r1.z + sg * p0.w * r1.w;
                                v1.x = v1.x * r2.x + sg * p1.x * r2.y; v1.y = v1.y * r2.z + sg * p1.y * r2.w;
                                v1.z = v1.z * r3.x + sg * p1.z * r3.y; v1.w = v1.w * r3.z + sg * p1.w * r3.w;
                            }
                        }
                        bf16_t* dst = (pn < 4) ? (q + (size_t)row * 1024 + pn * 256 + cl) : (k + (size_t)row * 128 + cl);
                        *(u32x4*)dst = pack8(v0, v1);
                    } else if (pn == 4) {
                        bf16_t* dst = vT + (size_t)(cl - 128) * SEQ + row;
                        dst[0 * (size_t)SEQ] = (bf16_t)f2bf(v0.x); dst[1 * (size_t)SEQ] = (bf16_t)f2bf(v0.y); dst[2 * (size_t)SEQ] = (bf16_t)f2bf(v0.z); dst[3 * (size_t)SEQ] = (bf16_t)f2bf(v0.w);
                        dst[4 * (size_t)SEQ] = (bf16_t)f2bf(v1.x); dst[5 * (size_t)SEQ] = (bf16_t)f2bf(v1.y); dst[6 * (size_t)SEQ] = (bf16_t)f2bf(v1.z); dst[7 * (size_t)SEQ] = (bf16_t)f2bf(v1.w);
                    } else if (pn < 9) {
                        const int c = (pn - 5) * 256 + cl, g = c >> 4, ci0 = c & 15;
                        *(u32x4*)(ax + ((size_t)g * 512 + (row >> 4)) * 384 + (row & 15) * 16 + ci0) = pack8(v0, v1);
                    } else if (pn < 17) {
                        *(u32x4*)(ga + (size_t)row * 2048 + (pn - 9) * 256 + cl) = pack8(sig4(v0), sig4(v1));
                    } else {
                        *(u32x4*)(gs + (size_t)row * 2048 + (pn - 17) * 256 + cl) = pack8(sig4(v0), sig4(v1));
                    }
                }
            }
    }
};
struct EpiSf {
    static constexpr bool PERM = false, FUSED = false, CHAIN = false; float* S;
    __device__ __forceinline__ void operator()(const acc_t& acc, const pg8::Unit& u, int wr, int wc, int fr, int fq) const {
#pragma unroll
        for (int ai = 0; ai < 2; ++ai)
#pragma unroll
            for (int m = 0; m < 4; ++m) { const int row = EPI_ROW(ai, m);
#pragma unroll
                for (int n = 0; n < 2; ++n) *(f32x4*)(S + ((size_t)u.b * 512 + row) * 128 + wc * 32 + 16 * n + 4 * fq) = acc[ai][0][m][n]; }
    }
};
struct EpiYf {
    static constexpr bool PERM = true, FUSED = false, CHAIN = false; bf16_t* y;
    __device__ __forceinline__ void operator()(const acc_t& acc, const pg8::Unit& u, int wr, int wc, int fr, int fq) const {
#pragma unroll
        for (int ai = 0; ai < 2; ++ai)
#pragma unroll
            for (int m = 0; m < 4; ++m) { const int row = EPI_ROW(ai, m);
#pragma unroll
                for (int bj = 0; bj < 2; ++bj) { const int c = bj * 128 + wc * 32 + 8 * fq, t = c >> 4, co0 = c & 15;
                    const f32x4 a0 = acc[ai][bj][m][0], a1 = acc[ai][bj][m][1];
                    u32x4 w; w.x = pk2(gelu_tanh(a0.x), gelu_tanh(a0.y)); w.y = pk2(gelu_tanh(a0.z), gelu_tanh(a0.w)); w.z = pk2(gelu_tanh(a1.x), gelu_tanh(a1.y)); w.w = pk2(gelu_tanh(a1.z), gelu_tanh(a1.w));
                    *(u32x4*)(y + (unsigned)((row * 16 + t) * 1024 + u.b * 16 + co0)) = w;
                    asm volatile("" ::: "memory"); } }
    }
};
struct EpiGLUf {
    static constexpr bool PERM = true, FUSED = false, CHAIN = false; bf16_t* o;
    __device__ __forceinline__ void operator()(const acc_t& acc, const pg8::Unit& u, int wr, int wc, int fr, int fq) const {
#pragma unroll
        for (int ai = 0; ai < 2; ++ai)
#pragma unroll
            for (int m = 0; m < 4; ++m) { const int row = EPI_ROW(ai, m);
                const f32x4 v0 = acc[ai][0][m][0] * sig4(acc[ai][1][m][0]), v1 = acc[ai][0][m][1] * sig4(acc[ai][1][m][1]);
                *(u32x4*)(o + (size_t)row * 1024 + u.pn * 128 + wc * 32 + 8 * fq) = pack8(v0, v1); }
    }
};
__device__ __forceinline__ f32x4 ld_bf4(const bf16_t* p) { const u32x2 w = *(const u32x2*)p; f32x4 o; o.x = bf2f(w.x & 0xffffu); o.y = bf2f(w.x >> 16); o.z = bf2f(w.y & 0xffffu); o.w = bf2f(w.y >> 16); return o; }
__device__ __forceinline__ void ld_bf8(const bf16_t* p, f32x4& lo, f32x4& hi) { const u32x4 w = *(const u32x4*)p;
    lo.x = bf2f(w.x & 0xffffu); lo.y = bf2f(w.x >> 16); lo.z = bf2f(w.y & 0xffffu); lo.w = bf2f(w.y >> 16); hi.x = bf2f(w.z & 0xffffu); hi.y = bf2f(w.z >> 16); hi.z = bf2f(w.w & 0xffffu); hi.w = bf2f(w.w >> 16); }
struct EpiBrF {
    static constexpr bool PERM = true, FUSED = true, CHAIN = true; const bf16_t* ga; const bf16_t* gs; bf16_t* mo;
    __device__ __forceinline__ void fused(acc_t& acc, const pg8::Unit& u, int wr, int wc, int fr, int fq) const {
#pragma unroll
        for (int ai = 0; ai < 2; ++ai)
#pragma unroll
            for (int m = 0; m < 4; ++m) { const int row = EPI_ROW(ai, m);
#pragma unroll
                for (int bj = 0; bj < 2; ++bj) { const unsigned o = (unsigned)(row * 2048 + u.pn * 256 + bj * 128 + wc * 32 + 8 * fq); f32x4 s0, s1; ld_bf8(gs + o, s0, s1);
                    if (u.b == 0) { f32x4 a0, a1; ld_bf8(ga + o, a0, a1);
                        f32x4 r0, r1; r0.x = a0.x * __builtin_amdgcn_rcpf(fmaxf(s0.x, 1e-30f)); r0.y = a0.y * __builtin_amdgcn_rcpf(fmaxf(s0.y, 1e-30f)); r0.z = a0.z * __builtin_amdgcn_rcpf(fmaxf(s0.z, 1e-30f)); r0.w = a0.w * __builtin_amdgcn_rcpf(fmaxf(s0.w, 1e-30f));
                        r1.x = a1.x * __builtin_amdgcn_rcpf(fmaxf(s1.x, 1e-30f)); r1.y = a1.y * __builtin_amdgcn_rcpf(fmaxf(s1.y, 1e-30f)); r1.z = a1.z * __builtin_amdgcn_rcpf(fmaxf(s1.z, 1e-30f)); r1.w = a1.w * __builtin_amdgcn_rcpf(fmaxf(s1.w, 1e-30f));
                        acc[ai][bj][m][0] = acc[ai][bj][m][0] * r0; acc[ai][bj][m][1] = acc[ai][bj][m][1] * r1; }
                    else *(u32x4*)(mo + o) = pack8(acc[ai][bj][m][0] * s0, acc[ai][bj][m][1] * s1); } }
    }
};
struct EpiT1f {
    static constexpr bool PERM = true, FUSED = false, CHAIN = false; f32x4* t1; const bf16_t* ga; int tid;
    __device__ __forceinline__ void operator()(const acc_t& acc, const pg8::Unit& u, int wr, int wc, int fr, int fq) const {
        f32x4* base = t1 + (size_t)(u.pm * 8 + u.pn) * 32 * 512 + tid;
#pragma unroll
        for (int ai = 0; ai < 2; ++ai)
#pragma unroll
            for (int m = 0; m < 4; ++m) { const int row = EPI_ROW(ai, m);
#pragma unroll
                for (int bj = 0; bj < 2; ++bj) { const int col = u.pn * 256 + bj * 128 + wc * 32 + 8 * fq; f32x4 g0, g1; ld_bf8(ga + (size_t)row * 2048 + col, g0, g1);
                    base[(((ai * 2 + bj) * 4 + m) * 2 + 0) * 512] = g0 * acc[ai][bj][m][0]; base[(((ai * 2 + bj) * 4 + m) * 2 + 1) * 512] = g1 * acc[ai][bj][m][1]; } }
    }
};
struct EpiMf {
    static constexpr bool PERM = true, FUSED = false, CHAIN = false; const f32x4* t1; const bf16_t* gs; bf16_t* mo; int tid;
    __device__ __forceinline__ void operator()(const acc_t& acc, const pg8::Unit& u, int wr, int wc, int fr, int fq) const {
        const f32x4* base = t1 + (size_t)(u.pm * 8 + u.pn) * 32 * 512 + tid;
#pragma unroll
        for (int ai = 0; ai < 2; ++ai)
#pragma unroll
            for (int m = 0; m < 4; ++m) { const int row = EPI_ROW(ai, m);
#pragma unroll
                for (int bj = 0; bj < 2; ++bj) { const int col = u.pn * 256 + bj * 128 + wc * 32 + 8 * fq; f32x4 g0, g1; ld_bf8(gs + (size_t)row * 2048 + col, g0, g1);
                    const f32x4 v0 = base[(((ai * 2 + bj) * 4 + m) * 2 + 0) * 512] + g0 * acc[ai][bj][m][0], v1 = base[(((ai * 2 + bj) * 4 + m) * 2 + 1) * 512] + g1 * acc[ai][bj][m][1];
                    *(u32x4*)(mo + (size_t)row * 2048 + col) = pack8(v0, v1); } }
    }
};
struct EpiF32f {
    static constexpr bool PERM = false, FUSED = false, CHAIN = false; float* o;
    __device__ __forceinline__ void operator()(const acc_t& acc, const pg8::Unit& u, int wr, int wc, int fr, int fq) const {
#pragma unroll
        for (int ai = 0; ai < 2; ++ai)
#pragma unroll
            for (int m = 0; m < 4; ++m) { const int row = EPI_ROW(ai, m);
#pragma unroll
                for (int bj = 0; bj < 2; ++bj)
#pragma unroll
                    for (int n = 0; n < 2; ++n) *(f32x4*)(o + (size_t)row * 2048 + u.pn * 256 + bj * 128 + wc * 32 + 16 * n + 4 * fq) = acc[ai][bj][m][n]; }
    }
};
struct EpiUpf {
    static constexpr bool PERM = true, FUSED = false, CHAIN = false; bf16_t* a; const float* part2;
    __device__ __forceinline__ void operator()(const acc_t& acc, const pg8::Unit& u, int wr, int wc, int fr, int fq) const {
#pragma unroll
        for (int ai = 0; ai < 2; ++ai)
#pragma unroll
            for (int m = 0; m < 4; ++m) { const int row = EPI_ROW(ai, m);
                const f32x4* pp = (const f32x4*)(part2 + (size_t)row * 32 + fq * 8); const f32x4 pa = pp[0], pb = pp[1];
                float ss = ((pa.x + pa.y) + (pa.z + pa.w)) + ((pb.x + pb.y) + (pb.z + pb.w)); ss += __shfl_xor(ss, 16); ss += __shfl_xor(ss, 32);
                const float ri = rsqrtf(ss * (1.0f / DM) + 1e-6f);
#pragma unroll
                for (int bj = 0; bj < 2; ++bj) {
                    f32x4 v0 = acc[ai][bj][m][0] * ri, v1 = acc[ai][bj][m][1] * ri;
                    v0.x = fmaxf(v0.x, 0.f); v0.y = fmaxf(v0.y, 0.f); v0.z = fmaxf(v0.z, 0.f); v0.w = fmaxf(v0.w, 0.f);
                    v1.x = fmaxf(v1.x, 0.f); v1.y = fmaxf(v1.y, 0.f); v1.z = fmaxf(v1.z, 0.f); v1.w = fmaxf(v1.w, 0.f);
                    *(u32x4*)(a + (size_t)row * DFF + u.pn * 256 + bj * 128 + wc * 32 + 8 * fq) = pack8(v0 * v0, v1 * v1); } }
    }
};

__device__ __forceinline__ void row_partials(const acc_t& acc, float* part, const pg8::Unit& u, int wr, int wc, int fr, int fq) {
#pragma unroll
    for (int ai = 0; ai < 2; ++ai)
#pragma unroll
        for (int m = 0; m < 4; ++m) {
            float s = 0.f;
#pragma unroll
            for (int bj = 0; bj < 2; ++bj)
#pragma unroll
                for (int n = 0; n < 2; ++n) { const f32x4 v = acc[ai][bj][m][n]; s += (v.x * v.x + v.y * v.y) + (v.z * v.z + v.w * v.w); }
            s += __shfl_xor(s, 16); s += __shfl_xor(s, 32);
            if (fq == 0) part[(size_t)EPI_ROW(ai, m) * 32 + u.pn * 4 + wc] = s;
        }
}
__device__ __forceinline__ void row_rinv(const float* part, float (&rinv)[2][4], const pg8::Unit& u, int wr, int fr, int fq) {
#pragma unroll
    for (int ai = 0; ai < 2; ++ai)
#pragma unroll
        for (int m = 0; m < 4; ++m) {
            const f32x4* pp = (const f32x4*)(part + (size_t)EPI_ROW(ai, m) * 32 + fq * 8);
            const f32x4 a = pp[0], b = pp[1];
            float s = ((a.x + a.y) + (a.z + a.w)) + ((b.x + b.y) + (b.z + b.w));
            s += __shfl_xor(s, 16); s += __shfl_xor(s, 32);
            rinv[ai][m] = rsqrtf(s * (1.0f / DM) + 1e-6f);
        }
}
struct EpiOutNormF {
    static constexpr bool PERM = true, FUSED = true, CHAIN = false;
    const float* x; const float* g1; const float* g2; float* x1; bf16_t* h2; float* part1; float* part2; XcdBarrier xb;
    __device__ __forceinline__ void fused(acc_t& acc, const pg8::Unit& u, int wr, int wc, int fr, int fq) const {
        float rinv[2][4];
        row_partials(acc, part1, u, wr, wc, fr, fq);
        xcd_barrier(xb);
        row_rinv(part1, rinv, u, wr, fr, fq);
#pragma unroll
        for (int bj = 0; bj < 2; ++bj) { const int col = u.pn * 256 + bj * 128 + wc * 32 + 8 * fq;
            const f32x4 ga0 = *(const f32x4*)(g1 + col), ga1 = *(const f32x4*)(g1 + col + 4), gb0 = *(const f32x4*)(g2 + col), gb1 = *(const f32x4*)(g2 + col + 4);
#pragma unroll
            for (int ai = 0; ai < 2; ++ai)
#pragma unroll
              for (int mh = 0; mh < 2; ++mh) {
                f32x4 xv[2][2];
#pragma unroll
                for (int mm = 0; mm < 2; ++mm) { const unsigned o = (unsigned)(EPI_ROW(ai, 2 * mh + mm) * DM + col); xv[mm][0] = *(const f32x4*)(x + o); xv[mm][1] = *(const f32x4*)(x + o + 4); }
#pragma unroll
                for (int mm = 0; mm < 2; ++mm) { const int m = 2 * mh + mm; const unsigned o = (unsigned)(EPI_ROW(ai, m) * DM + col);
                    const f32x4 v0 = xv[mm][0] + acc[ai][bj][m][0] * rinv[ai][m] * ga0, v1 = xv[mm][1] + acc[ai][bj][m][1] * rinv[ai][m] * ga1;
                    acc[ai][bj][m][0] = v0; acc[ai][bj][m][1] = v1; *(f32x4*)(x1 + o) = v0; *(f32x4*)(x1 + o + 4) = v1; *(u32x4*)(h2 + o) = pack8(v0 * gb0, v1 * gb1); }
#pragma unroll
                for (int mm = 0; mm < 2; ++mm) asm volatile("" : "+v"(acc[ai][bj][2 * mh + mm][0]), "+v"(acc[ai][bj][2 * mh + mm][1]));
                asm volatile("" ::: "memory"); } }
        row_partials(acc, part2, u, wr, wc, fr, fq);
    }
};
struct EpiDownNormF {
    static constexpr bool PERM = true, FUSED = true, CHAIN = false;
    const float* g; float* x1; float* part; XcdBarrier xb;
    __device__ __forceinline__ void fused(acc_t& acc, const pg8::Unit& u, int wr, int wc, int fr, int fq) const {
        float rinv[2][4];
        row_partials(acc, part, u, wr, wc, fr, fq);
        xcd_barrier(xb);
        row_rinv(part, rinv, u, wr, fr, fq);
#pragma unroll
        for (int bj = 0; bj < 2; ++bj) { const int col = u.pn * 256 + bj * 128 + wc * 32 + 8 * fq;
            const f32x4 g0 = *(const f32x4*)(g + col), g1 = *(const f32x4*)(g + col + 4);
#pragma unroll
            for (int ai = 0; ai < 2; ++ai)
#pragma unroll
                for (int m = 0; m < 4; ++m) { float* o = x1 + (unsigned)(EPI_ROW(ai, m) * DM + col);
                    const f32x4 a0 = *(const f32x4*)o, a1 = *(const f32x4*)(o + 4);
                    *(f32x4*)o = a0 + acc[ai][bj][m][0] * rinv[ai][m] * g0; *(f32x4*)(o + 4) = a1 + acc[ai][bj][m][1] * rinv[ai][m] * g1; } }
    }
};

typedef float f32x16 __attribute__((ext_vector_type(16)));
typedef short s16x8 __attribute__((ext_vector_type(8)));
constexpr int ATT_KROW = 144, ATT_VROW = 336, ATT_VOFF = 160 * ATT_KROW;
__device__ __forceinline__ void attn_stage(LAS unsigned char* lds, const bf16_t* Kb, const bf16_t* VT, const int q0, const int hk, const int tid) {
    for (int c = tid; c < 1280; c += 512) {
        const int row = c >> 3, ch = c & 7, key = q0 - 128 + row;
        u32x4 v = {0u, 0u, 0u, 0u}; if (key >= 0) v = *(const u32x4*)(Kb + (size_t)key * 128 + hk * 64 + ch * 8);
        *(LAS u32x4*)(lds + row * ATT_KROW + ch * 16) = v;
        const int d = c / 20, cc = c % 20, k0 = q0 - 128 + cc * 8;
        u32x4 w = {0u, 0u, 0u, 0u}; if (k0 >= 0) w = *(const u32x4*)(VT + (size_t)(hk * 64 + d) * SEQ + k0);
        *(LAS u32x4*)(lds + ATT_VOFF + d * ATT_VROW + cc * 16) = w;
    }
}
__device__ __forceinline__ void attn_item(LAS unsigned char* lds, const bf16_t* Q, bf16_t* O, const float sink, const int q0, const int h, const int lane) {
    const int r = lane & 31, hf = lane >> 5;
    s16x8 qf[4];
#pragma unroll
    for (int kk = 0; kk < 4; ++kk) qf[kk] = *(const s16x8*)(Q + (size_t)(q0 + r) * 1024 + h * 64 + 16 * kk + 8 * hf);
    f32x16 st[5];
#pragma unroll
    for (int kt = 0; kt < 5; ++kt) {
        f32x16 a = {0.f, 0.f, 0.f, 0.f, 0.f, 0.f, 0.f, 0.f, 0.f, 0.f, 0.f, 0.f, 0.f, 0.f, 0.f, 0.f};
#pragma unroll
        for (int kk = 0; kk < 4; ++kk) {
            const s16x8 kf = *(const LAS s16x8*)(lds + (32 * kt + r) * ATT_KROW + (16 * kk + 8 * hf) * 2);
            a = __builtin_amdgcn_mfma_f32_32x32x16_bf16(kf, qf[kk], a, 0, 0, 0);
        }
        st[kt] = a;
    }
    float mx = sink;
#pragma unroll
    for (int kt = 0; kt < 5; ++kt)
#pragma unroll
        for (int e = 0; e < 16; ++e) {
            const int kofs = -128 + 32 * kt + (e & 3) + 8 * (e >> 2) + 4 * hf;
            const int diff = r - kofs;
            const bool ok = (diff >= 0) && (diff < 128) && (q0 + kofs >= 0);
            const float sv = ok ? st[kt][e] * 0.125f : -1e30f;
            st[kt][e] = sv; mx = fmaxf(mx, sv);
        }
    mx = fmaxf(mx, __shfl_xor(mx, 32));
    float sum = 0.f;
#pragma unroll
    for (int kt = 0; kt < 5; ++kt)
#pragma unroll
        for (int e = 0; e < 16; ++e) { const float pv = (st[kt][e] > -1e29f) ? __expf(st[kt][e] - mx) : 0.f; st[kt][e] = pv; sum += pv; }
    sum += __shfl_xor(sum, 32);
    sum += __expf(sink - mx);
    const float inv = 1.0f / sum;
    f32x16 o0 = {0.f, 0.f, 0.f, 0.f, 0.f, 0.f, 0.f, 0.f, 0.f, 0.f, 0.f, 0.f, 0.f, 0.f, 0.f, 0.f}, o1 = o0;
#pragma unroll
    for (int kt = 0; kt < 5; ++kt)
#pragma unroll
        for (int s = 0; s < 2; ++s) {
            u32x4 pw; pw.x = pk2(st[kt][8 * s + 0], st[kt][8 * s + 1]); pw.y = pk2(st[kt][8 * s + 2], st[kt][8 * s + 3]);
            pw.z = pk2(st[kt][8 * s + 4], st[kt][8 * s + 5]); pw.w = pk2(st[kt][8 * s + 6], st[kt][8 * s + 7]);
            const s16x8 pf = __builtin_bit_cast(s16x8, pw);
#pragma unroll
            for (int dt = 0; dt < 2; ++dt) {
                const LAS unsigned char* vp = lds + ATT_VOFF + (32 * dt + r) * ATT_VROW + (32 * kt + 16 * s + 4 * hf) * 2;
                const u32x2 a0 = *(const LAS u32x2*)vp, a1 = *(const LAS u32x2*)(vp + 16);
                u32x4 vw; vw.x = a0.x; vw.y = a0.y; vw.z = a1.x; vw.w = a1.y;
                const s16x8 vf = __builtin_bit_cast(s16x8, vw);
                if (dt == 0) o0 = __builtin_amdgcn_mfma_f32_32x32x16_bf16(vf, pf, o0, 0, 0, 0);
                else o1 = __builtin_amdgcn_mfma_f32_32x32x16_bf16(vf, pf, o1, 0, 0, 0);
            }
        }
    bf16_t* op = O + (size_t)(q0 + r) * 1024 + h * 64 + 4 * hf;
#pragma unroll
    for (int i = 0; i < 4; ++i) {
        u32x2 w; w.x = pk2(o0[4 * i] * inv, o0[4 * i + 1] * inv); w.y = pk2(o0[4 * i + 2] * inv, o0[4 * i + 3] * inv); *(u32x2*)(op + 8 * i) = w;
        u32x2 w1; w1.x = pk2(o1[4 * i] * inv, o1[4 * i + 1] * inv); w1.y = pk2(o1[4 * i + 2] * inv, o1[4 * i + 3] * inv); *(u32x2*)(op + 32 + 8 * i) = w1;
    }
}

constexpr int NPHASE = 8;

#ifndef PROBE_PH
#define PROBE_PH -1
#endif
template <int PH, int REP = 1>
__device__ __forceinline__ void run_phase(const P& p, LAS unsigned char* lds, const XcdBarrier& xb) {
    int tid_ = threadIdx.x; asm volatile("" : "+v"(tid_));
    const int tid = tid_, lane = tid & 63, wave = tid >> 6;
    int bid_ = blockIdx.x; asm volatile("" : "+s"(bid_));
    const int bid = bid_;
    const int G = gridDim.x, gw = bid * 8 + wave, NGW = G * 8;
    const size_t gt = (size_t)bid * 512 + tid, NGT = (size_t)G * 512;
    unsigned char* ws = p.ws; unsigned char* dout = (unsigned char*)p.out;
    asm volatile("" : "+s"(ws), "+s"(dout));
    float* PART1 = (float*)(ws + WS_PART1); float* PART2 = (float*)(ws + WS_PART2);
    float2* AP = (float2*)(ws + WS_AP); float2* BBAR = (float2*)(ws + WS_BBAR); float2* ROPE = (float2*)(ws + WS_ROPE);
    bf16_t* WUP = (bf16_t*)(ws + WS_WUP); bf16_t* WDN = (bf16_t*)(ws + WS_WDN); bf16_t* WIN = (bf16_t*)(ws + WS_WIN); bf16_t* WGLU = (bf16_t*)(ws + WS_WGLU);
    bf16_t* WBRA = (bf16_t*)(ws + WS_WBRA); bf16_t* WBRS = (bf16_t*)(ws + WS_WBRS); bf16_t* WOUT = (bf16_t*)(ws + WS_WOUT);
    bf16_t* H = (bf16_t*)(ws + WS_H); bf16_t* OATT = (bf16_t*)(ws + WS_OATT); bf16_t* Q = (bf16_t*)(ws + WS_Q); bf16_t* OSSM = (bf16_t*)(ws + WS_OSSM);
    bf16_t* Kb = (bf16_t*)(ws + WS_K); bf16_t* VT = (bf16_t*)(ws + WS_VT); bf16_t* AX = (bf16_t*)(ws + WS_AX); bf16_t* Y = (bf16_t*)(ws + WS_Y);
    bf16_t* Mb = (bf16_t*)(ws + WS_M); bf16_t* GA = (bf16_t*)(ws + WS_GA); bf16_t* GS = (bf16_t*)(ws + WS_GS); float* MIXED = (float*)(ws + WS_MIXED);
    bf16_t* H2 = (bf16_t*)(ws + WS_H2); bf16_t* Ab = (bf16_t*)(ws + WS_A); float* DN = (float*)(ws + WS_DN);
    float* S = (float*)(dout + DO_S); float* KTAB = (float*)(dout + DO_KTAB); bf16_t* BC = (bf16_t*)(dout + DO_BC); bf16_t* YB = (bf16_t*)(dout + DO_YB);
    float* T1 = (float*)dout; float* X1 = (float*)dout;
    const float* x = p.in[0];

    if constexpr (PH == 0) {
        LAS float* scr = (LAS float*)(lds + wave * 16384);
        for (int base = bid * 32; base < TI_IN; base += G * 32) transpose_quad(p, base + wave * 4, scr, lane);
        if (gw < SEQ) {
            f32x4 v[8];
#pragma unroll
            for (int j = 0; j < 8; ++j) v[j] = ((const f32x4*)(x + (size_t)gw * DM))[64 * j + lane];
            for (int m = gw; m < SEQ; m += NGW) {
                const bool more = m + NGW < SEQ; f32x4 nv[8];
                if (more) {
#pragma unroll
                    for (int j = 0; j < 8; ++j) nv[j] = ((const f32x4*)(x + (size_t)(m + NGW) * DM))[64 * j + lane]; }
                float ss = 0.f;
#pragma unroll
                for (int j = 0; j < 8; ++j) ss += v[j].x * v[j].x + v[j].y * v[j].y + v[j].z * v[j].z + v[j].w * v[j].w;
                const float rr = rsqrtf(wave_sum(ss) * (1.0f / DM) + 1e-6f);
#pragma unroll
                for (int j = 0; j < 8; ++j) { const f32x4 g = ((const f32x4*)p.in[1])[64 * j + lane]; const f32x4 o = v[j] * rr * g;
                    u32x2 w; w.x = pk2(o.x, o.y); w.y = pk2(o.z, o.w); ((u32x2*)(H + (size_t)m * DM))[64 * j + lane] = w; }
                if (more) {
#pragma unroll
                    for (int j = 0; j < 8; ++j) v[j] = nv[j]; }
            }
        }
        for (size_t e = gt; e < (size_t)NG * SP * NAP; e += NGT) {
            const int i = (int)(e / NAP), n = (int)(e % NAP), g = i / SP;
            const double dt = exp((double)p.in[9][g]), lr = (double)p.in[7][i], li = (double)p.in[8][i];
            const double pw = (n == 17) ? 1024.0 : (double)n;
            const float mag = (float)exp(pw * lr * dt); float sn, cs; sincos_d(pw * li * dt, sn, cs);
            AP[((size_t)g * NAP + n) * SP + (i % SP)] = make_float2(mag * cs, mag * sn);
        }
        for (size_t e = gt; e < (size_t)NG * SP * GC; e += NGT) {
            const int i = (int)(e >> 4), g = i / SP;
            const double dt = exp((double)p.in[9][g]), lr = (double)p.in[7][i], li = (double)p.in[8][i];
            float s1, c1; sincos_d(li * dt, s1, c1);
            const double mag1 = exp(lr * dt), are = mag1 * (double)c1, aim = mag1 * (double)s1;
            const double nr = are - 1.0, ni = aim, den = lr * lr + li * li;
            const double cre = (nr * lr + ni * li) / den, cim = (ni * lr - nr * li) / den;
            const double br = (double)p.in[10][e], bi = (double)p.in[11][e];
            BBAR[e] = make_float2((float)(cre * br - cim * bi), (float)(cre * bi + cim * br));
        }
        for (size_t i = gt; i < (size_t)SEQ * 8; i += NGT) {
            const int pos = (int)(i >> 3), k = (int)(i & 7);
            const double inv = exp(-(double)k * 0.125 * 13.122363377404328);
            float s, c; sincos_d((double)pos * inv, s, c);
            ROPE[i] = make_float2(c, s);
        }
        }
    if constexpr (PH == 1) {
        { pg8::Gemm g{H, WIN, SEQ, INW, DM, DM, DM, 1, 0, 0}; pg8::Order S; S.init(SEQ, INW, 1, G, bid, 3);
          EpiZf E{Q, Kb, VT, AX, GA, GS, (const float*)ROPE}; pg8::gemm_phase(lds, g, S, E, tid); }
        for (size_t e = gt; e < (size_t)NG * 256 * 32; e += NGT) {
            const int g = (int)(e >> 13), r = (int)(e >> 5) & 255, k8 = (int)e & 31, s_ = k8 >> 1, ci0 = (k8 & 1) * 8;
            u32x4 w = {0u, 0u, 0u, 0u};
            if (r < 128) { const int pp = r & 63; const float2 a = AP[((size_t)g * NAP + 15 - s_) * SP + pp];
                const f32x4* bp = (const f32x4*)(BBAR + ((size_t)g * SP + pp) * GC + ci0); const f32x4 b0 = bp[0], b1 = bp[1], b2 = bp[2], b3 = bp[3];
                if (r >> 6) { w.x = pk2(a.x * b0.y + a.y * b0.x, a.x * b0.w + a.y * b0.z); w.y = pk2(a.x * b1.y + a.y * b1.x, a.x * b1.w + a.y * b1.z);
                              w.z = pk2(a.x * b2.y + a.y * b2.x, a.x * b2.w + a.y * b2.z); w.w = pk2(a.x * b3.y + a.y * b3.x, a.x * b3.w + a.y * b3.z); }
                else {        w.x = pk2(a.x * b0.x - a.y * b0.y, a.x * b0.z - a.y * b0.w); w.y = pk2(a.x * b1.x - a.y * b1.y, a.x * b1.z - a.y * b1.w);
                              w.z = pk2(a.x * b2.x - a.y * b2.y, a.x * b2.z - a.y * b2.w); w.w = pk2(a.x * b3.x - a.y * b3.y, a.x * b3.z - a.y * b3.w); } }
            *(u32x4*)(BC + e * 8) = w;
        }
        for (size_t e = gt; e < (size_t)NG * 256 * 16; e += NGT) {
            const int g = (int)(e >> 12), row = (int)(e >> 4) & 255, r0 = ((int)e & 15) * 8, t = row >> 4, co = row & 15, pp0 = r0 & 63;
            const f32x4* ap = (const f32x4*)(AP + ((size_t)g * NAP + t + 1) * SP + pp0); const f32x4 a0 = ap[0], a1 = ap[1], a2 = ap[2], a3 = ap[3];
            const f32x4* crp = (const f32x4*)(p.in[12] + ((size_t)g * GC + co) * SP + pp0); const f32x4* cip = (const f32x4*)(p.in[13] + ((size_t)g * GC + co) * SP + pp0);
            const f32x4 cr0 = crp[0], cr1 = crp[1], ci0 = cip[0], ci1 = cip[1];
            u32x4 w;
            if (r0 >> 6) { w.x = pk2(-(cr0.x * a0.y + ci0.x * a0.x), -(cr0.y * a0.w + ci0.y * a0.z)); w.y = pk2(-(cr0.z * a1.y + ci0.z * a1.x), -(cr0.w * a1.w + ci0.w * a1.z));
                           w.z = pk2(-(cr1.x * a2.y + ci1.x * a2.x), -(cr1.y * a2.w + ci1.y * a2.z)); w.w = pk2(-(cr1.z * a3.y + ci1.z * a3.x), -(cr1.w * a3.w + ci1.w * a3.z)); }
            else {         w.x = pk2(cr0.x * a0.x - ci0.x * a0.y, cr0.y * a0.z - ci0.y * a0.w); w.y = pk2(cr0.z * a1.x - ci0.z * a1.y, cr0.w * a1.z - ci0.w * a1.w);
                           w.z = pk2(cr1.x * a2.x - ci1.x * a2.y, cr1.y * a2.z - ci1.y * a2.w); w.w = pk2(cr1.z * a3.x - ci1.z * a3.y, cr1.w * a3.z - ci1.w * a3.w); }
            *(u32x4*)(YB + ((size_t)g * 256 + row) * 384 + 256 + r0) = w;
        }
        {
            LAS float* Cre = (LAS float*)lds; LAS float* Cim = Cre + 16 * 65; LAS float* APr = Cim + 16 * 65; LAS float* APi = APr + 256; LAS float* Bbr = APi + 256; LAS float* Bbi = Bbr + 1024;
            for (int item = bid; item < NG * 4; item += G) {
                const int g = item >> 2, tq = item & 3;
                __syncthreads();
                for (int i = tid; i < 1024; i += 512) { Cre[(i >> 6) * 65 + (i & 63)] = p.in[12][(size_t)g * 1024 + i]; Cim[(i >> 6) * 65 + (i & 63)] = p.in[13][(size_t)g * 1024 + i];
                    const float2 b = BBAR[(size_t)g * 1024 + i]; Bbr[i] = b.x; Bbi[i] = b.y; }
                if (tid < 256) { const float2 a = AP[((size_t)g * NAP + 4 * tq + (tid >> 6)) * SP + (tid & 63)]; APr[tid] = a.x; APi[tid] = a.y; }
                __syncthreads();
#pragma unroll
                for (int rr = 0; rr < 2; ++rr) {
                    const int idx = tid + 512 * rr, tl = idx >> 8, co = (idx >> 4) & 15, ci = idx & 15;
                    float acc = 0.f;
#pragma unroll 8
                    for (int pp = 0; pp < SP; ++pp) {
                        const float cr = Cre[co * 65 + pp], cim = Cim[co * 65 + pp], ax = APr[tl * 64 + pp], ay = APi[tl * 64 + pp];
                        const float wre = cr * ax - cim * ay, wim = cr * ay + cim * ax;
                        acc += wre * Bbr[pp * 16 + ci] - wim * Bbi[pp * 16 + ci];
                    }
                    const int tau = 4 * tq + tl;
                    if (tau == 0 && co == ci) acc += p.in[14][g * GC + co];
                    KTAB[(((size_t)g * 16 + tau) * 16 + co) * 16 + ci] = acc;
                }
            }
            __syncthreads();
        }
        }
    if constexpr (PH == 2) {
        if (bid < 2 * NG) {
            const int g = bid & 63, h = bid >> 6;
            unsigned* flagS = (unsigned*)(ws + WS_CTL + 14464) + g;
            unsigned* flagX = (unsigned*)(ws + WS_CTL + 14464 + 256) + g;
            if (h == 0) {
                for (int e = tid; e < 256 * 32; e += 512) {
                    const int row = e >> 5, k8 = e & 31, s_ = k8 >> 1, ci0 = (k8 & 1) * 8, t = row >> 4, co = row & 15;
                    u32x4 w = {0u, 0u, 0u, 0u};
                    if (t >= s_) { const f32x4* kp = (const f32x4*)(KTAB + (((size_t)g * 16 + (t - s_)) * 16 + co) * 16 + ci0); w = pack8(kp[0], kp[1]); }
                    *(u32x4*)(YB + ((size_t)g * 256 + row) * 384 + 8 * k8) = w;
                }
            }
            { pg8::Gemm gm{AX, BC, 512, 256, 256, 384, 256, NG, (size_t)512 * 384, (size_t)256 * 256}; pg8::Order S_; S_.init(512, 256, NG, 1, 0, 1, 2 * g + h);
              EpiSf E{S}; pg8::gemm_phase(lds, gm, S_, E, tid); }
            asm volatile("s_waitcnt vmcnt(0)" ::: "memory"); __syncthreads();
            if (h == 1) {
                if (tid == 0) { __builtin_amdgcn_fence(__ATOMIC_RELEASE, "agent"); asm volatile("s_waitcnt vmcnt(0)" ::: "memory"); __hip_atomic_store(flagS, 1u, __ATOMIC_RELAXED, __HIP_MEMORY_SCOPE_AGENT);
                    unsigned sp = 0; while (__hip_atomic_load(flagX, __ATOMIC_RELAXED, __HIP_MEMORY_SCOPE_AGENT) == 0u && ++sp < (1u << 24)) __builtin_amdgcn_s_sleep(2);
                    __builtin_amdgcn_fence(__ATOMIC_ACQUIRE, "agent"); asm volatile("s_waitcnt vmcnt(0)" ::: "memory"); }
                __syncthreads();
            } else {
                if (tid == 0) { unsigned sp = 0; while (__hip_atomic_load(flagS, __ATOMIC_RELAXED, __HIP_MEMORY_SCOPE_AGENT) == 0u && ++sp < (1u << 24)) __builtin_amdgcn_s_sleep(2);
                    __builtin_amdgcn_fence(__ATOMIC_ACQUIRE, "agent"); asm volatile("s_waitcnt vmcnt(0)" ::: "memory"); }
                __syncthreads();
        LAS float* Elr = (LAS float*)lds; LAS float* Eli = Elr + 512;
        {
            const int pp = tid & 63, seg = tid >> 6;
            const float2 A16 = AP[((size_t)g * NAP + 16) * SP + pp], A1k = AP[((size_t)g * NAP + 17) * SP + pp];
            const float* Sg = S + (size_t)g * 512 * 128;
            float lre = 0.f, lim = 0.f;
            for (int j0 = seg * 64; j0 < seg * 64 + 64; j0 += 16) {
                float sr[16], si[16];
#pragma unroll
                for (int q = 0; q < 16; ++q) { sr[q] = Sg[(j0 + q) * 128 + pp]; si[q] = Sg[(j0 + q) * 128 + 64 + pp]; }
#pragma unroll
                for (int q = 0; q < 16; ++q) { const float nr = A16.x * lre - A16.y * lim + sr[q], ni = A16.x * lim + A16.y * lre + si[q]; lre = nr; lim = ni; }
            }
            __syncthreads();
            Elr[seg * 64 + pp] = lre; Eli[seg * 64 + pp] = lim;
            __syncthreads();
            float cre = 0.f, cim = 0.f;
            for (int s2 = 0; s2 < seg; ++s2) { const float2 e = make_float2(Elr[s2 * 64 + pp], Eli[s2 * 64 + pp]);
                const float nr = A1k.x * cre - A1k.y * cim + e.x, ni = A1k.x * cim + A1k.y * cre + e.y; cre = nr; cim = ni; }
            for (int j0 = seg * 64; j0 < seg * 64 + 64; j0 += 16) {
                float sr[16], si[16];
#pragma unroll
                for (int q = 0; q < 16; ++q) { sr[q] = Sg[(j0 + q) * 128 + pp]; si[q] = Sg[(j0 + q) * 128 + 64 + pp]; }
#pragma unroll
                for (int q = 0; q < 16; ++q) {
                    bf16_t* axr = AX + ((size_t)g * 512 + j0 + q) * 384 + 256;
                    axr[pp] = (bf16_t)f2bf(cre); axr[64 + pp] = (bf16_t)f2bf(cim);
                    const float nr = A16.x * cre - A16.y * cim + sr[q], ni = A16.x * cim + A16.y * cre + si[q]; cre = nr; cim = ni; }
            }
            }
                asm volatile("s_waitcnt vmcnt(0)" ::: "memory"); __syncthreads();
                if (tid == 0) { __builtin_amdgcn_fence(__ATOMIC_RELEASE, "agent"); asm volatile("s_waitcnt vmcnt(0)" ::: "memory"); __hip_atomic_store(flagX, 1u, __ATOMIC_RELAXED, __HIP_MEMORY_SCOPE_AGENT); }
                __syncthreads();
            }
            { pg8::Gemm gm{AX, YB, 512, 256, 384, 384, 384, NG, (size_t)512 * 384, (size_t)256 * 384}; pg8::Order S_; S_.init(512, 256, NG, 1, 0, 1, 2 * g + h);
              EpiYf E{Y}; pg8::gemm_phase(lds, gm, S_, E, tid); }
        } else if (bid < 2 * NG + 32) {
            pg8::Gemm gm{H, WIN, SEQ, INW, DM, DM, DM, 1, 0, 0}; pg8::Order S_; S_.init(SEQ, INW, 1, 1 << 20, bid - 2 * NG, 1, 768);
            EpiZf E{Q, Kb, VT, AX, GA, GS, (const float*)ROPE}; pg8::gemm_phase(lds, gm, S_, E, tid);
        } else {
            for (int item = bid - (2 * NG + 32); item < 512; item += G - (2 * NG + 32)) {
                const int hk = item & 1, q0 = (item >> 1) * 32, h = hk * 8 + wave;
                __syncthreads();
                attn_stage(lds, Kb, VT, q0, hk, tid);
                __syncthreads();
                attn_item(lds, Q, OATT, p.in[6][h], q0, h, lane);
            }
        }
        {
            unsigned* ctr = (unsigned*)(ws + WS_CTL + 14336); volatile LAS int* slot = (volatile LAS int*)(lds + 131072 + 64);
            for (;;) {
                __syncthreads();
                if (tid == 0) slot[0] = TI_IN + (int)__hip_atomic_fetch_add(ctr, 32u, __ATOMIC_RELAXED, __HIP_MEMORY_SCOPE_AGENT);
                __syncthreads();
                const int base = slot[0];
                if (base >= TI_ALL) break;
                transpose_quad(p, base + wave * 4, (LAS float*)(lds + wave * 16384), lane);
            }
        }
    }
    if constexpr (PH == 3) { pg8::Gemm g{Y, WGLU, SEQ, 2048, 1024, 1024, 1024, 1, 0, 0}; pg8::Order S_; S_.init(SEQ, 2048, 1, G, bid);
        EpiGLUf E{OSSM}; pg8::gemm_phase(lds, g, S_, E, tid); }
    if constexpr (PH == 4) {
        pg8::Gemm g{OATT, WBRA, SEQ, 2048, 1024, 1024, 1024, 2, (size_t)(OSSM - OATT), (size_t)(WBRS - WBRA)}; pg8::Order S_; S_.init(SEQ, 2048, 2, G, bid);
        EpiBrF E{GA, GS, Mb}; pg8::gemm_phase(lds, g, S_, E, tid);
    }
    if constexpr (PH == 5) { pg8::Gemm g{Mb, WOUT, SEQ, 2048, 2048, 2048, 2048, 1, 0, 0}; pg8::Order S_; S_.init(SEQ, 2048, 1, G, bid);
        EpiOutNormF E{x, p.in[2], p.in[3], X1, H2, PART1, PART2, xb}; pg8::gemm_phase(lds, g, S_, E, tid); }
    if constexpr (PH == 6) { pg8::Gemm g{H2, WUP, SEQ, DFF, DM, DM, DM, 1, 0, 0}; pg8::Order S_; S_.init(SEQ, DFF, 1, G, bid);
        EpiUpf E{Ab, PART2}; pg8::gemm_phase(lds, g, S_, E, tid); }
    if constexpr (PH == 7) { pg8::Gemm g{Ab, WDN, SEQ, DM, DFF, DFF, DFF, 1, 0, 0}; pg8::Order S_; S_.init(SEQ, DM, 1, G, bid);
        EpiDownNormF E{p.in[4], X1, PART1, xb}; pg8::gemm_phase(lds, g, S_, E, tid); }
}

constexpr int LDS_BYTES = 147456;

#ifndef TPROBE
#define TPROBE -1
#endif
template <int PH>
__device__ __forceinline__ void run_all(const P& p, LAS unsigned char* lds, cg::grid_group& grid, const XcdBarrier& xb, volatile LAS unsigned* misc) {
    if constexpr (PH == PROBE_PH) { run_phase<PH, 0>(p, lds, xb); xcd_barrier(xb); }
    run_phase<PH>(p, lds, xb);
    if constexpr (PH + 1 < NPHASE) {
        if constexpr (PH == 0) { if (p.use_cg_sync) grid.sync(); else xcd_barrier(xb); } else xcd_barrier(xb);
        if constexpr (TPROBE >= 0) { if (blockIdx.x == 0 && threadIdx.x == 0) misc[4 + PH + 1] = (unsigned)__builtin_amdgcn_s_memrealtime(); }
        run_all<PH + 1>(p, lds, grid, xb, misc);
    }
}
__global__ void __launch_bounds__(512, 2) k_all(P p) {
    extern __shared__ __attribute__((aligned(16))) unsigned char lds_raw[];
    cg::grid_group grid = cg::this_grid();
    LAS unsigned char* lds = (LAS unsigned char*)lds_raw;
    volatile LAS unsigned* misc = (volatile LAS unsigned*)(lds + 131072);
    if (threadIdx.x < 2) misc[threadIdx.x] = 0u;
    __syncthreads();
    const XcdBarrier xb = xcd_barrier_post((unsigned*)(p.ws + WS_CTL), misc);
    if constexpr (TPROBE >= 0) { if (blockIdx.x == 0 && threadIdx.x == 0) misc[4] = (unsigned)__builtin_amdgcn_s_memrealtime(); }
    run_all<0>(p, lds, grid, xb, misc);
    if constexpr (TPROBE >= 0) {
        if (blockIdx.x == 0 && threadIdx.x == 0) {
            const unsigned now = (unsigned)__builtin_amdgcn_s_memrealtime(); misc[4 + NPHASE] = now;
            const unsigned d = misc[4 + TPROBE + 1] - misc[4 + TPROBE];
            while ((unsigned)__builtin_amdgcn_s_memrealtime() - now < 8u * d) __builtin_amdgcn_s_sleep(8);
        }
    }
}

extern "C" void kernel_launch(void* const* d_in, const int* in_sizes, int n_in, void* d_out, int out_size, void* d_ws, size_t ws_size, hipStream_t stream) {
    static int grid = 0;
    if (grid == 0) {
        if (n_in != 20 || out_size != SEQ * DM || ws_size < WS_END) { fprintf(stderr, "kernel_launch: unexpected shapes (n_in %d out %d ws %zu)\n", n_in, out_size, ws_size); grid = -1; return; }
        int dev = 0, cus = 0;
        (void)hipGetDevice(&dev); (void)hipDeviceGetAttribute(&cus, hipDeviceAttributeMultiprocessorCount, dev);
        (void)hipFuncSetAttribute((const void*)k_all, hipFuncAttributeMaxDynamicSharedMemorySize, LDS_BYTES);
        int per_cu = 0;
        (void)hipOccupancyMaxActiveBlocksPerMultiprocessor(&per_cu, (const void*)k_all, 512, LDS_BYTES);
        if (per_cu < 1) fprintf(stderr, "kernel_launch: occupancy query says %d blocks/CU\n", per_cu);
        (void)hipGetLastError();
        if (cus != 256) { fprintf(stderr, "kernel_launch: built for a 256-CU device (one 512-thread workgroup per CU, one 256x256 tile per workgroup in the fused-norm GEMM phases); found %d CUs\n", cus); grid = -1; return; }
        grid = cus;
    }
    if (grid < 0) return;
    P p{};
    for (int i = 0; i < 20; ++i) p.in[i] = (const float*)d_in[i];
    p.out = (float*)d_out; p.ws = (unsigned char*)d_ws;
    (void)hipMemsetAsync((char*)d_ws + WS_CTL, 0, CTL_BYTES, stream);
    void* args[] = {&p};
    hipError_t e = hipLaunchCooperativeKernel((const void*)k_all, dim3(grid), dim3(512), args, LDS_BYTES, stream);
    if (e != hipSuccess) fprintf(stderr, "cooperative launch failed: %s (grid %d)\n", hipGetErrorString(e), grid);
}
```

```cpp
#include <hip/hip_runtime.h>
#include <hip/hip_cooperative_groups.h>
#include <cstdio>
#include <cstdint>
namespace cg = cooperative_groups;


typedef unsigned short bf16_t;
typedef float f32x4 __attribute__((ext_vector_type(4)));
typedef unsigned u32x2 __attribute__((ext_vector_type(2)));
typedef unsigned u32x4 __attribute__((ext_vector_type(4)));
#define LAS __attribute__((address_space(3)))

constexpr int SEQ = 8192, DM = 2048, INW = 6400, QW = 1024, SSMW = 1024, DFF = 8192;
constexpr int NG = 64, GC = 16, SP = 64, NH = 16;
constexpr size_t MiB = 1u << 20;
constexpr size_t WS_AP = 0, WS_BBAR = 1 * MiB, WS_ROPE = 1 * MiB + 512 * 1024, WS_CTL = 2 * MiB, CTL_BYTES = 16384, WS_PART1 = 3 * MiB, WS_PART2 = 0;
constexpr size_t WS_WUP = 4 * MiB, WS_WDN = 36 * MiB, WS_WIN = 68 * MiB, WS_WGLU = 93 * MiB, WS_WBRA = 97 * MiB, WS_WBRS = 101 * MiB, WS_WOUT = 105 * MiB;
constexpr size_t WS_H = 113 * MiB, WS_OSSM = 113 * MiB  , WS_Q = 145 * MiB, WS_OATT = 145 * MiB  , WS_K = 161 * MiB, WS_VT = 163 * MiB, WS_AX = 165 * MiB, WS_Y = 189 * MiB;
constexpr size_t WS_M = 161 * MiB, WS_GA = 205 * MiB, WS_GS = 237 * MiB, WS_MIXED = 205 * MiB, WS_H2 = 68 * MiB, WS_A = 141 * MiB, WS_DN = 68 * MiB, WS_END = 269 * MiB;
constexpr size_t DO_S = 0, DO_KTAB = 16 * MiB, DO_BC = 17 * MiB, DO_YB = 25 * MiB;
constexpr int NAP = 18;

struct P {
    const float* in[20];
    float* out;
    unsigned char* ws;
    unsigned long long use_cg_sync;
};

__device__ __forceinline__ float bf2f(unsigned v) { return __uint_as_float(v << 16); }
__device__ __forceinline__ unsigned f2bf(float f) { unsigned u = __float_as_uint(f); return (u + 0x7fffu + ((u >> 16) & 1u)) >> 16; }
__device__ __forceinline__ unsigned pk2(float lo, float hi) { return f2bf(lo) | (f2bf(hi) << 16); }
__device__ __forceinline__ float wave_sum(float v) {
#pragma unroll
    for (int o = 1; o < 64; o <<= 1) v += __shfl_xor(v, o);
    return v;
}
__device__ __forceinline__ float wave_max(float v) {
#pragma unroll
    for (int o = 1; o < 64; o <<= 1) v = fmaxf(v, __shfl_xor(v, o));
    return v;
}
__device__ __forceinline__ float sigmoidf_(float v) { return __builtin_amdgcn_rcpf(1.0f + __expf(-v)); }
__device__ __forceinline__ float gelu_tanh(float v) {
    const float z2 = 1.5957691216057308f * (v + 0.044715f * v * v * v);
    return v * __builtin_amdgcn_rcpf(1.0f + __expf(-z2));
}
__device__ __forceinline__ void sincos_d(double ang, float& s, float& c) {
    double rev = ang * 0.15915494309189535; rev -= rint(rev);
    const double q4 = rev * 4.0, qr = rint(q4); const int q = ((int)qr) & 3;
    const double th = (q4 - qr) * 1.5707963267948966, t2 = th * th;
    const double sn = th * (1.0 + t2 * (-1.0 / 6 + t2 * (1.0 / 120 + t2 * (-1.0 / 5040 + t2 * (1.0 / 362880 + t2 * (-1.0 / 39916800 + t2 * (1.0 / 6227020800.0)))))));
    const double cs = 1.0 + t2 * (-0.5 + t2 * (1.0 / 24 + t2 * (-1.0 / 720 + t2 * (1.0 / 40320 + t2 * (-1.0 / 3628800 + t2 * (1.0 / 479001600.0 + t2 * (-1.0 / 87178291200.0)))))));
    const double so = (q == 0) ? sn : (q == 1) ? cs : (q == 2) ? -sn : -cs;
    const double co = (q == 0) ? cs : (q == 1) ? -sn : (q == 2) ? -cs : sn;
    s = (float)so; c = (float)co;
}

struct TItem { const float* W; bf16_t* WT; int N, ldk, k0, n0, drow0; };
constexpr int TI_IN = 32 * 200, TI_GLU = 16 * 64, TI_BR = 16 * 64, TI_OUT = 32 * 64, TI_UP = 32 * 256, TI_DN = 128 * 64;
constexpr int TI_P0 = TI_IN + TI_GLU + 2 * TI_BR + TI_OUT, TI_ALL = TI_P0 + TI_UP + TI_DN;
__device__ __forceinline__ void tdecode(int r, int ncols, int& kb, int& nb) { const int st = r >> 5, c = r & 31, sn = ncols >> 8; kb = 4 * (st / sn) + (c & 3); nb = 8 * (st % sn) + (c >> 2); }
__device__ __forceinline__ TItem titem(const P& p, int r) {
    unsigned char* ws = p.ws; TItem t; int kb, nb;
    if (r < TI_IN) { tdecode(r, INW, kb, nb); t = TItem{p.in[5], (bf16_t*)(ws + WS_WIN), INW, 2048, 64 * kb, 32 * nb, 32 * nb}; return t; } r -= TI_IN;
    if (r < TI_GLU) { tdecode(r, 2048, kb, nb); const int n0 = 32 * nb, bj = n0 >> 10, j = n0 & 1023, tt = j >> 7, jj = j & 127;
        t = TItem{p.in[15], (bf16_t*)(ws + WS_WGLU), 2048, 1024, 64 * kb, n0, 256 * tt + 128 * bj + jj}; return t; } r -= TI_GLU;
    if (r < TI_BR) { tdecode(r, 2048, kb, nb); t = TItem{p.in[16], (bf16_t*)(ws + WS_WBRA), 2048, 1024, 64 * kb, 32 * nb, 32 * nb}; return t; } r -= TI_BR;
    if (r < TI_BR) { tdecode(r, 2048, kb, nb); t = TItem{p.in[16] + (size_t)1024 * 2048, (bf16_t*)(ws + WS_WBRS), 2048, 1024, 64 * kb, 32 * nb, 32 * nb}; return t; } r -= TI_BR;
    if (r < TI_OUT) { tdecode(r, 2048, kb, nb); t = TItem{p.in[17], (bf16_t*)(ws + WS_WOUT), 2048, 2048, 64 * kb, 32 * nb, 32 * nb}; return t; } r -= TI_OUT;
    if (r < TI_UP) { tdecode(r, DFF, kb, nb); t = TItem{p.in[18], (bf16_t*)(ws + WS_WUP), DFF, 2048, 64 * kb, 32 * nb, 32 * nb}; return t; } r -= TI_UP;
    { tdecode(r, 2048, kb, nb); t = TItem{p.in[19], (bf16_t*)(ws + WS_WDN), 2048, DFF, 64 * kb, 32 * nb, 32 * nb}; return t; }
}
__device__ __forceinline__ void titem_load(const TItem& t, f32x4 (&v)[8], int lane) {
#pragma unroll
    for (int i = 0; i < 8; ++i) v[i] = __builtin_nontemporal_load((const f32x4*)(t.W + (size_t)(t.k0 + 8 * i + (lane >> 3)) * t.N + t.n0 + (lane & 7) * 4));
}
__device__ __forceinline__ void transpose_items(const P& p, int it0, int it1, int step, LAS float* scr, int lane) {
    if (it0 >= it1) return;
    TItem cur = titem(p, it0); f32x4 v[8]; titem_load(cur, v, lane);
    for (int it = it0; it < it1; it += step) {
        const bool more = it + step < it1;
        TItem nxt = cur; f32x4 nv[8];
        if (more) { nxt = titem(p, it + step); titem_load(nxt, nv, lane); }
#pragma unroll
        for (int i = 0; i < 8; ++i) { LAS float* d = scr + (8 * i + (lane >> 3)) * 33 + (lane & 7) * 4; d[0] = v[i].x; d[1] = v[i].y; d[2] = v[i].z; d[3] = v[i].w; }
        asm volatile("s_waitcnt lgkmcnt(0)" ::: "memory");
        const int c = lane & 7;
#pragma unroll
        for (int j = 0; j < 4; ++j) { const int n = (lane >> 3) + 8 * j; const LAS float* sp = scr + (8 * c) * 33 + n;
            u32x4 o; o.x = pk2(sp[0 * 33], sp[1 * 33]); o.y = pk2(sp[2 * 33], sp[3 * 33]); o.z = pk2(sp[4 * 33], sp[5 * 33]); o.w = pk2(sp[6 * 33], sp[7 * 33]);
            *(u32x4*)(cur.WT + (size_t)(cur.drow0 + n) * cur.ldk + cur.k0 + 8 * c) = o; }
        asm volatile("s_waitcnt lgkmcnt(0)" ::: "memory");
        if (more) { cur = nxt;
#pragma unroll
            for (int i = 0; i < 8; ++i) v[i] = nv[i]; }
    }
}
__device__ __forceinline__ int titem_fetch(unsigned* ctr, int base) {
    unsigned v = 0u; if ((threadIdx.x & 63) == 0) v = __hip_atomic_fetch_add(ctr, 1u, __ATOMIC_RELAXED, __HIP_MEMORY_SCOPE_AGENT);
    return base + (int)__builtin_amdgcn_readfirstlane(v);
}
__device__ __forceinline__ void transpose_items_dyn(const P& p, unsigned* ctr, int base, int it1, LAS float* scr, int lane) {
    int it = titem_fetch(ctr, base);
    if (it >= it1) return;
    TItem cur = titem(p, it); f32x4 v[8]; titem_load(cur, v, lane);
    for (;;) {
        const int nit = titem_fetch(ctr, base); const bool more = nit < it1;
        TItem nxt = cur; f32x4 nv[8];
        if (more) { nxt = titem(p, nit); titem_load(nxt, nv, lane); }
#pragma unroll
        for (int i = 0; i < 8; ++i) { LAS float* d = scr + (8 * i + (lane >> 3)) * 33 + (lane & 7) * 4; d[0] = v[i].x; d[1] = v[i].y; d[2] = v[i].z; d[3] = v[i].w; }
        asm volatile("s_waitcnt lgkmcnt(0)" ::: "memory");
        const int c = lane & 7;
#pragma unroll
        for (int j = 0; j < 4; ++j) { const int n = (lane >> 3) + 8 * j; const LAS float* sp = scr + (8 * c) * 33 + n;
            u32x4 o; o.x = pk2(sp[0 * 33], sp[1 * 33]); o.y = pk2(sp[2 * 33], sp[3 * 33]); o.z = pk2(sp[4 * 33], sp[5 * 33]); o.w = pk2(sp[6 * 33], sp[7 * 33]);
            *(u32x4*)(cur.WT + (size_t)(cur.drow0 + n) * cur.ldk + cur.k0 + 8 * c) = o; }
        asm volatile("s_waitcnt lgkmcnt(0)" ::: "memory");
        if (!more) break;
        cur = nxt;
#pragma unroll
        for (int i = 0; i < 8; ++i) v[i] = nv[i];
    }
}
__device__ __forceinline__ void transpose_quad(const P& p, int i0, LAS float* scr, int lane) {
    TItem t[4]; f32x4 v[4][8];
#pragma unroll
    for (int q = 0; q < 4; ++q) { t[q] = titem(p, i0 + q); titem_load(t[q], v[q], lane); }
#pragma unroll
    for (int q = 0; q < 4; ++q) {
#pragma unroll
        for (int i = 0; i < 8; ++i) { LAS float* d = scr + (8 * i + (lane >> 3)) * 33 + (lane & 7) * 4; d[0] = v[q][i].x; d[1] = v[q][i].y; d[2] = v[q][i].z; d[3] = v[q][i].w; }
        asm volatile("s_waitcnt lgkmcnt(0)" ::: "memory");
        const int c = lane & 7;
#pragma unroll
        for (int j = 0; j < 4; ++j) { const int n = (lane >> 3) + 8 * j; const LAS float* sp = scr + (8 * c) * 33 + n;
            u32x4 o; o.x = pk2(sp[0 * 33], sp[1 * 33]); o.y = pk2(sp[2 * 33], sp[3 * 33]); o.z = pk2(sp[4 * 33], sp[5 * 33]); o.w = pk2(sp[6 * 33], sp[7 * 33]);
            *(u32x4*)(t[q].WT + (size_t)(t[q].drow0 + n) * t[q].ldk + t[q].k0 + 8 * c) = o; }
        asm volatile("s_waitcnt lgkmcnt(0)" ::: "memory");
    }
}
__device__ __forceinline__ void rms_row_bf16(const float* xrow, const float* gain, bf16_t* orow, int lane) {
    f32x4 v[8]; float s = 0.f;
#pragma unroll
    for (int j = 0; j < 8; ++j) { v[j] = ((const f32x4*)xrow)[64 * j + lane]; s += v[j].x * v[j].x + v[j].y * v[j].y + v[j].z * v[j].z + v[j].w * v[j].w; }
    const float r = rsqrtf(wave_sum(s) * (1.0f / DM) + 1e-6f);
#pragma unroll
    for (int j = 0; j < 8; ++j) { const f32x4 g = ((const f32x4*)gain)[64 * j + lane]; const f32x4 o = v[j] * r * g;
        u32x2 w; w.x = pk2(o.x, o.y); w.y = pk2(o.z, o.w); ((u32x2*)orow)[64 * j + lane] = w; }
}

namespace pg8 {
typedef short bf16x8 __attribute__((ext_vector_type(8)));
constexpr int BM = 256, BK = 64, HALF = 128, HTB = HALF * BK * 2, STAGE_BYTES = 8 * HTB, NXCD = 8, WGM = 8;
__device__ __forceinline__ int lds_byte(int r, int c) { const int st = (r >> 4) * 2 + (c >> 5), rr = r & 15, cc = c & 31, ob = rr * 64 + cc * 2; return st * 1024 + (ob ^ (((ob >> 9) & 1) << 5)); }
__device__ __forceinline__ void stage_rc(int b, int& R, int& C) { const int st = b / 1024, sb = b % 1024, swz = sb ^ (((sb >> 9) & 1) << 5); R = (st >> 1) * 16 + swz / 64; C = (st & 1) * 32 + (swz % 64) / 2; }
__device__ __forceinline__ int perm32(int rho) { const int n = rho >> 4, i = rho & 15; return 8 * (i >> 2) + 4 * n + (i & 3); }

struct Unit { int pm, pn, b; };
struct Gemm { const bf16_t* A; const bf16_t* Bt; int M, N, K, lda, ldb, nb; size_t sA, sB; };

struct Order {
    int nM, nN, nwg, nb, G, c, maxi, base;
    __device__ void init(int M, int N, int nb_, int G_, int c_, int maxi_ = (1 << 30), int base_ = 0) { nM = M / BM; nN = N / BM; nwg = nM * nN; nb = nb_; G = G_; c = c_; maxi = maxi_; base = base_; }
    __device__ bool next(int i, Unit& u) const {
        if (i >= maxi) return false;
        const long L = (long)base + (long)i * G + c; if (L >= (long)nwg * nb) return false;
        u.b = (int)(L / nwg); int wgid = (int)(L % nwg);
        { const int q = nwg / NXCD, r = nwg % NXCD, xcd = wgid % NXCD, off = wgid / NXCD; wgid = (xcd < r ? xcd * (q + 1) : r * (q + 1) + (xcd - r) * q) + off; }
        const int nig = WGM * nN, gid = wgid / nig, fm = gid * WGM, gsz = (nM - fm) < WGM ? (nM - fm) : WGM;
        u.pm = fm + ((wgid % nig) % gsz); u.pn = (wgid % nig) / gsz; return true;
    }
};

template <class Epi>
__device__ __forceinline__ void gemm_phase(LAS unsigned char* lds, const Gemm g, const Order& S, const Epi& E, const int tid) {
    const int wid = __builtin_amdgcn_readfirstlane(tid >> 6), lane = tid & 63, wr = wid >> 2, wc = wid & 3, fr = lane & 15, fq = lane >> 4;
    int K_ = g.K; asm volatile("" : "+s"(K_));
    const int nt = K_ / BK;
    unsigned voffA[2], voffB[2];
#pragma unroll
    for (int i = 0; i < 2; ++i) { int R, C; stage_rc(tid * 16 + i * 8192, R, C); const int Rb = Epi::PERM ? ((R & ~31) + perm32(R & 31)) : R;
        voffA[i] = (unsigned)(R * g.lda + C) * 2u; voffB[i] = (unsigned)(Rb * g.ldb + C) * 2u; }
    const size_t kstep = (size_t)(BK * 2);
    const size_t hstepA = (size_t)HALF * g.lda * 2, tstepA = 2 * hstepA, hstepB = (size_t)HALF * g.ldb * 2, tstepB = 2 * hstepB;
    const unsigned ldsw = (unsigned)wid * 1024u;
    const int aoff = lds_byte(wr * 64 + fr, fq * 8), boff = lds_byte(wc * 32 + fr, fq * 8);
#define PG8_SA(b, h) (((b) * 2 + (h)) * HTB)
#define PG8_SB(b, h) ((4 + (b) * 2 + (h)) * HTB)
#define PG8_STAGE(bufoff, gbase, voff) do { _Pragma("unroll") for (int _i = 0; _i < 2; ++_i) \
        __builtin_amdgcn_global_load_lds((const unsigned*)((const char*)(gbase) + (voff)[_i]), (LAS unsigned*)(lds + (bufoff) + ldsw + _i * 8192), 16, 0, 0); } while (0)
#define PG8_LDA(dst, b, h) do { _Pragma("unroll") for (int m = 0; m < 4; ++m) _Pragma("unroll") for (int k = 0; k < 2; ++k) dst[m][k] = *(const LAS bf16x8*)(lds + PG8_SA(b, h) + aoff + m * 2048 + k * 1024); } while (0)
#define PG8_LDB(dst, b, h) do { _Pragma("unroll") for (int n = 0; n < 2; ++n) _Pragma("unroll") for (int k = 0; k < 2; ++k) dst[n][k] = *(const LAS bf16x8*)(lds + PG8_SB(b, h) + boff + n * 2048 + k * 1024); } while (0)
#define PG8_MMA(ai, bj, At, Bt) do { __builtin_amdgcn_s_setprio(1); _Pragma("unroll") for (int m = 0; m < 4; ++m) _Pragma("unroll") for (int n = 0; n < 2; ++n) _Pragma("unroll") for (int k = 0; k < 2; ++k) \
        acc[ai][bj][m][n] = __builtin_amdgcn_mfma_f32_16x16x32_bf16(Bt[n][k], At[m][k], acc[ai][bj][m][n], 0, 0, 0); __builtin_amdgcn_s_setprio(0); } while (0)
#define PG8_WAIT_V(n) asm volatile("s_waitcnt vmcnt(" #n ")" ::: "memory")
#define PG8_WAIT_L(n) asm volatile("s_waitcnt lgkmcnt(" #n ")" ::: "memory")
#define PG8_BAR __builtin_amdgcn_s_barrier()
#define PG8_SCHED __builtin_amdgcn_sched_barrier(0)
    Unit cur, nxt; int ui = 0;
    if (!S.next(0, cur)) return;
    f32x4 acc[2][2][4][2];
#pragma unroll
    for (int a = 0; a < 2; ++a)
#pragma unroll
        for (int b = 0; b < 2; ++b)
#pragma unroll
            for (int m = 0; m < 4; ++m)
#pragma unroll
                for (int n = 0; n < 2; ++n) acc[a][b][m][n] = (f32x4){0.f, 0.f, 0.f, 0.f};
    bf16x8 At[4][2], B0[2][2], B1[2][2];
    const char* cA = (const char*)g.A + (size_t)cur.b * g.sA * 2 + (size_t)cur.pm * tstepA; const char* cB = (const char*)g.Bt + (size_t)cur.b * g.sB * 2 + (size_t)cur.pn * tstepB;
    PG8_STAGE(PG8_SB(0, 0), cB, voffB); PG8_STAGE(PG8_SB(0, 1), cB + hstepB, voffB); PG8_STAGE(PG8_SA(0, 0), cA, voffA); PG8_STAGE(PG8_SA(0, 1), cA + hstepA, voffA);
    if (wr == 1) PG8_BAR;
    PG8_WAIT_V(2); PG8_BAR;
    PG8_STAGE(PG8_SB(1, 0), cB + kstep, voffB); PG8_STAGE(PG8_SA(1, 0), cA + kstep, voffA); PG8_STAGE(PG8_SB(1, 1), cB + hstepB + kstep, voffB);
    PG8_WAIT_V(6); PG8_BAR;
    for (;;) {
        const bool has_next = S.next(ui + 1, nxt);
        const char* nA = has_next ? (const char*)g.A + (size_t)nxt.b * g.sA * 2 + (size_t)nxt.pm * tstepA : cA;
        const char* nB = has_next ? (const char*)g.Bt + (size_t)nxt.b * g.sB * 2 + (size_t)nxt.pn * tstepB : cB;
        for (int t = 0; t < nt; t += 2) {
            const bool last = (t == nt - 2);
            const char* a1 = cA + (size_t)(t + 1) * kstep;
            const char* a2 = last ? nA : cA + (size_t)(t + 2) * kstep; const char* b2 = last ? nB : cB + (size_t)(t + 2) * kstep;
            const char* a3 = a2 + kstep; const char* b3 = b2 + kstep;
            PG8_LDB(B0, 0, 0); PG8_LDB(B1, 0, 1); PG8_SCHED; PG8_LDA(At, 0, 0); PG8_STAGE(PG8_SA(1, 1), a1 + hstepA, voffA);
            PG8_WAIT_V(8); PG8_WAIT_L(0); PG8_BAR; PG8_MMA(0, 0, At, B0); PG8_MMA(0, 1, At, B1); PG8_BAR; PG8_SCHED;
            PG8_LDA(At, 0, 1); PG8_STAGE(PG8_SB(0, 0), b2, voffB); PG8_STAGE(PG8_SB(0, 1), b2 + hstepB, voffB); PG8_STAGE(PG8_SA(0, 0), a2, voffA);
            PG8_WAIT_V(8); PG8_WAIT_L(0); PG8_BAR; PG8_MMA(1, 0, At, B0); PG8_MMA(1, 1, At, B1); PG8_BAR; PG8_SCHED;
            PG8_LDB(B0, 1, 0); PG8_LDB(B1, 1, 1); PG8_SCHED; PG8_LDA(At, 1, 0); PG8_STAGE(PG8_SA(0, 1), a2 + hstepA, voffA);
            PG8_WAIT_V(8); PG8_WAIT_L(0); PG8_BAR; PG8_MMA(0, 0, At, B0); PG8_MMA(0, 1, At, B1); PG8_BAR; PG8_SCHED;
            PG8_LDA(At, 1, 1); PG8_STAGE(PG8_SB(1, 0), b3, voffB); PG8_STAGE(PG8_SB(1, 1), b3 + hstepB, voffB); PG8_STAGE(PG8_SA(1, 0), a3, voffA);
            PG8_WAIT_V(8); PG8_WAIT_L(0); PG8_BAR; PG8_MMA(1, 0, At, B0); PG8_MMA(1, 1, At, B1); PG8_BAR; PG8_SCHED;
        }
        if (wr == 0) PG8_BAR;
        if constexpr (Epi::FUSED) E.fused(acc, cur, wr, wc, fr, fq); else E(acc, cur, wr, wc, fr, fq);
        if (!has_next) break;
        if (!(Epi::CHAIN && cur.b == 0)) {
#pragma unroll
        for (int a = 0; a < 2; ++a)
#pragma unroll
            for (int b = 0; b < 2; ++b)
#pragma unroll
                for (int m = 0; m < 4; ++m)
#pragma unroll
                    for (int n = 0; n < 2; ++n) acc[a][b][m][n] = (f32x4){0.f, 0.f, 0.f, 0.f};
        }
        cur = nxt; cA = nA; cB = nB; ++ui;
        if (wr == 1) PG8_BAR;
    }
    PG8_WAIT_V(0);
    PG8_BAR;
#undef PG8_SA
#undef PG8_SB
#undef PG8_STAGE
#undef PG8_LDA
#undef PG8_LDB
#undef PG8_MMA
#undef PG8_WAIT_V
#undef PG8_WAIT_L
#undef PG8_BAR
#undef PG8_SCHED
}
}

#define XB_TMO      128
#define XB_XCNT(j)  (256  + 64 * (j))
#define XB_XSUB(j)  (1280 + 64 * (j))
#define XB_XGEN(j)  (2304 + 64 * (j))
#define XB_TOP      3328
#define XB_TOPGEN   3392
#define XCD_BAR_WORDS 3456
#define XB_SPIN_CAP (1u << 22)
__device__ __forceinline__ unsigned xb_ld(unsigned* p)              { return __hip_atomic_load(p, __ATOMIC_RELAXED, __HIP_MEMORY_SCOPE_AGENT); }
__device__ __forceinline__ unsigned xb_add(unsigned* p, unsigned v) { return __hip_atomic_fetch_add(p, v, __ATOMIC_RELAXED, __HIP_MEMORY_SCOPE_AGENT); }
__device__ __forceinline__ unsigned xb_xcc_id() { return (unsigned)__builtin_amdgcn_s_getreg((3 << 11) | 20) & 0xFu; }
#define XB_SPIN(cond, bar) do { unsigned _sp = 0; while (cond) { __builtin_amdgcn_s_sleep(1); \
    if ((++_sp & 255u) == 0u) { if (xb_ld(&(bar)[XB_TMO])) break; if (_sp > XB_SPIN_CAP) { atomicAdd(&(bar)[XB_TMO], 1u); break; } } } } while (0)
struct XcdBarrier { unsigned* bar; unsigned x; volatile LAS unsigned* st; };
__device__ __forceinline__ XcdBarrier xcd_barrier_post(unsigned* bar, volatile LAS unsigned* st) {
    XcdBarrier b; b.bar = bar; b.x = xb_xcc_id(); b.st = st;
    if (threadIdx.x == 0) (void)xb_add(&bar[XB_XCNT(b.x)], 1u);
    return b;
}
__device__ __forceinline__ void xcd_barrier_complete(unsigned* bar, unsigned x, unsigned& nloc, unsigned& nx) {
    const unsigned G = gridDim.x * gridDim.y * gridDim.z;
    unsigned sum, cnt, mine, sp = 0u;
    for (;;) {
        sum = 0u; cnt = 0u; mine = 0u;
#pragma unroll
        for (unsigned j = 0; j < 16; ++j) { const unsigned c = xb_ld(&bar[XB_XCNT(j)]); sum += c; cnt += (c > 0u) ? 1u : 0u; mine = (j == x) ? c : mine; }
        if (sum == G) break;
        __builtin_amdgcn_s_sleep(1);
        if ((++sp & 255u) == 0u) { if (xb_ld(&bar[XB_TMO])) break; if (sp > XB_SPIN_CAP) { atomicAdd(&bar[XB_TMO], 1u); break; } }
    }
    nloc = mine > 0u ? mine : 1u; nx = cnt > 0u ? cnt : 1u;
}
__device__ __forceinline__ void xcd_barrier(const XcdBarrier& b) {
    asm volatile("s_waitcnt vmcnt(0)" ::: "memory");
    __syncthreads();
    if (threadIdx.x == 0) {
        unsigned* bar = b.bar;
        __builtin_amdgcn_s_waitcnt(0);
        unsigned nloc = b.st[0], nx = b.st[1];
        if (nloc == 0u) { xcd_barrier_complete(bar, b.x, nloc, nx); b.st[0] = nloc; b.st[1] = nx; }
        const unsigned old = xb_add(&bar[XB_XSUB(b.x)], 1u);
        const unsigned gen = old / nloc;
        if (old + 1u == (gen + 1u) * nloc) {
            __builtin_amdgcn_fence(__ATOMIC_RELEASE, "agent");
            asm volatile("s_waitcnt vmcnt(0)" ::: "memory");
            const unsigned og = xb_add(&bar[XB_TOP], 1u);
            const unsigned tg = og / nx;
            if (og + 1u == (tg + 1u) * nx) xb_add(&bar[XB_TOPGEN], 1u);
            else XB_SPIN(xb_ld(&bar[XB_TOPGEN]) == tg, bar);
            __builtin_amdgcn_fence(__ATOMIC_ACQUIRE, "agent");
            xb_add(&bar[XB_XGEN(b.x)], 1u);
            asm volatile("s_waitcnt vmcnt(0)" ::: "memory");
        } else {
            XB_SPIN(xb_ld(&bar[XB_XGEN(b.x)]) == gen, bar);
            __builtin_amdgcn_fence(__ATOMIC_ACQUIRE, "agent");
            asm volatile("s_waitcnt vmcnt(0)" ::: "memory");
        }
    }
    __syncthreads();
}

typedef f32x4 acc_t[2][2][4][2];
#define EPI_ROW(ai, m) (u.pm * 256 + (ai) * 128 + wr * 64 + (m) * 16 + fr)
__device__ __forceinline__ u32x4 pack8(const f32x4 a, const f32x4 b) { u32x4 w; w.x = pk2(a.x, a.y); w.y = pk2(a.z, a.w); w.z = pk2(b.x, b.y); w.w = pk2(b.z, b.w); return w; }
__device__ __forceinline__ f32x4 sig4(const f32x4 v) { f32x4 o; o.x = sigmoidf_(v.x); o.y = sigmoidf_(v.y); o.z = sigmoidf_(v.z); o.w = sigmoidf_(v.w); return o; }

struct EpiZf {
    static constexpr bool PERM = true, FUSED = false, CHAIN = false;
    bf16_t *q, *k, *vT, *ax, *ga, *gs; const float* rope;
    __device__ __forceinline__ void operator()(const acc_t& acc, const pg8::Unit& u, int wr, int wc, int fr, int fq) const {
        const int pn = u.pn;
#pragma unroll
        for (int ai = 0; ai < 2; ++ai)
#pragma unroll
            for (int m = 0; m < 4; ++m) {
                const int row = EPI_ROW(ai, m);
#pragma unroll
                for (int bj = 0; bj < 2; ++bj) {
                    f32x4 v0 = acc[ai][bj][m][0], v1 = acc[ai][bj][m][1];
                    const int cl = bj * 128 + wc * 32 + 8 * fq;
                    if (pn < 4 || (pn == 4 && bj == 0)) {
                        if ((wc & 1) == 0) {
                            f32x4 p0, p1;
                            p0.x = __shfl_xor(v0.x, 16); p0.y = __shfl_xor(v0.y, 16); p0.z = __shfl_xor(v0.z, 16); p0.w = __shfl_xor(v0.w, 16);
                            p1.x = __shfl_xor(v1.x, 16); p1.y = __shfl_xor(v1.y, 16); p1.z = __shfl_xor(v1.z, 16); p1.w = __shfl_xor(v1.w, 16);
                            if (fq < 2) {
                                const f32x4* rp = (const f32x4*)(rope + (size_t)row * 16);
                                const f32x4 r0 = rp[0], r1 = rp[1], r2 = rp[2], r3 = rp[3];
                                const float sg = (fq == 0) ? -1.f : 1.f;
                                v0.x = v0.x * r0.x + sg * p0.x * r0.y; v0.y = v0.y * r0.z + sg * p0.y * r0.w;
                                v0.z = v0.z * r1.x + sg * p0.z * r1.y; v0.w = v0.w * r1.z + sg * p0.w * r1.w;
                                v1.x = v1.x * r2.x + sg * p1.x * r2.y; v1.y = v1.y * r2.z + sg * p1.y * r2.w;
                                v1.z = v1.z * r3.x + sg * p1.z * r3.y; v1.w = v1.w * r3.z + sg * p1.w * r3.w;
                            }
                        }
                        bf16_t* dst = (pn < 4) ? (q + (size_t)row * 1024 + pn * 256 + cl) : (k + (size_t)row * 128 + cl);
                        *(u32x4*)dst = pack8(v0, v1);
                    } else if (pn == 4) {
                        bf16_t* dst = vT + (size_t)(cl - 128) * SEQ + row;
                        dst[0 * (size_t)SEQ] = (bf16_t)f2bf(v0.x); dst[1 * (size_t)SEQ] = (bf16_t)f2bf(v0.y); dst[2 * (size_t)SEQ] = (bf16_t)f2bf(v0.z); dst[3 * (size_t)SEQ] = (bf16_t)f2bf(v0.w);
                        dst[4 * (size_t)SEQ] = (bf16_t)f2bf(v1.x); dst[5 * (size_t)SEQ] = (bf16_t)f2bf(v1.y); dst[6 * (size_t)SEQ] = (bf16_t)f2bf(v1.z); dst[7 * (size_t)SEQ] = (bf16_t)f2bf(v1.w);
                    } else if (pn < 9) {
                        const int c = (pn - 5) * 256 + cl, g = c >> 4, ci0 = c & 15;
                        *(u32x4*)(ax + ((size_t)g * 512 + (row >> 4)) * 384 + (row & 15) * 16 + ci0) = pack8(v0, v1);
                    } else if (pn < 17) {
                        *(u32x4*)(ga + (size_t)row * 2048 + (pn - 9) * 256 + cl) = pack8(sig4(v0), sig4(v1));
                    } else {
                        *(u32x4*)(gs + (size_t)row * 2048 + (pn - 17) * 256 + cl) = pack8(sig4(v0), sig4(v1));
                    }
                }
            }
    }
};
struct EpiSf {
    static constexpr bool PERM = false, FUSED = false, CHAIN = false; float* S;
    __device__ __forceinline__ void operator()(const acc_t& acc, const pg8::Unit& u, int wr, int wc, int fr, int fq) const {
#pragma unroll
        for (int ai = 0; ai < 2; ++ai)
#pragma unroll
            for (int m = 0; m < 4; ++m) { const int row = EPI_ROW(ai, m);
#pragma unroll
                for (int n = 0; n < 2; ++n) *(f32x4*)(S + ((size_t)u.b * 512 + row) * 128 + wc * 32 + 16 * n + 4 * fq) = acc[ai][0][m][n]; }
    }
};
struct EpiYf {
    static constexpr bool PERM = true, FUSED = false, CHAIN = false; bf16_t* y;
    __device__ __forceinline__ void operator()(const acc_t& acc, const pg8::Unit& u, int wr, int wc, int fr, int fq) const {
#pragma unroll
        for (int ai = 0; ai < 2; ++ai)
#pragma unroll
            for (int m = 0; m < 4; ++m) { const int row = EPI_ROW(ai, m);
#pragma unroll
                for (int bj = 0; bj < 2; ++bj) { const int c = bj * 128 + wc * 32 + 8 * fq, t = c >> 4, co0 = c & 15;
                    const f32x4 a0 = acc[ai][bj][m][0], a1 = acc[ai][bj][m][1];
                    u32x4 w; w.x = pk2(gelu_tanh(a0.x), gelu_tanh(a0.y)); w.y = pk2(gelu_tanh(a0.z), gelu_tanh(a0.w)); w.z = pk2(gelu_tanh(a1.x), gelu_tanh(a1.y)); w.w = pk2(gelu_tanh(a1.z), gelu_tanh(a1.w));
                    *(u32x4*)(y + (unsigned)((row * 16 + t) * 1024 + u.b * 16 + co0)) = w;
                    asm volatile("" ::: "memory"); } }
    }
};
struct EpiGLUf {
    static constexpr bool PERM = true, FUSED = false, CHAIN = false; bf16_t* o;
    __device__ __forceinline__ void operator()(const acc_t& acc, const pg8::Unit& u, int wr, int wc, int fr, int fq) const {
#pragma unroll
        for (int ai = 0; ai < 2; ++ai)
#pragma unroll
            for (int m = 0; m < 4; ++m) { const int row = EPI_ROW(ai, m);
                const f32x4 v0 = acc[ai][0][m][0] * sig4(acc[ai][1][m][0]), v1 = acc[ai][0][m][1] * sig4(acc[ai][1][m][1]);
                *(u32x4*)(o + (size_t)row * 1024 + u.pn * 128 + wc * 32 + 8 * fq) = pack8(v0, v1); }
    }
};
__device__ __forceinline__ f32x4 ld_bf4(const bf16_t* p) { const u32x2 w = *(const u32x2*)p; f32x4 o; o.x = bf2f(w.x & 0xffffu); o.y = bf2f(w.x >> 16); o.z = bf2f(w.y & 0xffffu); o.w = bf2f(w.y >> 16); return o; }
__device__ __forceinline__ void ld_bf8(const bf16_t* p, f32x4& lo, f32x4& hi) { const u32x4 w = *(const u32x4*)p;
    lo.x = bf2f(w.x & 0xffffu); lo.y = bf2f(w.x >> 16); lo.z = bf2f(w.y & 0xffffu); lo.w = bf2f(w.y >> 16); hi.x = bf2f(w.z & 0xffffu); hi.y = bf2f(w.z >> 16); hi.z = bf2f(w.w & 0xffffu); hi.w = bf2f(w.w >> 16); }
__device__ __forceinline__ void ld_bf8_nt(const bf16_t* p, f32x4& lo, f32x4& hi) { const u32x4 w = __builtin_nontemporal_load((const u32x4*)p);
    lo.x = bf2f(w.x & 0xffffu); lo.y = bf2f(w.x >> 16); lo.z = bf2f(w.y & 0xffffu); lo.w = bf2f(w.y >> 16); hi.x = bf2f(w.z & 0xffffu); hi.y = bf2f(w.z >> 16); hi.z = bf2f(w.w & 0xffffu); hi.w = bf2f(w.w >> 16); }
struct EpiBrF {
    static constexpr bool PERM = true, FUSED = true, CHAIN = true; const bf16_t* ga; const bf16_t* gs; bf16_t* mo;
    __device__ __forceinline__ void fused(acc_t& acc, const pg8::Unit& u, int wr, int wc, int fr, int fq) const {
#pragma unroll
        for (int ai = 0; ai < 2; ++ai)
#pragma unroll
            for (int m = 0; m < 4; ++m) { const int row = EPI_ROW(ai, m);
#pragma unroll
                for (int bj = 0; bj < 2; ++bj) { const unsigned o = (unsigned)(row * 2048 + u.pn * 256 + bj * 128 + wc * 32 + 8 * fq); f32x4 s0, s1; if (u.b == 0) ld_bf8(gs + o, s0, s1); else ld_bf8_nt(gs + o, s0, s1);
                    if (u.b == 0) { f32x4 a0, a1; ld_bf8_nt(ga + o, a0, a1);
                        f32x4 r0, r1; r0.x = a0.x * __builtin_amdgcn_rcpf(fmaxf(s0.x, 1e-30f)); r0.y = a0.y * __builtin_amdgcn_rcpf(fmaxf(s0.y, 1e-30f)); r0.z = a0.z * __builtin_amdgcn_rcpf(fmaxf(s0.z, 1e-30f)); r0.w = a0.w * __builtin_amdgcn_rcpf(fmaxf(s0.w, 1e-30f));
                        r1.x = a1.x * __builtin_amdgcn_rcpf(fmaxf(s1.x, 1e-30f)); r1.y = a1.y * __builtin_amdgcn_rcpf(fmaxf(s1.y, 1e-30f)); r1.z = a1.z * __builtin_amdgcn_rcpf(fmaxf(s1.z, 1e-30f)); r1.w = a1.w * __builtin_amdgcn_rcpf(fmaxf(s1.w, 1e-30f));
                        acc[ai][bj][m][0] = acc[ai][bj][m][0] * r0; acc[ai][bj][m][1] = acc[ai][bj][m][1] * r1; }
                    else *(u32x4*)(mo + o) = pack8(acc[ai][bj][m][0] * s0, acc[ai][bj][m][1] * s1); } }
    }
};
struct EpiT1f {
    static constexpr bool PERM = true, FUSED = false, CHAIN = false; f32x4* t1; const bf16_t* ga; int tid;
    __device__ __forceinline__ void operator()(const acc_t& acc, const pg8::Unit& u, int wr, int wc, int fr, int fq) const {
        f32x4* base = t1 + (size_t)(u.pm * 8 + u.pn) * 32 * 512 + tid;
#pragma unroll
        for (int ai = 0; ai < 2; ++ai)
#pragma unroll
            for (int m = 0; m < 4; ++m) { const int row = EPI_ROW(ai, m);
#pragma unroll
                for (int bj = 0; bj < 2; ++bj) { const int col = u.pn * 256 + bj * 128 + wc * 32 + 8 * fq; f32x4 g0, g1; ld_bf8(ga + (size_t)row * 2048 + col, g0, g1);
                    base[(((ai * 2 + bj) * 4 + m) * 2 + 0) * 512] = g0 * acc[ai][bj][m][0]; base[(((ai * 2 + bj) * 4 + m) * 2 + 1) * 512] = g1 * acc[ai][bj][m][1]; } }
    }
};
struct EpiMf {
    static constexpr bool PERM = true, FUSED = false, CHAIN = false; const f32x4* t1; const bf16_t* gs; bf16_t* mo; int tid;
    __device__ __forceinline__ void operator()(const acc_t& acc, const pg8::Unit& u, int wr, int wc, int fr, int fq) const {
        const f32x4* base = t1 + (size_t)(u.pm * 8 + u.pn) * 32 * 512 + tid;
#pragma unroll
        for (int ai = 0; ai < 2; ++ai)
#pragma unroll
            for (int m = 0; m < 4; ++m) { const int row = EPI_ROW(ai, m);
#pragma unroll
                for (int bj = 0; bj < 2; ++bj) { const int col = u.pn * 256 + bj * 128 + wc * 32 + 8 * fq; f32x4 g0, g1; ld_bf8(gs + (size_t)row * 2048 + col, g0, g1);
                    const f32x4 v0 = base[(((ai * 2 + bj) * 4 + m) * 2 + 0) * 512] + g0 * acc[ai][bj][m][0], v1 = base[(((ai * 2 + bj) * 4 + m) * 2 + 1) * 512] + g1 * acc[ai][bj][m][1];
                    *(u32x4*)(mo + (size_t)row * 2048 + col) = pack8(v0, v1); } }
    }
};
struct EpiF32f {
    static constexpr bool PERM = false, FUSED = false, CHAIN = false; float* o;
    __device__ __forceinline__ void operator()(const acc_t& acc, const pg8::Unit& u, int wr, int wc, int fr, int fq) const {
#pragma unroll
        for (int ai = 0; ai < 2; ++ai)
#pragma unroll
            for (int m = 0; m < 4; ++m) { const int row = EPI_ROW(ai, m);
#pragma unroll
                for (int bj = 0; bj < 2; ++bj)
#pragma unroll
                    for (int n = 0; n < 2; ++n) *(f32x4*)(o + (size_t)row * 2048 + u.pn * 256 + bj * 128 + wc * 32 + 16 * n + 4 * fq) = acc[ai][bj][m][n]; }
    }
};
struct EpiUpf {
    static constexpr bool PERM = true, FUSED = false, CHAIN = false; bf16_t* a; const float* part2;
    __device__ __forceinline__ void operator()(const acc_t& acc, const pg8::Unit& u, int wr, int wc, int fr, int fq) const {
#pragma unroll
        for (int ai = 0; ai < 2; ++ai)
#pragma unroll
            for (int m = 0; m < 4; ++m) { const int row = EPI_ROW(ai, m);
                const f32x4* pp = (const f32x4*)(part2 + (size_t)row * 32 + fq * 8); const f32x4 pa = pp[0], pb = pp[1];
                float ss = ((pa.x + pa.y) + (pa.z + pa.w)) + ((pb.x + pb.y) + (pb.z + pb.w)); ss += __shfl_xor(ss, 16); ss += __shfl_xor(ss, 32);
                const float ri = rsqrtf(ss * (1.0f / DM) + 1e-6f);
#pragma unroll
                for (int bj = 0; bj < 2; ++bj) {
                    f32x4 v0 = acc[ai][bj][m][0] * ri, v1 = acc[ai][bj][m][1] * ri;
                    v0.x = fmaxf(v0.x, 0.f); v0.y = fmaxf(v0.y, 0.f); v0.z = fmaxf(v0.z, 0.f); v0.w = fmaxf(v0.w, 0.f);
                    v1.x = fmaxf(v1.x, 0.f); v1.y = fmaxf(v1.y, 0.f); v1.z = fmaxf(v1.z, 0.f); v1.w = fmaxf(v1.w, 0.f);
                    *(u32x4*)(a + (size_t)row * DFF + u.pn * 256 + bj * 128 + wc * 32 + 8 * fq) = pack8(v0 * v0, v1 * v1); } }
    }
};

__device__ __forceinline__ void row_partials(const acc_t& acc, float* part, const pg8::Unit& u, int wr, int wc, int fr, int fq) {
#pragma unroll
    for (int ai = 0; ai < 2; ++ai)
#pragma unroll
        for (int m = 0; m < 4; ++m) {
            float s = 0.f;
#pragma unroll
            for (int bj = 0; bj < 2; ++bj)
#pragma unroll
                for (int n = 0; n < 2; ++n) { const f32x4 v = acc[ai][bj][m][n]; s += (v.x * v.x + v.y * v.y) + (v.z * v.z + v.w * v.w); }
            s += __shfl_xor(s, 16); s += __shfl_xor(s, 32);
            if (fq == 0) part[(size_t)EPI_ROW(ai, m) * 32 + u.pn * 4 + wc] = s;
        }
}
__device__ __forceinline__ void row_rinv(const float* part, float (&rinv)[2][4], const pg8::Unit& u, int wr, int fr, int fq) {
#pragma unroll
    for (int ai = 0; ai < 2; ++ai)
#pragma unroll
        for (int m = 0; m < 4; ++m) {
            const f32x4* pp = (const f32x4*)(part + (size_t)EPI_ROW(ai, m) * 32 + fq * 8);
            const f32x4 a = pp[0], b = pp[1];
            float s = ((a.x + a.y) + (a.z + a.w)) + ((b.x + b.y) + (b.z + b.w));
            s += __shfl_xor(s, 16); s += __shfl_xor(s, 32);
            rinv[ai][m] = rsqrtf(s * (1.0f / DM) + 1e-6f);
        }
}
struct EpiOutNormF {
    static constexpr bool PERM = true, FUSED = true, CHAIN = false;
    const float* x; const float* g1; const float* g2; float* x1; bf16_t* h2; float* part1; float* part2; XcdBarrier xb;
    __device__ __forceinline__ void fused(acc_t& acc, const pg8::Unit& u, int wr, int wc, int fr, int fq) const {
        float rinv[2][4];
        row_partials(acc, part1, u, wr, wc, fr, fq);
        xcd_barrier(xb);
        row_rinv(part1, rinv, u, wr, fr, fq);
#pragma unroll
        for (int bj = 0; bj < 2; ++bj) { const int col = u.pn * 256 + bj * 128 + wc * 32 + 8 * fq;
            const f32x4 ga0 = *(const f32x4*)(g1 + col), ga1 = *(const f32x4*)(g1 + col + 4), gb0 = *(const f32x4*)(g2 + col), gb1 = *(const f32x4*)(g2 + col + 4);
#pragma unroll
            for (int ai = 0; ai < 2; ++ai)
#pragma unroll
              for (int mh = 0; mh < 2; ++mh) {
                f32x4 xv[2][2];
#pragma unroll
                for (int mm = 0; mm < 2; ++mm) { const unsigned o = (unsigned)(EPI_ROW(ai, 2 * mh + mm) * DM + col); xv[mm][0] = __builtin_nontemporal_load((const f32x4*)(x + o)); xv[mm][1] = __builtin_nontemporal_load((const f32x4*)(x + o + 4)); }
#pragma unroll
                for (int mm = 0; mm < 2; ++mm) { const int m = 2 * mh + mm; const unsigned o = (unsigned)(EPI_ROW(ai, m) * DM + col);
                    const f32x4 v0 = xv[mm][0] + acc[ai][bj][m][0] * rinv[ai][m] * ga0, v1 = xv[mm][1] + acc[ai][bj][m][1] * rinv[ai][m] * ga1;
                    acc[ai][bj][m][0] = v0; acc[ai][bj][m][1] = v1; *(f32x4*)(x1 + o) = v0; *(f32x4*)(x1 + o + 4) = v1; *(u32x4*)(h2 + o) = pack8(v0 * gb0, v1 * gb1); }
#pragma unroll
                for (int mm = 0; mm < 2; ++mm) asm volatile("" : "+v"(acc[ai][bj][2 * mh + mm][0]), "+v"(acc[ai][bj][2 * mh + mm][1]));
                asm volatile("" ::: "memory"); } }
        row_partials(acc, part2, u, wr, wc, fr, fq);
    }
};
struct EpiDownNormF {
    static constexpr bool PERM = true, FUSED = true, CHAIN = false;
    const float* g; float* x1; float* part; XcdBarrier xb;
    __device__ __forceinline__ void fused(acc_t& acc, const pg8::Unit& u, int wr, int wc, int fr, int fq) const {
        float rinv[2][4];
        row_partials(acc, part, u, wr, wc, fr, fq);
        xcd_barrier(xb);
        row_rinv(part, rinv, u, wr, fr, fq);
#pragma unroll
        for (int bj = 0; bj < 2; ++bj) { const int col = u.pn * 256 + bj * 128 + wc * 32 + 8 * fq;
            const f32x4 g0 = *(const f32x4*)(g + col), g1 = *(const f32x4*)(g + col + 4);
#pragma unroll
            for (int ai = 0; ai < 2; ++ai)
#pragma unroll
                for (int m = 0; m < 4; ++m) { float* o = x1 + (unsigned)(EPI_ROW(ai, m) * DM + col);
                    const f32x4 a0 = __builtin_nontemporal_load((const f32x4*)o), a1 = __builtin_nontemporal_load((const f32x4*)(o + 4));
                    __builtin_nontemporal_store(a0 + acc[ai][bj][m][0] * rinv[ai][m] * g0, (f32x4*)o); __builtin_nontemporal_store(a1 + acc[ai][bj][m][1] * rinv[ai][m] * g1, (f32x4*)(o + 4)); } }
    }
};

typedef float f32x16 __attribute__((ext_vector_type(16)));
typedef short s16x8 __attribute__((ext_vector_type(8)));
constexpr int ATT_KROW = 144, ATT_VROW = 336, ATT_VOFF = 160 * ATT_KROW;
__device__ __forceinline__ void attn_stage(LAS unsigned char* lds, const bf16_t* Kb, const bf16_t* VT, const int q0, const int hk, const int tid) {
    for (int c = tid; c < 1280; c += 512) {
        const int row = c >> 3, ch = c & 7, key = q0 - 128 + row;
        u32x4 v = {0u, 0u, 0u, 0u}; if (key >= 0) v = *(const u32x4*)(Kb + (size_t)key * 128 + hk * 64 + ch * 8);
        *(LAS u32x4*)(lds + row * ATT_KROW + ch * 16) = v;
        const int d = c / 20, cc = c % 20, k0 = q0 - 128 + cc * 8;
        u32x4 w = {0u, 0u, 0u, 0u}; if (k0 >= 0) w = *(const u32x4*)(VT + (size_t)(hk * 64 + d) * SEQ + k0);
        *(LAS u32x4*)(lds + ATT_VOFF + d * ATT_VROW + cc * 16) = w;
    }
}
__device__ __forceinline__ void attn_item(LAS unsigned char* lds, const bf16_t* Q, bf16_t* O, const float sink, const int q0, const int h, const int lane) {
    const int r = lane & 31, hf = lane >> 5;
    s16x8 qf[4];
#pragma unroll
    for (int kk = 0; kk < 4; ++kk) qf[kk] = *(const s16x8*)(Q + (size_t)(q0 + r) * 1024 + h * 64 + 16 * kk + 8 * hf);
    f32x16 st[5];
#pragma unroll
    for (int kt = 0; kt < 5; ++kt) {
        f32x16 a = {0.f, 0.f, 0.f, 0.f, 0.f, 0.f, 0.f, 0.f, 0.f, 0.f, 0.f, 0.f, 0.f, 0.f, 0.f, 0.f};
#pragma unroll
        for (int kk = 0; kk < 4; ++kk) {
            const s16x8 kf = *(const LAS s16x8*)(lds + (32 * kt + r) * ATT_KROW + (16 * kk + 8 * hf) * 2);
            a = __builtin_amdgcn_mfma_f32_32x32x16_bf16(kf, qf[kk], a, 0, 0, 0);
        }
        st[kt] = a;
    }
    float mx = sink;
#pragma unroll
    for (int kt = 0; kt < 5; ++kt)
#pragma unroll
        for (int e = 0; e < 16; ++e) {
            const int kofs = -128 + 32 * kt + (e & 3) + 8 * (e >> 2) + 4 * hf;
            const int diff = r - kofs;
            const bool ok = (diff >= 0) && (diff < 128) && (q0 + kofs >= 0);
            const float sv = ok ? st[kt][e] * 0.125f : -1e30f;
            st[kt][e] = sv; mx = fmaxf(mx, sv);
        }
    mx = fmaxf(mx, __shfl_xor(mx, 32));
    float sum = 0.f;
#pragma unroll
    for (int kt = 0; kt < 5; ++kt)
#pragma unroll
        for (int e = 0; e < 16; ++e) { const float pv = (st[kt][e] > -1e29f) ? __expf(st[kt][e] - mx) : 0.f; st[kt][e] = pv; sum += pv; }
    sum += __shfl_xor(sum, 32);
    sum += __expf(sink - mx);
    const float inv = 1.0f / sum;
    f32x16 o0 = {0.f, 0.f, 0.f, 0.f, 0.f, 0.f, 0.f, 0.f, 0.f, 0.f, 0.f, 0.f, 0.f, 0.f, 0.f, 0.f}, o1 = o0;
#pragma unroll
    for (int kt = 0; kt < 5; ++kt)
#pragma unroll
        for (int s = 0; s < 2; ++s) {
            u32x4 pw; pw.x = pk2(st[kt][8 * s + 0], st[kt][8 * s + 1]); pw.y = pk2(st[kt][8 * s + 2], st[kt][8 * s + 3]);
            pw.z = pk2(st[kt][8 * s + 4], st[kt][8 * s + 5]); pw.w = pk2(st[kt][8 * s + 6], st[kt][8 * s + 7]);
            const s16x8 pf = __builtin_bit_cast(s16x8, pw);
#pragma unroll
            for (int dt = 0; dt < 2; ++dt) {
                const LAS unsigned char* vp = lds + ATT_VOFF + (32 * dt + r) * ATT_VROW + (32 * kt + 16 * s + 4 * hf) * 2;
                const u32x2 a0 = *(const LAS u32x2*)vp, a1 = *(const LAS u32x2*)(vp + 16);
                u32x4 vw; vw.x = a0.x; vw.y = a0.y; vw.z = a1.x; vw.w = a1.y;
                const s16x8 vf = __builtin_bit_cast(s16x8, vw);
                if (dt == 0) o0 = __builtin_amdgcn_mfma_f32_32x32x16_bf16(vf, pf, o0, 0, 0, 0);
                else o1 = __builtin_amdgcn_mfma_f32_32x32x16_bf16(vf, pf, o1, 0, 0, 0);
            }
        }
    bf16_t* op = O + (size_t)(q0 + r) * 1024 + h * 64 + 4 * hf;
#pragma unroll
    for (int i = 0; i < 4; ++i) {
        u32x2 w; w.x = pk2(o0[4 * i] * inv, o0[4 * i + 1] * inv); w.y = pk2(o0[4 * i + 2] * inv, o0[4 * i + 3] * inv); *(u32x2*)(op + 8 * i) = w;
        u32x2 w1; w1.x = pk2(o1[4 * i] * inv, o1[4 * i + 1] * inv); w1.y = pk2(o1[4 * i + 2] * inv, o1[4 * i + 3] * inv); *(u32x2*)(op + 32 + 8 * i) = w1;
    }
}

constexpr int NPHASE = 8;

#ifndef PROBE_PH
#define PROBE_PH -1
#endif
template <int PH, int REP = 1>
__device__ __forceinline__ void run_phase(const P& p, LAS unsigned char* lds, const XcdBarrier& xb) {
    int tid_ = threadIdx.x; asm volatile("" : "+v"(tid_));
    const int tid = tid_, lane = tid & 63, wave = tid >> 6;
    int bid_ = blockIdx.x; asm volatile("" : "+s"(bid_));
    const int bid = bid_;
    const int G = gridDim.x, gw = bid * 8 + wave, NGW = G * 8;
    const size_t gt = (size_t)bid * 512 + tid, NGT = (size_t)G * 512;
    unsigned char* ws = p.ws; unsigned char* dout = (unsigned char*)p.out;
    asm volatile("" : "+s"(ws), "+s"(dout));
    float* PART1 = (float*)(ws + WS_PART1); float* PART2 = (float*)(ws + WS_PART2);
    float2* AP = (float2*)(ws + WS_AP); float2* BBAR = (float2*)(ws + WS_BBAR); float2* ROPE = (float2*)(ws + WS_ROPE);
    bf16_t* WUP = (bf16_t*)(ws + WS_WUP); bf16_t* WDN = (bf16_t*)(ws + WS_WDN); bf16_t* WIN = (bf16_t*)(ws + WS_WIN); bf16_t* WGLU = (bf16_t*)(ws + WS_WGLU);
    bf16_t* WBRA = (bf16_t*)(ws + WS_WBRA); bf16_t* WBRS = (bf16_t*)(ws + WS_WBRS); bf16_t* WOUT = (bf16_t*)(ws + WS_WOUT);
    bf16_t* H = (bf16_t*)(ws + WS_H); bf16_t* OATT = (bf16_t*)(ws + WS_OATT); bf16_t* Q = (bf16_t*)(ws + WS_Q); bf16_t* OSSM = (bf16_t*)(ws + WS_OSSM);
    bf16_t* Kb = (bf16_t*)(ws + WS_K); bf16_t* VT = (bf16_t*)(ws + WS_VT); bf16_t* AX = (bf16_t*)(ws + WS_AX); bf16_t* Y = (bf16_t*)(ws + WS_Y);
    bf16_t* Mb = (bf16_t*)(ws + WS_M); bf16_t* GA = (bf16_t*)(ws + WS_GA); bf16_t* GS = (bf16_t*)(ws + WS_GS); float* MIXED = (float*)(ws + WS_MIXED);
    bf16_t* H2 = (bf16_t*)(ws + WS_H2); bf16_t* Ab = (bf16_t*)(ws + WS_A); float* DN = (float*)(ws + WS_DN);
    float* S = (float*)(dout + DO_S); float* KTAB = (float*)(dout + DO_KTAB); bf16_t* BC = (bf16_t*)(dout + DO_BC); bf16_t* YB = (bf16_t*)(dout + DO_YB);
    float* T1 = (float*)dout; float* X1 = (float*)dout;
    const float* x = p.in[0];

    if constexpr (PH == 0) {
        LAS float* scr = (LAS float*)(lds + wave * 16384);
        for (int base = bid * 32; base < TI_IN; base += G * 32) transpose_quad(p, base + wave * 4, scr, lane);
        if (gw < SEQ) {
            f32x4 v[8];
#pragma unroll
            for (int j = 0; j < 8; ++j) v[j] = __builtin_nontemporal_load((const f32x4*)(x + (size_t)gw * DM) + 64 * j + lane);
            for (int m = gw; m < SEQ; m += NGW) {
                const bool more = m + NGW < SEQ; f32x4 nv[8];
                if (more) {
#pragma unroll
                    for (int j = 0; j < 8; ++j) nv[j] = __builtin_nontemporal_load((const f32x4*)(x + (size_t)(m + NGW) * DM) + 64 * j + lane); }
                float ss = 0.f;
#pragma unroll
                for (int j = 0; j < 8; ++j) ss += v[j].x * v[j].x + v[j].y * v[j].y + v[j].z * v[j].z + v[j].w * v[j].w;
                const float rr = rsqrtf(wave_sum(ss) * (1.0f / DM) + 1e-6f);
#pragma unroll
                for (int j = 0; j < 8; ++j) { const f32x4 g = ((const f32x4*)p.in[1])[64 * j + lane]; const f32x4 o = v[j] * rr * g;
                    u32x2 w; w.x = pk2(o.x, o.y); w.y = pk2(o.z, o.w); ((u32x2*)(H + (size_t)m * DM))[64 * j + lane] = w; }
                if (more) {
#pragma unroll
                    for (int j = 0; j < 8; ++j) v[j] = nv[j]; }
            }
        }
        for (size_t e = gt; e < (size_t)NG * SP * NAP; e += NGT) {
            const int i = (int)(e / NAP), n = (int)(e % NAP), g = i / SP;
            const double dt = exp((double)p.in[9][g]), lr = (double)p.in[7][i], li = (double)p.in[8][i];
            const double pw = (n == 17) ? 1024.0 : (double)n;
            const float mag = (float)exp(pw * lr * dt); float sn, cs; sincos_d(pw * li * dt, sn, cs);
            AP[((size_t)g * NAP + n) * SP + (i % SP)] = make_float2(mag * cs, mag * sn);
        }
        for (size_t e = gt; e < (size_t)NG * SP * GC; e += NGT) {
            const int i = (int)(e >> 4), g = i / SP;
            const double dt = exp((double)p.in[9][g]), lr = (double)p.in[7][i], li = (double)p.in[8][i];
            float s1, c1; sincos_d(li * dt, s1, c1);
            const double mag1 = exp(lr * dt), are = mag1 * (double)c1, aim = mag1 * (double)s1;
            const double nr = are - 1.0, ni = aim, den = lr * lr + li * li;
            const double cre = (nr * lr + ni * li) / den, cim = (ni * lr - nr * li) / den;
            const double br = (double)p.in[10][e], bi = (double)p.in[11][e];
            BBAR[e] = make_float2((float)(cre * br - cim * bi), (float)(cre * bi + cim * br));
        }
        for (size_t i = gt; i < (size_t)SEQ * 8; i += NGT) {
            const int pos = (int)(i >> 3), k = (int)(i & 7);
            const double inv = exp(-(double)k * 0.125 * 13.122363377404328);
            float s, c; sincos_d((double)pos * inv, s, c);
            ROPE[i] = make_float2(c, s);
        }
        }
    if constexpr (PH == 1) {
        { pg8::Gemm g{H, WIN, SEQ, INW, DM, DM, DM, 1, 0, 0}; pg8::Order S; S.init(SEQ, INW, 1, G, bid, 3);
          EpiZf E{Q, Kb, VT, AX, GA, GS, (const float*)ROPE}; pg8::gemm_phase(lds, g, S, E, tid); }
        for (size_t e = gt; e < (size_t)NG * 256 * 32; e += NGT) {
            const int g = (int)(e >> 13), r = (int)(e >> 5) & 255, k8 = (int)e & 31, s_ = k8 >> 1, ci0 = (k8 & 1) * 8;
            u32x4 w = {0u, 0u, 0u, 0u};
            if (r < 128) { const int pp = r & 63; const float2 a = AP[((size_t)g * NAP + 15 - s_) * SP + pp];
                const f32x4* bp = (const f32x4*)(BBAR + ((size_t)g * SP + pp) * GC + ci0); const f32x4 b0 = bp[0], b1 = bp[1], b2 = bp[2], b3 = bp[3];
                if (r >> 6) { w.x = pk2(a.x * b0.y + a.y * b0.x, a.x * b0.w + a.y * b0.z); w.y = pk2(a.x * b1.y + a.y * b1.x, a.x * b1.w + a.y * b1.z);
                              w.z = pk2(a.x * b2.y + a.y * b2.x, a.x * b2.w + a.y * b2.z); w.w = pk2(a.x * b3.y + a.y * b3.x, a.x * b3.w + a.y * b3.z); }
                else {        w.x = pk2(a.x * b0.x - a.y * b0.y, a.x * b0.z - a.y * b0.w); w.y = pk2(a.x * b1.x - a.y * b1.y, a.x * b1.z - a.y * b1.w);
                              w.z = pk2(a.x * b2.x - a.y * b2.y, a.x * b2.z - a.y * b2.w); w.w = pk2(a.x * b3.x - a.y * b3.y, a.x * b3.z - a.y * b3.w); } }
            *(u32x4*)(BC + e * 8) = w;
        }
        for (size_t e = gt; e < (size_t)NG * 256 * 16; e += NGT) {
            const int g = (int)(e >> 12), row = (int)(e >> 4) & 255, r0 = ((int)e & 15) * 8, t = row >> 4, co = row & 15, pp0 = r0 & 63;
            const f32x4* ap = (const f32x4*)(AP + ((size_t)g * NAP + t + 1) * SP + pp0); const f32x4 a0 = ap[0], a1 = ap[1], a2 = ap[2], a3 = ap[3];
            const f32x4* crp = (const f32x4*)(p.in[12] + ((size_t)g * GC + co) * SP + pp0); const f32x4* cip = (const f32x4*)(p.in[13] + ((size_t)g * GC + co) * SP + pp0);
            const f32x4 cr0 = crp[0], cr1 = crp[1], ci0 = cip[0], ci1 = cip[1];
            u32x4 w;
            if (r0 >> 6) { w.x = pk2(-(cr0.x * a0.y + ci0.x * a0.x), -(cr0.y * a0.w + ci0.y * a0.z)); w.y = pk2(-(cr0.z * a1.y + ci0.z * a1.x), -(cr0.w * a1.w + ci0.w * a1.z));
                           w.z = pk2(-(cr1.x * a2.y + ci1.x * a2.x), -(cr1.y * a2.w + ci1.y * a2.z)); w.w = pk2(-(cr1.z * a3.y + ci1.z * a3.x), -(cr1.w * a3.w + ci1.w * a3.z)); }
            else {         w.x = pk2(cr0.x * a0.x - ci0.x * a0.y, cr0.y * a0.z - ci0.y * a0.w); w.y = pk2(cr0.z * a1.x - ci0.z * a1.y, cr0.w * a1.z - ci0.w * a1.w);
                           w.z = pk2(cr1.x * a2.x - ci1.x * a2.y, cr1.y * a2.z - ci1.y * a2.w); w.w = pk2(cr1.z * a3.x - ci1.z * a3.y, cr1.w * a3.z - ci1.w * a3.w); }
            *(u32x4*)(YB + ((size_t)g * 256 + row) * 384 + 256 + r0) = w;
        }
        {
            LAS float* Cre = (LAS float*)lds; LAS float* Cim = Cre + 16 * 65; LAS float* APr = Cim + 16 * 65; LAS float* APi = APr + 256; LAS float* Bbr = APi + 256; LAS float* Bbi = Bbr + 1024;
            for (int item = bid; item < NG * 4; item += G) {
                const int g = item >> 2, tq = item & 3;
                __syncthreads();
                for (int i = tid; i < 1024; i += 512) { Cre[(i >> 6) * 65 + (i & 63)] = p.in[12][(size_t)g * 1024 + i]; Cim[(i >> 6) * 65 + (i & 63)] = p.in[13][(size_t)g * 1024 + i];
                    const float2 b = BBAR[(size_t)g * 1024 + i]; Bbr[i] = b.x; Bbi[i] = b.y; }
                if (tid < 256) { const float2 a = AP[((size_t)g * NAP + 4 * tq + (tid >> 6)) * SP + (tid & 63)]; APr[tid] = a.x; APi[tid] = a.y; }
                __syncthreads();
#pragma unroll
                for (int rr = 0; rr < 2; ++rr) {
                    const int idx = tid + 512 * rr, tl = idx >> 8, co = (idx >> 4) & 15, ci = idx & 15;
                    float acc = 0.f;
#pragma unroll 8
                    for (int pp = 0; pp < SP; ++pp) {
                        const float cr = Cre[co * 65 + pp], cim = Cim[co * 65 + pp], ax = APr[tl * 64 + pp], ay = APi[tl * 64 + pp];
                        const float wre = cr * ax - cim * ay, wim = cr * ay + cim * ax;
                        acc += wre * Bbr[pp * 16 + ci] - wim * Bbi[pp * 16 + ci];
                    }
                    const int tau = 4 * tq + tl;
                    if (tau == 0 && co == ci) acc += p.in[14][g * GC + co];
                    KTAB[(((size_t)g * 16 + tau) * 16 + co) * 16 + ci] = acc;
                }
            }
            __syncthreads();
        }
        }
    if constexpr (PH == 2) {
        if (bid < 2 * NG) {
            const int g = bid & 63, h = bid >> 6;
            unsigned* flagS = (unsigned*)(ws + WS_CTL + 14464) + g;
            unsigned* flagX = (unsigned*)(ws + WS_CTL + 14464 + 256) + g;
            if (h == 0) {
                for (int e = tid; e < 256 * 32; e += 512) {
                    const int row = e >> 5, k8 = e & 31, s_ = k8 >> 1, ci0 = (k8 & 1) * 8, t = row >> 4, co = row & 15;
                    u32x4 w = {0u, 0u, 0u, 0u};
                    if (t >= s_) { const f32x4* kp = (const f32x4*)(KTAB + (((size_t)g * 16 + (t - s_)) * 16 + co) * 16 + ci0); w = pack8(kp[0], kp[1]); }
                    *(u32x4*)(YB + ((size_t)g * 256 + row) * 384 + 8 * k8) = w;
                }
            }
            { pg8::Gemm gm{AX, BC, 512, 256, 256, 384, 256, NG, (size_t)512 * 384, (size_t)256 * 256}; pg8::Order S_; S_.init(512, 256, NG, 1, 0, 1, 2 * g + h);
              EpiSf E{S}; pg8::gemm_phase(lds, gm, S_, E, tid); }
            asm volatile("s_waitcnt vmcnt(0)" ::: "memory"); __syncthreads();
            if (h == 1) {
                if (tid == 0) { __builtin_amdgcn_fence(__ATOMIC_RELEASE, "agent"); asm volatile("s_waitcnt vmcnt(0)" ::: "memory"); __hip_atomic_store(flagS, 1u, __ATOMIC_RELAXED, __HIP_MEMORY_SCOPE_AGENT);
                    unsigned sp = 0; while (__hip_atomic_load(flagX, __ATOMIC_RELAXED, __HIP_MEMORY_SCOPE_AGENT) == 0u && ++sp < (1u << 24)) __builtin_amdgcn_s_sleep(2);
                    __builtin_amdgcn_fence(__ATOMIC_ACQUIRE, "agent"); asm volatile("s_waitcnt vmcnt(0)" ::: "memory"); }
                __syncthreads();
            } else {
                if (tid == 0) { unsigned sp = 0; while (__hip_atomic_load(flagS, __ATOMIC_RELAXED, __HIP_MEMORY_SCOPE_AGENT) == 0u && ++sp < (1u << 24)) __builtin_amdgcn_s_sleep(2);
                    __builtin_amdgcn_fence(__ATOMIC_ACQUIRE, "agent"); asm volatile("s_waitcnt vmcnt(0)" ::: "memory"); }
                __syncthreads();
        LAS float* Elr = (LAS float*)lds; LAS float* Eli = Elr + 512;
        {
            const int pp = tid & 63, seg = tid >> 6;
            const float2 A16 = AP[((size_t)g * NAP + 16) * SP + pp], A1k = AP[((size_t)g * NAP + 17) * SP + pp];
            const float* Sg = S + (size_t)g * 512 * 128;
            float lre = 0.f, lim = 0.f;
            for (int j0 = seg * 64; j0 < seg * 64 + 64; j0 += 16) {
                float sr[16], si[16];
#pragma unroll
                for (int q = 0; q < 16; ++q) { sr[q] = Sg[(j0 + q) * 128 + pp]; si[q] = Sg[(j0 + q) * 128 + 64 + pp]; }
#pragma unroll
                for (int q = 0; q < 16; ++q) { const float nr = A16.x * lre - A16.y * lim + sr[q], ni = A16.x * lim + A16.y * lre + si[q]; lre = nr; lim = ni; }
            }
            __syncthreads();
            Elr[seg * 64 + pp] = lre; Eli[seg * 64 + pp] = lim;
            __syncthreads();
            float cre = 0.f, cim = 0.f;
            for (int s2 = 0; s2 < seg; ++s2) { const float2 e = make_float2(Elr[s2 * 64 + pp], Eli[s2 * 64 + pp]);
                const float nr = A1k.x * cre - A1k.y * cim + e.x, ni = A1k.x * cim + A1k.y * cre + e.y; cre = nr; cim = ni; }
            for (int j0 = seg * 64; j0 < seg * 64 + 64; j0 += 16) {
                float sr[16], si[16];
#pragma unroll
                for (int q = 0; q < 16; ++q) { sr[q] = Sg[(j0 + q) * 128 + pp]; si[q] = Sg[(j0 + q) * 128 + 64 + pp]; }
#pragma unroll
                for (int q = 0; q < 16; ++q) {
                    bf16_t* axr = AX + ((size_t)g * 512 + j0 + q) * 384 + 256;
                    axr[pp] = (bf16_t)f2bf(cre); axr[64 + pp] = (bf16_t)f2bf(cim);
                    const float nr = A16.x * cre - A16.y * cim + sr[q], ni = A16.x * cim + A16.y * cre + si[q]; cre = nr; cim = ni; }
            }
            }
                asm volatile("s_waitcnt vmcnt(0)" ::: "memory"); __syncthreads();
                if (tid == 0) { __builtin_amdgcn_fence(__ATOMIC_RELEASE, "agent"); asm volatile("s_waitcnt vmcnt(0)" ::: "memory"); __hip_atomic_store(flagX, 1u, __ATOMIC_RELAXED, __HIP_MEMORY_SCOPE_AGENT); }
                __syncthreads();
            }
            { pg8::Gemm gm{AX, YB, 512, 256, 384, 384, 384, NG, (size_t)512 * 384, (size_t)256 * 384}; pg8::Order S_; S_.init(512, 256, NG, 1, 0, 1, 2 * g + h);
              EpiYf E{Y}; pg8::gemm_phase(lds, gm, S_, E, tid); }
        } else if (bid < 2 * NG + 32) {
            pg8::Gemm gm{H, WIN, SEQ, INW, DM, DM, DM, 1, 0, 0}; pg8::Order S_; S_.init(SEQ, INW, 1, 1 << 20, bid - 2 * NG, 1, 768);
            EpiZf E{Q, Kb, VT, AX, GA, GS, (const float*)ROPE}; pg8::gemm_phase(lds, gm, S_, E, tid);
        } else {
            for (int item = bid - (2 * NG + 32); item < 512; item += G - (2 * NG + 32)) {
                const int hk = item & 1, q0 = (item >> 1) * 32, h = hk * 8 + wave;
                __syncthreads();
                attn_stage(lds, Kb, VT, q0, hk, tid);
                __syncthreads();
                attn_item(lds, Q, OATT, p.in[6][h], q0, h, lane);
            }
        }
        {
            unsigned* ctr = (unsigned*)(ws + WS_CTL + 14336); volatile LAS int* slot = (volatile LAS int*)(lds + 131072 + 64);
            for (;;) {
                __syncthreads();
                if (tid == 0) slot[0] = TI_IN + (int)__hip_atomic_fetch_add(ctr, 32u, __ATOMIC_RELAXED, __HIP_MEMORY_SCOPE_AGENT);
                __syncthreads();
                const int base = slot[0];
                if (base >= TI_ALL) break;
                transpose_quad(p, base + wave * 4, (LAS float*)(lds + wave * 16384), lane);
            }
        }
    }
    if constexpr (PH == 3) { pg8::Gemm g{Y, WGLU, SEQ, 2048, 1024, 1024, 1024, 1, 0, 0}; pg8::Order S_; S_.init(SEQ, 2048, 1, G, bid);
        EpiGLUf E{OSSM}; pg8::gemm_phase(lds, g, S_, E, tid); }
    if constexpr (PH == 4) {
        pg8::Gemm g{OATT, WBRA, SEQ, 2048, 1024, 1024, 1024, 2, (size_t)(OSSM - OATT), (size_t)(WBRS - WBRA)}; pg8::Order S_; S_.init(SEQ, 2048, 2, G, bid);
        EpiBrF E{GA, GS, Mb}; pg8::gemm_phase(lds, g, S_, E, tid);
    }
    if constexpr (PH == 5) { pg8::Gemm g{Mb, WOUT, SEQ, 2048, 2048, 2048, 2048, 1, 0, 0}; pg8::Order S_; S_.init(SEQ, 2048, 1, G, bid);
        EpiOutNormF E{x, p.in[2], p.in[3], X1, H2, PART1, PART2, xb}; pg8::gemm_phase(lds, g, S_, E, tid); }
    if constexpr (PH == 6) { pg8::Gemm g{H2, WUP, SEQ, DFF, DM, DM, DM, 1, 0, 0}; pg8::Order S_; S_.init(SEQ, DFF, 1, G, bid);
        EpiUpf E{Ab, PART2}; pg8::gemm_phase(lds, g, S_, E, tid); }
    if constexpr (PH == 7) { pg8::Gemm g{Ab, WDN, SEQ, DM, DFF, DFF, DFF, 1, 0, 0}; pg8::Order S_; S_.init(SEQ, DM, 1, G, bid);
        EpiDownNormF E{p.in[4], X1, PART1, xb}; pg8::gemm_phase(lds, g, S_, E, tid); }
}

constexpr int LDS_BYTES = 147456;

#ifndef TPROBE
#define TPROBE -1
#endif
template <int PH>
__device__ __forceinline__ void run_all(const P& p, LAS unsigned char* lds, cg::grid_group& grid, const XcdBarrier& xb, volatile LAS unsigned* misc) {
    if constexpr (PH == PROBE_PH) { run_phase<PH, 0>(p, lds, xb); xcd_barrier(xb); }
    run_phase<PH>(p, lds, xb);
    if constexpr (PH + 1 < NPHASE) {
        if constexpr (PH == 0) { if (p.use_cg_sync) grid.sync(); else xcd_barrier(xb); } else xcd_barrier(xb);
        if constexpr (TPROBE >= 0) { if (blockIdx.x == 0 && threadIdx.x == 0) misc[4 + PH + 1] = (unsigned)__builtin_amdgcn_s_memrealtime(); }
        run_all<PH + 1>(p, lds, grid, xb, misc);
    }
}
__global__ void __launch_bounds__(512, 2) k_all(P p) {
    extern __shared__ __attribute__((aligned(16))) unsigned char lds_raw[];
    cg::grid_group grid = cg::this_grid();
    LAS unsigned char* lds = (LAS unsigned char*)lds_raw;
    volatile LAS unsigned* misc = (volatile LAS unsigned*)(lds + 131072);
    if (threadIdx.x < 2) misc[threadIdx.x] = 0u;
    __syncthreads();
    const XcdBarrier xb = xcd_barrier_post((unsigned*)(p.ws + WS_CTL), misc);
    if constexpr (TPROBE >= 0) { if (blockIdx.x == 0 && threadIdx.x == 0) misc[4] = (unsigned)__builtin_amdgcn_s_memrealtime(); }
    run_all<0>(p, lds, grid, xb, misc);
    if constexpr (TPROBE >= 0) {
        if (blockIdx.x == 0 && threadIdx.x == 0) {
            const unsigned now = (unsigned)__builtin_amdgcn_s_memrealtime(); misc[4 + NPHASE] = now;
            const unsigned d = misc[4 + TPROBE + 1] - misc[4 + TPROBE];
            while ((unsigned)__builtin_amdgcn_s_memrealtime() - now < 8u * d) __builtin_amdgcn_s_sleep(8);
        }
    }
}

extern "C" void kernel_launch(void* const* d_in, const int* in_sizes, int n_in, void* d_out, int out_size, void* d_ws, size_t ws_size, hipStream_t stream) {
    static int grid = 0;
    if (grid == 0) {
        if (n_in != 20 || out_size != SEQ * DM || ws_size < WS_END) { fprintf(stderr, "kernel_launch: unexpected shapes (n_in %d out %d ws %zu)\n", n_in, out_size, ws_size); grid = -1; return; }
        int dev = 0, cus = 0;
        (void)hipGetDevice(&dev); (void)hipDeviceGetAttribute(&cus, hipDeviceAttributeMultiprocessorCount, dev);
        (void)hipFuncSetAttribute((const void*)k_all, hipFuncAttributeMaxDynamicSharedMemorySize, LDS_BYTES);
        int per_cu = 0;
        (void)hipOccupancyMaxActiveBlocksPerMultiprocessor(&per_cu, (const void*)k_all, 512, LDS_BYTES);
        if (per_cu < 1) fprintf(stderr, "kernel_launch: occupancy query says %d blocks/CU\n", per_cu);
        (void)hipGetLastError();
        if (cus != 256) { fprintf(stderr, "kernel_launch: built for a 256-CU device (one 512-thread workgroup per CU, one 256x256 tile per workgroup in the fused-norm GEMM phases); found %d CUs\n", cus); grid = -1; return; }
        grid = cus;
    }
    if (grid < 0) return;
    P p{};
    for (int i = 0; i < 20; ++i) p.in[i] = (const float*)d_in[i];
    p.out = (float*)d_out; p.ws = (unsigned char*)d_ws;
    (void)hipMemsetAsync((char*)d_ws + WS_CTL, 0, CTL_BYTES, stream);
    void* args[] = {&p};
    hipError_t e = hipLaunchCooperativeKernel((const void*)k_all, dim3(grid), dim3(512), args, LDS_BYTES, stream);
    if (e != hipSuccess) fprintf(stderr, "cooperative launch failed: %s (grid %d)\n", hipGetErrorString(e), grid);
}
```

```cpp
#include <hip/hip_runtime.h>
#include <hip/hip_cooperative_groups.h>
#include <cstdio>
#include <cstdint>
namespace cg = cooperative_groups;


typedef unsigned short bf16_t;
typedef float f32x4 __attribute__((ext_vector_type(4)));
typedef unsigned u32x2 __attribute__((ext_vector_type(2)));
typedef unsigned u32x4 __attribute__((ext_vector_type(4)));
#define LAS __attribute__((address_space(3)))

constexpr int SEQ = 8192, DM = 2048, INW = 6400, QW = 1024, SSMW = 1024, DFF = 8192;
constexpr int NG = 64, GC = 16, SP = 64, NH = 16;
constexpr size_t MiB = 1u << 20;
constexpr size_t WS_AP = 0, WS_BBAR = 1 * MiB, WS_ROPE = 1 * MiB + 512 * 1024, WS_CTL = 2 * MiB, CTL_BYTES = 16384, WS_PART1 = 3 * MiB, WS_PART2 = 0;
constexpr size_t WS_WUP = 4 * MiB, WS_WDN = 36 * MiB, WS_WIN = 68 * MiB, WS_WGLU = 93 * MiB, WS_WBRA = 97 * MiB, WS_WBRS = 101 * MiB, WS_WOUT = 105 * MiB;
constexpr size_t WS_H = 113 * MiB, WS_OSSM = 113 * MiB  , WS_Q = 145 * MiB, WS_OATT = 145 * MiB  , WS_K = 161 * MiB, WS_VT = 163 * MiB, WS_AX = 165 * MiB, WS_Y = 189 * MiB;
constexpr size_t WS_M = 161 * MiB, WS_GA = 205 * MiB, WS_GS = 237 * MiB, WS_MIXED = 205 * MiB, WS_H2 = 68 * MiB, WS_A = 141 * MiB, WS_DN = 68 * MiB, WS_END = 269 * MiB;
constexpr size_t DO_S = 0, DO_KTAB = 16 * MiB, DO_BC = 17 * MiB, DO_YB = 25 * MiB;
constexpr int NAP = 18;

struct P {
    const float* in[20];
    float* out;
    unsigned char* ws;
    unsigned long long use_cg_sync;
};

__device__ __forceinline__ float bf2f(unsigned v) { return __uint_as_float(v << 16); }
__device__ __forceinline__ unsigned f2bf(float f) { unsigned u = __float_as_uint(f); return (u + 0x7fffu + ((u >> 16) & 1u)) >> 16; }
__device__ __forceinline__ unsigned pk2(float lo, float hi) { return f2bf(lo) | (f2bf(hi) << 16); }
__device__ __forceinline__ float wave_sum(float v) {
#pragma unroll
    for (int o = 1; o < 64; o <<= 1) v += __shfl_xor(v, o);
    return v;
}
__device__ __forceinline__ float wave_max(float v) {
#pragma unroll
    for (int o = 1; o < 64; o <<= 1) v = fmaxf(v, __shfl_xor(v, o));
    return v;
}
__device__ __forceinline__ float sigmoidf_(float v) { return __builtin_amdgcn_rcpf(1.0f + __expf(-v)); }
__device__ __forceinline__ float gelu_tanh(float v) {
    const float z2 = 1.5957691216057308f * (v + 0.044715f * v * v * v);
    return v * __builtin_amdgcn_rcpf(1.0f + __expf(-z2));
}
__device__ __forceinline__ void sincos_d(double ang, float& s, float& c) {
    double rev = ang * 0.15915494309189535; rev -= rint(rev);
    const double q4 = rev * 4.0, qr = rint(q4); const int q = ((int)qr) & 3;
    const double th = (q4 - qr) * 1.5707963267948966, t2 = th * th;
    const double sn = th * (1.0 + t2 * (-1.0 / 6 + t2 * (1.0 / 120 + t2 * (-1.0 / 5040 + t2 * (1.0 / 362880 + t2 * (-1.0 / 39916800 + t2 * (1.0 / 6227020800.0)))))));
    const double cs = 1.0 + t2 * (-0.5 + t2 * (1.0 / 24 + t2 * (-1.0 / 720 + t2 * (1.0 / 40320 + t2 * (-1.0 / 3628800 + t2 * (1.0 / 479001600.0 + t2 * (-1.0 / 87178291200.0)))))));
    const double so = (q == 0) ? sn : (q == 1) ? cs : (q == 2) ? -sn : -cs;
    const double co = (q == 0) ? cs : (q == 1) ? -sn : (q == 2) ? -cs : sn;
    s = (float)so; c = (float)co;
}

struct TItem { const float* W; bf16_t* WT; int N, ldk, k0, n0, drow0; };
constexpr int TI_IN = 32 * 200, TI_GLU = 16 * 64, TI_BR = 16 * 64, TI_OUT = 32 * 64, TI_UP = 32 * 256, TI_DN = 128 * 64;
constexpr int TI_P0 = TI_IN + TI_GLU + 2 * TI_BR + TI_OUT, TI_ALL = TI_P0 + TI_UP + TI_DN;
__device__ __forceinline__ void tdecode(int r, int ncols, int& kb, int& nb) { const int st = r >> 5, c = r & 31, sn = ncols >> 8; kb = 4 * (st / sn) + (c & 3); nb = 8 * (st % sn) + (c >> 2); }
__device__ __forceinline__ TItem titem(const P& p, int r) {
    unsigned char* ws = p.ws; TItem t; int kb, nb;
    if (r < TI_IN) { tdecode(r, INW, kb, nb); t = TItem{p.in[5], (bf16_t*)(ws + WS_WIN), INW, 2048, 64 * kb, 32 * nb, 32 * nb}; return t; } r -= TI_IN;
    if (r < TI_GLU) { tdecode(r, 2048, kb, nb); const int n0 = 32 * nb, bj = n0 >> 10, j = n0 & 1023, tt = j >> 7, jj = j & 127;
        t = TItem{p.in[15], (bf16_t*)(ws + WS_WGLU), 2048, 1024, 64 * kb, n0, 256 * tt + 128 * bj + jj}; return t; } r -= TI_GLU;
    if (r < TI_BR) { tdecode(r, 2048, kb, nb); t = TItem{p.in[16], (bf16_t*)(ws + WS_WBRA), 2048, 1024, 64 * kb, 32 * nb, 32 * nb}; return t; } r -= TI_BR;
    if (r < TI_BR) { tdecode(r, 2048, kb, nb); t = TItem{p.in[16] + (size_t)1024 * 2048, (bf16_t*)(ws + WS_WBRS), 2048, 1024, 64 * kb, 32 * nb, 32 * nb}; return t; } r -= TI_BR;
    if (r < TI_OUT) { tdecode(r, 2048, kb, nb); t = TItem{p.in[17], (bf16_t*)(ws + WS_WOUT), 2048, 2048, 64 * kb, 32 * nb, 32 * nb}; return t; } r -= TI_OUT;
    if (r < TI_UP) { tdecode(r, DFF, kb, nb); t = TItem{p.in[18], (bf16_t*)(ws + WS_WUP), DFF, 2048, 64 * kb, 32 * nb, 32 * nb}; return t; } r -= TI_UP;
    { tdecode(r, 2048, kb, nb); t = TItem{p.in[19], (bf16_t*)(ws + WS_WDN), 2048, DFF, 64 * kb, 32 * nb, 32 * nb}; return t; }
}
__device__ __forceinline__ void titem_load(const TItem& t, f32x4 (&v)[8], int lane) {
#pragma unroll
    for (int i = 0; i < 8; ++i) v[i] = __builtin_nontemporal_load((const f32x4*)(t.W + (size_t)(t.k0 + 8 * i + (lane >> 3)) * t.N + t.n0 + (lane & 7) * 4));
}
__device__ __forceinline__ void transpose_quad(const P& p, int i0, LAS float* scr, int lane) {
    TItem t[4]; f32x4 v[4][8];
#pragma unroll
    for (int q = 0; q < 4; ++q) { t[q] = titem(p, i0 + q); titem_load(t[q], v[q], lane); }
#pragma unroll
    for (int q = 0; q < 4; ++q) {
#pragma unroll
        for (int i = 0; i < 8; ++i) { LAS float* d = scr + (8 * i + (lane >> 3)) * 33 + (lane & 7) * 4; d[0] = v[q][i].x; d[1] = v[q][i].y; d[2] = v[q][i].z; d[3] = v[q][i].w; }
        asm volatile("s_waitcnt lgkmcnt(0)" ::: "memory");
        const int c = lane & 7;
#pragma unroll
        for (int j = 0; j < 4; ++j) { const int n = (lane >> 3) + 8 * j; const LAS float* sp = scr + (8 * c) * 33 + n;
            u32x4 o; o.x = pk2(sp[0 * 33], sp[1 * 33]); o.y = pk2(sp[2 * 33], sp[3 * 33]); o.z = pk2(sp[4 * 33], sp[5 * 33]); o.w = pk2(sp[6 * 33], sp[7 * 33]);
            *(u32x4*)(t[q].WT + (size_t)(t[q].drow0 + n) * t[q].ldk + t[q].k0 + 8 * c) = o; }
        asm volatile("s_waitcnt lgkmcnt(0)" ::: "memory");
    }
}
namespace pg8 {
typedef short bf16x8 __attribute__((ext_vector_type(8)));
constexpr int BM = 256, BK = 64, HALF = 128, HTB = HALF * BK * 2, STAGE_BYTES = 8 * HTB, NXCD = 8, WGM = 8;
__device__ __forceinline__ int lds_byte(int r, int c) { const int st = (r >> 4) * 2 + (c >> 5), rr = r & 15, cc = c & 31, ob = rr * 64 + cc * 2; return st * 1024 + (ob ^ (((ob >> 9) & 1) << 5)); }
__device__ __forceinline__ void stage_rc(int b, int& R, int& C) { const int st = b / 1024, sb = b % 1024, swz = sb ^ (((sb >> 9) & 1) << 5); R = (st >> 1) * 16 + swz / 64; C = (st & 1) * 32 + (swz % 64) / 2; }
__device__ __forceinline__ int perm32(int rho) { const int n = rho >> 4, i = rho & 15; return 8 * (i >> 2) + 4 * n + (i & 3); }

struct Unit { int pm, pn, b; };
struct Gemm { const bf16_t* A; const bf16_t* Bt; int M, N, K, lda, ldb, nb; size_t sA, sB; };

struct Order {
    int nM, nN, nwg, nb, G, c, maxi, base;
    __device__ void init(int M, int N, int nb_, int G_, int c_, int maxi_ = (1 << 30), int base_ = 0) { nM = M / BM; nN = N / BM; nwg = nM * nN; nb = nb_; G = G_; c = c_; maxi = maxi_; base = base_; }
    __device__ bool next(int i, Unit& u) const {
        if (i >= maxi) return false;
        const long L = (long)base + (long)i * G + c; if (L >= (long)nwg * nb) return false;
        u.b = (int)(L / nwg); int wgid = (int)(L % nwg);
        { const int q = nwg / NXCD, r = nwg % NXCD, xcd = wgid % NXCD, off = wgid / NXCD; wgid = (xcd < r ? xcd * (q + 1) : r * (q + 1) + (xcd - r) * q) + off; }
        const int nig = WGM * nN, gid = wgid / nig, fm = gid * WGM, gsz = (nM - fm) < WGM ? (nM - fm) : WGM;
        u.pm = fm + ((wgid % nig) % gsz); u.pn = (wgid % nig) / gsz; return true;
    }
};

template <class Epi>
__device__ __forceinline__ void gemm_phase(LAS unsigned char* lds, const Gemm g, const Order& S, const Epi& E, const int tid) {
    const int wid = __builtin_amdgcn_readfirstlane(tid >> 6), lane = tid & 63, wr = wid >> 2, wc = wid & 3, fr = lane & 15, fq = lane >> 4;
    int K_ = g.K; asm volatile("" : "+s"(K_));
    const int nt = K_ / BK;
    unsigned voffA[2], voffB[2];
#pragma unroll
    for (int i = 0; i < 2; ++i) { int R, C; stage_rc(tid * 16 + i * 8192, R, C); const int Rb = Epi::PERM ? ((R & ~31) + perm32(R & 31)) : R;
        voffA[i] = (unsigned)(R * g.lda + C) * 2u; voffB[i] = (unsigned)(Rb * g.ldb + C) * 2u; }
    const size_t kstep = (size_t)(BK * 2);
    const size_t hstepA = (size_t)HALF * g.lda * 2, tstepA = 2 * hstepA, hstepB = (size_t)HALF * g.ldb * 2, tstepB = 2 * hstepB;
    const unsigned ldsw = (unsigned)wid * 1024u;
    const int aoff = lds_byte(wr * 64 + fr, fq * 8), boff = lds_byte(wc * 32 + fr, fq * 8);
#define PG8_SA(b, h) (((b) * 2 + (h)) * HTB)
#define PG8_SB(b, h) ((4 + (b) * 2 + (h)) * HTB)
#define PG8_STAGE(bufoff, gbase, voff) do { _Pragma("unroll") for (int _i = 0; _i < 2; ++_i) \
        __builtin_amdgcn_global_load_lds((const unsigned*)((const char*)(gbase) + (voff)[_i]), (LAS unsigned*)(lds + (bufoff) + ldsw + _i * 8192), 16, 0, 0); } while (0)
#define PG8_LDA(dst, b, h) do { _Pragma("unroll") for (int m = 0; m < 4; ++m) _Pragma("unroll") for (int k = 0; k < 2; ++k) dst[m][k] = *(const LAS bf16x8*)(lds + PG8_SA(b, h) + aoff + m * 2048 + k * 1024); } while (0)
#define PG8_LDB(dst, b, h) do { _Pragma("unroll") for (int n = 0; n < 2; ++n) _Pragma("unroll") for (int k = 0; k < 2; ++k) dst[n][k] = *(const LAS bf16x8*)(lds + PG8_SB(b, h) + boff + n * 2048 + k * 1024); } while (0)
#define PG8_MMA(ai, bj, At, Bt) do { __builtin_amdgcn_s_setprio(1); _Pragma("unroll") for (int m = 0; m < 4; ++m) _Pragma("unroll") for (int n = 0; n < 2; ++n) _Pragma("unroll") for (int k = 0; k < 2; ++k) \
        acc[ai][bj][m][n] = __builtin_amdgcn_mfma_f32_16x16x32_bf16(Bt[n][k], At[m][k], acc[ai][bj][m][n], 0, 0, 0); __builtin_amdgcn_s_setprio(0); } while (0)
#define PG8_WAIT_V(n) asm volatile("s_waitcnt vmcnt(" #n ")" ::: "memory")
#define PG8_WAIT_L(n) asm volatile("s_waitcnt lgkmcnt(" #n ")" ::: "memory")
#define PG8_BAR __builtin_amdgcn_s_barrier()
#define PG8_SCHED __builtin_amdgcn_sched_barrier(0)
    Unit cur, nxt; int ui = 0;
    if (!S.next(0, cur)) return;
    f32x4 acc[2][2][4][2];
#pragma unroll
    for (int a = 0; a < 2; ++a)
#pragma unroll
        for (int b = 0; b < 2; ++b)
#pragma unroll
            for (int m = 0; m < 4; ++m)
#pragma unroll
                for (int n = 0; n < 2; ++n) acc[a][b][m][n] = (f32x4){0.f, 0.f, 0.f, 0.f};
    bf16x8 At[4][2], B0[2][2], B1[2][2];
    const char* cA = (const char*)g.A + (size_t)cur.b * g.sA * 2 + (size_t)cur.pm * tstepA; const char* cB = (const char*)g.Bt + (size_t)cur.b * g.sB * 2 + (size_t)cur.pn * tstepB;
    PG8_STAGE(PG8_SB(0, 0), cB, voffB); PG8_STAGE(PG8_SB(0, 1), cB + hstepB, voffB); PG8_STAGE(PG8_SA(0, 0), cA, voffA); PG8_STAGE(PG8_SA(0, 1), cA + hstepA, voffA);
    if (wr == 1) PG8_BAR;
    PG8_WAIT_V(2); PG8_BAR;
    PG8_STAGE(PG8_SB(1, 0), cB + kstep, voffB); PG8_STAGE(PG8_SA(1, 0), cA + kstep, voffA); PG8_STAGE(PG8_SB(1, 1), cB + hstepB + kstep, voffB);
    PG8_WAIT_V(6); PG8_BAR;
    for (;;) {
        const bool has_next = S.next(ui + 1, nxt);
        const char* nA = has_next ? (const char*)g.A + (size_t)nxt.b * g.sA * 2 + (size_t)nxt.pm * tstepA : cA;
        const char* nB = has_next ? (const char*)g.Bt + (size_t)nxt.b * g.sB * 2 + (size_t)nxt.pn * tstepB : cB;
        for (int t = 0; t < nt; t += 2) {
            const bool last = (t == nt - 2);
            const char* a1 = cA + (size_t)(t + 1) * kstep;
            const char* a2 = last ? nA : cA + (size_t)(t + 2) * kstep; const char* b2 = last ? nB : cB + (size_t)(t + 2) * kstep;
            const char* a3 = a2 + kstep; const char* b3 = b2 + kstep;
            PG8_LDB(B0, 0, 0); PG8_LDB(B1, 0, 1); PG8_SCHED; PG8_LDA(At, 0, 0); PG8_STAGE(PG8_SA(1, 1), a1 + hstepA, voffA);
            PG8_WAIT_V(8); PG8_WAIT_L(0); PG8_BAR; PG8_MMA(0, 0, At, B0); PG8_MMA(0, 1, At, B1); PG8_BAR; PG8_SCHED;
            PG8_LDA(At, 0, 1); PG8_STAGE(PG8_SB(0, 0), b2, voffB); PG8_STAGE(PG8_SB(0, 1), b2 + hstepB, voffB); PG8_STAGE(PG8_SA(0, 0), a2, voffA);
            PG8_WAIT_V(8); PG8_WAIT_L(0); PG8_BAR; PG8_MMA(1, 0, At, B0); PG8_MMA(1, 1, At, B1); PG8_BAR; PG8_SCHED;
            PG8_LDB(B0, 1, 0); PG8_LDB(B1, 1, 1); PG8_SCHED; PG8_LDA(At, 1, 0); PG8_STAGE(PG8_SA(0, 1), a2 + hstepA, voffA);
            PG8_WAIT_V(8); PG8_WAIT_L(0); PG8_BAR; PG8_MMA(0, 0, At, B0); PG8_MMA(0, 1, At, B1); PG8_BAR; PG8_SCHED;
            PG8_LDA(At, 1, 1); PG8_STAGE(PG8_SB(1, 0), b3, voffB); PG8_STAGE(PG8_SB(1, 1), b3 + hstepB, voffB); PG8_STAGE(PG8_SA(1, 0), a3, voffA);
            PG8_WAIT_V(8); PG8_WAIT_L(0); PG8_BAR; PG8_MMA(1, 0, At, B0); PG8_MMA(1, 1, At, B1); PG8_BAR; PG8_SCHED;
        }
        if (wr == 0) PG8_BAR;
        if constexpr (Epi::FUSED) E.fused(acc, cur, wr, wc, fr, fq); else E(acc, cur, wr, wc, fr, fq);
        if (!has_next) break;
        if (!(Epi::CHAIN && cur.b == 0)) {
#pragma unroll
        for (int a = 0; a < 2; ++a)
#pragma unroll
            for (int b = 0; b < 2; ++b)
#pragma unroll
                for (int m = 0; m < 4; ++m)
#pragma unroll
                    for (int n = 0; n < 2; ++n) acc[a][b][m][n] = (f32x4){0.f, 0.f, 0.f, 0.f};
        }
        cur = nxt; cA = nA; cB = nB; ++ui;
        if (wr == 1) PG8_BAR;
    }
    PG8_WAIT_V(0);
    PG8_BAR;
#undef PG8_SA
#undef PG8_SB
#undef PG8_STAGE
#undef PG8_LDA
#undef PG8_LDB
#undef PG8_MMA
#undef PG8_WAIT_V
#undef PG8_WAIT_L
#undef PG8_BAR
#undef PG8_SCHED
}
}

#define XB_TMO      128
#define XB_XCNT(j)  (256  + 64 * (j))
#define XB_XSUB(j)  (1280 + 64 * (j))
#define XB_XGEN(j)  (2304 + 64 * (j))
#define XB_TOP      3328
#define XB_TOPGEN   3392
#define XCD_BAR_WORDS 3456
#define XB_SPIN_CAP (1u << 22)
__device__ __forceinline__ unsigned xb_ld(unsigned* p)              { return __hip_atomic_load(p, __ATOMIC_RELAXED, __HIP_MEMORY_SCOPE_AGENT); }
__device__ __forceinline__ unsigned xb_add(unsigned* p, unsigned v) { return __hip_atomic_fetch_add(p, v, __ATOMIC_RELAXED, __HIP_MEMORY_SCOPE_AGENT); }
__device__ __forceinline__ unsigned xb_xcc_id() { return (unsigned)__builtin_amdgcn_s_getreg((3 << 11) | 20) & 0xFu; }
#define XB_SPIN(cond, bar) do { unsigned _sp = 0; while (cond) { __builtin_amdgcn_s_sleep(1); \
    if ((++_sp & 255u) == 0u) { if (xb_ld(&(bar)[XB_TMO])) break; if (_sp > XB_SPIN_CAP) { atomicAdd(&(bar)[XB_TMO], 1u); break; } } } } while (0)
struct XcdBarrier { unsigned* bar; unsigned x; volatile LAS unsigned* st; };
__device__ __forceinline__ XcdBarrier xcd_barrier_post(unsigned* bar, volatile LAS unsigned* st) {
    XcdBarrier b; b.bar = bar; b.x = xb_xcc_id(); b.st = st;
    if (threadIdx.x == 0) (void)xb_add(&bar[XB_XCNT(b.x)], 1u);
    return b;
}
__device__ __forceinline__ void xcd_barrier_complete(unsigned* bar, unsigned x, unsigned& nloc, unsigned& nx) {
    const unsigned G = gridDim.x * gridDim.y * gridDim.z;
    unsigned sum, cnt, mine, sp = 0u;
    for (;;) {
        sum = 0u; cnt = 0u; mine = 0u;
#pragma unroll
        for (unsigned j = 0; j < 16; ++j) { const unsigned c = xb_ld(&bar[XB_XCNT(j)]); sum += c; cnt += (c > 0u) ? 1u : 0u; mine = (j == x) ? c : mine; }
        if (sum == G) break;
        __builtin_amdgcn_s_sleep(1);
        if ((++sp & 255u) == 0u) { if (xb_ld(&bar[XB_TMO])) break; if (sp > XB_SPIN_CAP) { atomicAdd(&bar[XB_TMO], 1u); break; } }
    }
    nloc = mine > 0u ? mine : 1u; nx = cnt > 0u ? cnt : 1u;
}
__device__ __forceinline__ void xcd_barrier(const XcdBarrier& b) {
    asm volatile("s_waitcnt vmcnt(0)" ::: "memory");
    __syncthreads();
    if (threadIdx.x == 0) {
        unsigned* bar = b.bar;
        __builtin_amdgcn_s_waitcnt(0);
        unsigned nloc = b.st[0], nx = b.st[1];
        if (nloc == 0u) { xcd_barrier_complete(bar, b.x, nloc, nx); b.st[0] = nloc; b.st[1] = nx; }
        const unsigned old = xb_add(&bar[XB_XSUB(b.x)], 1u);
        const unsigned gen = old / nloc;
        if (old + 1u == (gen + 1u) * nloc) {
            __builtin_amdgcn_fence(__ATOMIC_RELEASE, "agent");
            asm volatile("s_waitcnt vmcnt(0)" ::: "memory");
            const unsigned og = xb_add(&bar[XB_TOP], 1u);
            const unsigned tg = og / nx;
            if (og + 1u == (tg + 1u) * nx) xb_add(&bar[XB_TOPGEN], 1u);
            else XB_SPIN(xb_ld(&bar[XB_TOPGEN]) == tg, bar);
            __builtin_amdgcn_fence(__ATOMIC_ACQUIRE, "agent");
            xb_add(&bar[XB_XGEN(b.x)], 1u);
            asm volatile("s_waitcnt vmcnt(0)" ::: "memory");
        } else {
            XB_SPIN(xb_ld(&bar[XB_XGEN(b.x)]) == gen, bar);
            __builtin_amdgcn_fence(__ATOMIC_ACQUIRE, "agent");
            asm volatile("s_waitcnt vmcnt(0)" ::: "memory");
        }
    }
    __syncthreads();
}

typedef f32x4 acc_t[2][2][4][2];
#define EPI_ROW(ai, m) (u.pm * 256 + (ai) * 128 + wr * 64 + (m) * 16 + fr)
__device__ __forceinline__ u32x4 pack8(const f32x4 a, const f32x4 b) { u32x4 w; w.x = pk2(a.x, a.y); w.y = pk2(a.z, a.w); w.z = pk2(b.x, b.y); w.w = pk2(b.z, b.w); return w; }
__device__ __forceinline__ f32x4 sig4(const f32x4 v) { f32x4 o; o.x = sigmoidf_(v.x); o.y = sigmoidf_(v.y); o.z = sigmoidf_(v.z); o.w = sigmoidf_(v.w); return o; }

struct EpiZf {
    static constexpr bool PERM = true, FUSED = false, CHAIN = false;
    bf16_t *q, *k, *vT, *ax, *ga, *gs; const float* rope;
    __device__ __forceinline__ void operator()(const acc_t& acc, const pg8::Unit& u, int wr, int wc, int fr, int fq) const {
        const int pn = u.pn;
#pragma unroll
        for (int ai = 0; ai < 2; ++ai)
#pragma unroll
            for (int m = 0; m < 4; ++m) {
                const int row = EPI_ROW(ai, m);
#pragma unroll
                for (int bj = 0; bj < 2; ++bj) {
                    f32x4 v0 = acc[ai][bj][m][0], v1 = acc[ai][bj][m][1];
                    const int cl = bj * 128 + wc * 32 + 8 * fq;
                    if (pn < 4 || (pn == 4 && bj == 0)) {
                        if ((wc & 1) == 0) {
                            f32x4 p0, p1;
                            p0.x = __shfl_xor(v0.x, 16); p0.y = __shfl_xor(v0.y, 16); p0.z = __shfl_xor(v0.z, 16); p0.w = __shfl_xor(v0.w, 16);
                            p1.x = __shfl_xor(v1.x, 16); p1.y = __shfl_xor(v1.y, 16); p1.z = __shfl_xor(v1.z, 16); p1.w = __shfl_xor(v1.w, 16);
                            if (fq < 2) {
                                const f32x4* rp = (const f32x4*)(rope + (size_t)row * 16);
                                const f32x4 r0 = rp[0], r1 = rp[1], r2 = rp[2], r3 = rp[3];
                                const float sg = (fq == 0) ? -1.f : 1.f;
                                v0.x = v0.x * r0.x + sg * p0.x * r0.y; v0.y = v0.y * r0.z + sg * p0.y * r0.w;
                                v0.z = v0.z * r1.x + sg * p0.z * r1.y; v0.w = v0.w * r1.z + sg * p0.w * r1.w;
                                v1.x = v1.x * r2.x + sg * p1.x * r2.y; v1.y = v1.y * r2.z + sg * p1.y * r2.w;
                                v1.z = v1.z * r3.x + sg * p1.z * r3.y; v1.w = v1.w * r3.z + sg * p1.w * r3.w;
                            }
                        }
                        bf16_t* dst = (pn < 4) ? (q + (size_t)row * 1024 + pn * 256 + cl) : (k + (size_t)row * 128 + cl);
                        *(u32x4*)dst = pack8(v0, v1);
                    } else if (pn == 4) {
                        bf16_t* dst = vT + (size_t)(cl - 128) * SEQ + row;
                        dst[0 * (size_t)SEQ] = (bf16_t)f2bf(v0.x); dst[1 * (size_t)SEQ] = (bf16_t)f2bf(v0.y); dst[2 * (size_t)SEQ] = (bf16_t)f2bf(v0.z); dst[3 * (size_t)SEQ] = (bf16_t)f2bf(v0.w);
                        dst[4 * (size_t)SEQ] = (bf16_t)f2bf(v1.x); dst[5 * (size_t)SEQ] = (bf16_t)f2bf(v1.y); dst[6 * (size_t)SEQ] = (bf16_t)f2bf(v1.z); dst[7 * (size_t)SEQ] = (bf16_t)f2bf(v1.w);
                    } else if (pn < 9) {
                        const int c = (pn - 5) * 256 + cl, g = c >> 4, ci0 = c & 15;
                        *(u32x4*)(ax + ((size_t)g * 512 + (row >> 4)) * 384 + (row & 15) * 16 + ci0) = pack8(v0, v1);
                    } else if (pn < 17) {
                        *(u32x4*)(ga + (size_t)row * 2048 + (pn - 9) * 256 + cl) = pack8(sig4(v0), sig4(v1));
                    } else {
                        *(u32x4*)(gs + (size_t)row * 2048 + (pn - 17) * 256 + cl) = pack8(sig4(v0), sig4(v1));
                    }
                }
            }
    }
};
struct EpiSf {
    static constexpr bool PERM = false, FUSED = false, CHAIN = false; float* S;
    __device__ __forceinline__ void operator()(const acc_t& acc, const pg8::Unit& u, int wr, int wc, int fr, int fq) const {
#pragma unroll
        for (int ai = 0; ai < 2; ++ai)
#pragma unroll
            for (int m = 0; m < 4; ++m) { const int row = EPI_ROW(ai, m);
#pragma unroll
                for (int n = 0; n < 2; ++n) *(f32x4*)(S + ((size_t)u.b * 512 + row) * 128 + wc * 32 + 16 * n + 4 * fq) = acc[ai][0][m][n]; }
    }
};
struct EpiYf {
    static constexpr bool PERM = true, FUSED = false, CHAIN = false; bf16_t* y;
    __device__ __forceinline__ void operator()(const acc_t& acc, const pg8::Unit& u, int wr, int wc, int fr, int fq) const {
#pragma unroll
        for (int ai = 0; ai < 2; ++ai)
#pragma unroll
            for (int m = 0; m < 4; ++m) { const int row = EPI_ROW(ai, m);
#pragma unroll
                for (int bj = 0; bj < 2; ++bj) { const int c = bj * 128 + wc * 32 + 8 * fq, t = c >> 4, co0 = c & 15;
                    const f32x4 a0 = acc[ai][bj][m][0], a1 = acc[ai][bj][m][1];
                    u32x4 w; w.x = pk2(gelu_tanh(a0.x), gelu_tanh(a0.y)); w.y = pk2(gelu_tanh(a0.z), gelu_tanh(a0.w)); w.z = pk2(gelu_tanh(a1.x), gelu_tanh(a1.y)); w.w = pk2(gelu_tanh(a1.z), gelu_tanh(a1.w));
                    *(u32x4*)(y + (unsigned)((row * 16 + t) * 1024 + u.b * 16 + co0)) = w;
                    asm volatile("" ::: "memory"); } }
    }
};
struct EpiGLUf {
    static constexpr bool PERM = true, FUSED = false, CHAIN = false; bf16_t* o;
    __device__ __forceinline__ void operator()(const acc_t& acc, const pg8::Unit& u, int wr, int wc, int fr, int fq) const {
#pragma unroll
        for (int ai = 0; ai < 2; ++ai)
#pragma unroll
            for (int m = 0; m < 4; ++m) { const int row = EPI_ROW(ai, m);
                const f32x4 v0 = acc[ai][0][m][0] * sig4(acc[ai][1][m][0]), v1 = acc[ai][0][m][1] * sig4(acc[ai][1][m][1]);
                *(u32x4*)(o + (size_t)row * 1024 + u.pn * 128 + wc * 32 + 8 * fq) = pack8(v0, v1); }
    }
};
__device__ __forceinline__ void ld_bf8(const bf16_t* p, f32x4& lo, f32x4& hi) { const u32x4 w = *(const u32x4*)p;
    lo.x = bf2f(w.x & 0xffffu); lo.y = bf2f(w.x >> 16); lo.z = bf2f(w.y & 0xffffu); lo.w = bf2f(w.y >> 16); hi.x = bf2f(w.z & 0xffffu); hi.y = bf2f(w.z >> 16); hi.z = bf2f(w.w & 0xffffu); hi.w = bf2f(w.w >> 16); }
__device__ __forceinline__ void ld_bf8_nt(const bf16_t* p, f32x4& lo, f32x4& hi) { const u32x4 w = __builtin_nontemporal_load((const u32x4*)p);
    lo.x = bf2f(w.x & 0xffffu); lo.y = bf2f(w.x >> 16); lo.z = bf2f(w.y & 0xffffu); lo.w = bf2f(w.y >> 16); hi.x = bf2f(w.z & 0xffffu); hi.y = bf2f(w.z >> 16); hi.z = bf2f(w.w & 0xffffu); hi.w = bf2f(w.w >> 16); }
struct EpiBrF {
    static constexpr bool PERM = true, FUSED = true, CHAIN = true; const bf16_t* ga; const bf16_t* gs; bf16_t* mo;
    __device__ __forceinline__ void fused(acc_t& acc, const pg8::Unit& u, int wr, int wc, int fr, int fq) const {
#pragma unroll
        for (int ai = 0; ai < 2; ++ai)
#pragma unroll
            for (int m = 0; m < 4; ++m) { const int row = EPI_ROW(ai, m);
#pragma unroll
                for (int bj = 0; bj < 2; ++bj) { const unsigned o = (unsigned)(row * 2048 + u.pn * 256 + bj * 128 + wc * 32 + 8 * fq); f32x4 s0, s1; if (u.b == 0) ld_bf8(gs + o, s0, s1); else ld_bf8_nt(gs + o, s0, s1);
                    if (u.b == 0) { f32x4 a0, a1; ld_bf8_nt(ga + o, a0, a1);
                        f32x4 r0, r1; r0.x = a0.x * __builtin_amdgcn_rcpf(fmaxf(s0.x, 1e-30f)); r0.y = a0.y * __builtin_amdgcn_rcpf(fmaxf(s0.y, 1e-30f)); r0.z = a0.z * __builtin_amdgcn_rcpf(fmaxf(s0.z, 1e-30f)); r0.w = a0.w * __builtin_amdgcn_rcpf(fmaxf(s0.w, 1e-30f));
                        r1.x = a1.x * __builtin_amdgcn_rcpf(fmaxf(s1.x, 1e-30f)); r1.y = a1.y * __builtin_amdgcn_rcpf(fmaxf(s1.y, 1e-30f)); r1.z = a1.z * __builtin_amdgcn_rcpf(fmaxf(s1.z, 1e-30f)); r1.w = a1.w * __builtin_amdgcn_rcpf(fmaxf(s1.w, 1e-30f));
                        acc[ai][bj][m][0] = acc[ai][bj][m][0] * r0; acc[ai][bj][m][1] = acc[ai][bj][m][1] * r1; }
                    else *(u32x4*)(mo + o) = pack8(acc[ai][bj][m][0] * s0, acc[ai][bj][m][1] * s1); } }
    }
};
struct EpiUpf {
    static constexpr bool PERM = true, FUSED = false, CHAIN = false; bf16_t* a; const float* part2;
    __device__ __forceinline__ void operator()(const acc_t& acc, const pg8::Unit& u, int wr, int wc, int fr, int fq) const {
#pragma unroll
        for (int ai = 0; ai < 2; ++ai)
#pragma unroll
            for (int m = 0; m < 4; ++m) { const int row = EPI_ROW(ai, m);
                const f32x4* pp = (const f32x4*)(part2 + (size_t)row * 32 + fq * 8); const f32x4 pa = pp[0], pb = pp[1];
                float ss = ((pa.x + pa.y) + (pa.z + pa.w)) + ((pb.x + pb.y) + (pb.z + pb.w)); ss += __shfl_xor(ss, 16); ss += __shfl_xor(ss, 32);
                const float ri = rsqrtf(ss * (1.0f / DM) + 1e-6f);
#pragma unroll
                for (int bj = 0; bj < 2; ++bj) {
                    f32x4 v0 = acc[ai][bj][m][0] * ri, v1 = acc[ai][bj][m][1] * ri;
                    v0.x = fmaxf(v0.x, 0.f); v0.y = fmaxf(v0.y, 0.f); v0.z = fmaxf(v0.z, 0.f); v0.w = fmaxf(v0.w, 0.f);
                    v1.x = fmaxf(v1.x, 0.f); v1.y = fmaxf(v1.y, 0.f); v1.z = fmaxf(v1.z, 0.f); v1.w = fmaxf(v1.w, 0.f);
                    *(u32x4*)(a + (size_t)row * DFF + u.pn * 256 + bj * 128 + wc * 32 + 8 * fq) = pack8(v0 * v0, v1 * v1); } }
    }
};

__device__ __forceinline__ void row_partials(const acc_t& acc, float* part, const pg8::Unit& u, int wr, int wc, int fr, int fq) {
#pragma unroll
    for (int ai = 0; ai < 2; ++ai)
#pragma unroll
        for (int m = 0; m < 4; ++m) {
            float s = 0.f;
#pragma unroll
            for (int bj = 0; bj < 2; ++bj)
#pragma unroll
                for (int n = 0; n < 2; ++n) { const f32x4 v = acc[ai][bj][m][n]; s += (v.x * v.x + v.y * v.y) + (v.z * v.z + v.w * v.w); }
            s += __shfl_xor(s, 16); s += __shfl_xor(s, 32);
            if (fq == 0) part[(size_t)EPI_ROW(ai, m) * 32 + u.pn * 4 + wc] = s;
        }
}
__device__ __forceinline__ void row_rinv(const float* part, float (&rinv)[2][4], const pg8::Unit& u, int wr, int fr, int fq) {
#pragma unroll
    for (int ai = 0; ai < 2; ++ai)
#pragma unroll
        for (int m = 0; m < 4; ++m) {
            const f32x4* pp = (const f32x4*)(part + (size_t)EPI_ROW(ai, m) * 32 + fq * 8);
            const f32x4 a = pp[0], b = pp[1];
            float s = ((a.x + a.y) + (a.z + a.w)) + ((b.x + b.y) + (b.z + b.w));
            s += __shfl_xor(s, 16); s += __shfl_xor(s, 32);
            rinv[ai][m] = rsqrtf(s * (1.0f / DM) + 1e-6f);
        }
}
struct EpiOutNormF {
    static constexpr bool PERM = true, FUSED = true, CHAIN = false;
    const float* x; const float* g1; const float* g2; float* x1; bf16_t* h2; float* part1; float* part2; XcdBarrier xb;
    __device__ __forceinline__ void fused(acc_t& acc, const pg8::Unit& u, int wr, int wc, int fr, int fq) const {
        float rinv[2][4];
        row_partials(acc, part1, u, wr, wc, fr, fq);
        xcd_barrier(xb);
        row_rinv(part1, rinv, u, wr, fr, fq);
#pragma unroll
        for (int bj = 0; bj < 2; ++bj) { const int col = u.pn * 256 + bj * 128 + wc * 32 + 8 * fq;
            const f32x4 ga0 = *(const f32x4*)(g1 + col), ga1 = *(const f32x4*)(g1 + col + 4), gb0 = *(const f32x4*)(g2 + col), gb1 = *(const f32x4*)(g2 + col + 4);
#pragma unroll
            for (int ai = 0; ai < 2; ++ai)
#pragma unroll
              for (int mh = 0; mh < 2; ++mh) {
                f32x4 xv[2][2];
#pragma unroll
                for (int mm = 0; mm < 2; ++mm) { const unsigned o = (unsigned)(EPI_ROW(ai, 2 * mh + mm) * DM + col); xv[mm][0] = __builtin_nontemporal_load((const f32x4*)(x + o)); xv[mm][1] = __builtin_nontemporal_load((const f32x4*)(x + o + 4)); }
#pragma unroll
                for (int mm = 0; mm < 2; ++mm) { const int m = 2 * mh + mm; const unsigned o = (unsigned)(EPI_ROW(ai, m) * DM + col);
                    const f32x4 v0 = xv[mm][0] + acc[ai][bj][m][0] * rinv[ai][m] * ga0, v1 = xv[mm][1] + acc[ai][bj][m][1] * rinv[ai][m] * ga1;
                    acc[ai][bj][m][0] = v0; acc[ai][bj][m][1] = v1; *(f32x4*)(x1 + o) = v0; *(f32x4*)(x1 + o + 4) = v1; *(u32x4*)(h2 + o) = pack8(v0 * gb0, v1 * gb1); }
#pragma unroll
                for (int mm = 0; mm < 2; ++mm) asm volatile("" : "+v"(acc[ai][bj][2 * mh + mm][0]), "+v"(acc[ai][bj][2 * mh + mm][1]));
                asm volatile("" ::: "memory"); } }
        row_partials(acc, part2, u, wr, wc, fr, fq);
    }
};
struct EpiDownNormF {
    static constexpr bool PERM = true, FUSED = true, CHAIN = false;
    const float* g; float* x1; float* part; XcdBarrier xb;
    __device__ __forceinline__ void fused(acc_t& acc, const pg8::Unit& u, int wr, int wc, int fr, int fq) const {
        float rinv[2][4];
        row_partials(acc, part, u, wr, wc, fr, fq);
        xcd_barrier(xb);
        row_rinv(part, rinv, u, wr, fr, fq);
#pragma unroll
        for (int bj = 0; bj < 2; ++bj) { const int col = u.pn * 256 + bj * 128 + wc * 32 + 8 * fq;
            const f32x4 g0 = *(const f32x4*)(g + col), g1 = *(const f32x4*)(g + col + 4);
#pragma unroll
            for (int ai = 0; ai < 2; ++ai)
#pragma unroll
                for (int m = 0; m < 4; ++m) { float* o = x1 + (unsigned)(EPI_ROW(ai, m) * DM + col);
                    const f32x4 a0 = __builtin_nontemporal_load((const f32x4*)o), a1 = __builtin_nontemporal_load((const f32x4*)(o + 4));
                    __builtin_nontemporal_store(a0 + acc[ai][bj][m][0] * rinv[ai][m] * g0, (f32x4*)o); __builtin_nontemporal_store(a1 + acc[ai][bj][m][1] * rinv[ai][m] * g1, (f32x4*)(o + 4)); } }
    }
};

typedef float f32x16 __attribute__((ext_vector_type(16)));
typedef short s16x8 __attribute__((ext_vector_type(8)));
constexpr int ATT_KROW = 144, ATT_VROW = 336, ATT_VOFF = 160 * ATT_KROW;
__device__ __forceinline__ void attn_stage(LAS unsigned char* lds, const bf16_t* Kb, const bf16_t* VT, const int q0, const int hk, const int tid) {
    for (int c = tid; c < 1280; c += 512) {
        const int row = c >> 3, ch = c & 7, key = q0 - 128 + row;
        u32x4 v = {0u, 0u, 0u, 0u}; if (key >= 0) v = *(const u32x4*)(Kb + (size_t)key * 128 + hk * 64 + ch * 8);
        *(LAS u32x4*)(lds + row * ATT_KROW + ch * 16) = v;
        const int d = c / 20, cc = c % 20, k0 = q0 - 128 + cc * 8;
        u32x4 w = {0u, 0u, 0u, 0u}; if (k0 >= 0) w = *(const u32x4*)(VT + (size_t)(hk * 64 + d) * SEQ + k0);
        *(LAS u32x4*)(lds + ATT_VOFF + d * ATT_VROW + cc * 16) = w;
    }
}
__device__ __forceinline__ void attn_item(LAS unsigned char* lds, const bf16_t* Q, bf16_t* O, const float sink, const int q0, const int h, const int lane) {
    const int r = lane & 31, hf = lane >> 5;
    s16x8 qf[4];
#pragma unroll
    for (int kk = 0; kk < 4; ++kk) qf[kk] = *(const s16x8*)(Q + (size_t)(q0 + r) * 1024 + h * 64 + 16 * kk + 8 * hf);
    f32x16 st[5];
#pragma unroll
    for (int kt = 0; kt < 5; ++kt) {
        f32x16 a = {0.f, 0.f, 0.f, 0.f, 0.f, 0.f, 0.f, 0.f, 0.f, 0.f, 0.f, 0.f, 0.f, 0.f, 0.f, 0.f};
#pragma unroll
        for (int kk = 0; kk < 4; ++kk) {
            const s16x8 kf = *(const LAS s16x8*)(lds + (32 * kt + r) * ATT_KROW + (16 * kk + 8 * hf) * 2);
            a = __builtin_amdgcn_mfma_f32_32x32x16_bf16(kf, qf[kk], a, 0, 0, 0);
        }
        st[kt] = a;
    }
    float mx = sink;
#pragma unroll
    for (int kt = 0; kt < 5; ++kt)
#pragma unroll
        for (int e = 0; e < 16; ++e) {
            const int kofs = -128 + 32 * kt + (e & 3) + 8 * (e >> 2) + 4 * hf;
            const int diff = r - kofs;
            const bool ok = (diff >= 0) && (diff < 128) && (q0 + kofs >= 0);
            const float sv = ok ? st[kt][e] * 0.125f : -1e30f;
            st[kt][e] = sv; mx = fmaxf(mx, sv);
        }
    mx = fmaxf(mx, __shfl_xor(mx, 32));
    float sum = 0.f;
#pragma unroll
    for (int kt = 0; kt < 5; ++kt)
#pragma unroll
        for (int e = 0; e < 16; ++e) { const float pv = (st[kt][e] > -1e29f) ? __expf(st[kt][e] - mx) : 0.f; st[kt][e] = pv; sum += pv; }
    sum += __shfl_xor(sum, 32);
    sum += __expf(sink - mx);
    const float inv = 1.0f / sum;
    f32x16 o0 = {0.f, 0.f, 0.f, 0.f, 0.f, 0.f, 0.f, 0.f, 0.f, 0.f, 0.f, 0.f, 0.f, 0.f, 0.f, 0.f}, o1 = o0;
#pragma unroll
    for (int kt = 0; kt < 5; ++kt)
#pragma unroll
        for (int s = 0; s < 2; ++s) {
            u32x4 pw; pw.x = pk2(st[kt][8 * s + 0], st[kt][8 * s + 1]); pw.y = pk2(st[kt][8 * s + 2], st[kt][8 * s + 3]);
            pw.z = pk2(st[kt][8 * s + 4], st[kt][8 * s + 5]); pw.w = pk2(st[kt][8 * s + 6], st[kt][8 * s + 7]);
            const s16x8 pf = __builtin_bit_cast(s16x8, pw);
#pragma unroll
            for (int dt = 0; dt < 2; ++dt) {
                const LAS unsigned char* vp = lds + ATT_VOFF + (32 * dt + r) * ATT_VROW + (32 * kt + 16 * s + 4 * hf) * 2;
                const u32x2 a0 = *(const LAS u32x2*)vp, a1 = *(const LAS u32x2*)(vp + 16);
                u32x4 vw; vw.x = a0.x; vw.y = a0.y; vw.z = a1.x; vw.w = a1.y;
                const s16x8 vf = __builtin_bit_cast(s16x8, vw);
                if (dt == 0) o0 = __builtin_amdgcn_mfma_f32_32x32x16_bf16(vf, pf, o0, 0, 0, 0);
                else o1 = __builtin_amdgcn_mfma_f32_32x32x16_bf16(vf, pf, o1, 0, 0, 0);
            }
        }
    bf16_t* op = O + (size_t)(q0 + r) * 1024 + h * 64 + 4 * hf;
#pragma unroll
    for (int i = 0; i < 4; ++i) {
        u32x2 w; w.x = pk2(o0[4 * i] * inv, o0[4 * i + 1] * inv); w.y = pk2(o0[4 * i + 2] * inv, o0[4 * i + 3] * inv); *(u32x2*)(op + 8 * i) = w;
        u32x2 w1; w1.x = pk2(o1[4 * i] * inv, o1[4 * i + 1] * inv); w1.y = pk2(o1[4 * i + 2] * inv, o1[4 * i + 3] * inv); *(u32x2*)(op + 32 + 8 * i) = w1;
    }
}

constexpr int NPHASE = 8;

#ifndef PROBE_PH
#define PROBE_PH -1
#endif
template <int PH, int REP = 1>
__device__ __forceinline__ void run_phase(const P& p, LAS unsigned char* lds, const XcdBarrier& xb) {
    int tid_ = threadIdx.x; asm volatile("" : "+v"(tid_));
    const int tid = tid_, lane = tid & 63, wave = tid >> 6;
    int bid_ = blockIdx.x; asm volatile("" : "+s"(bid_));
    const int bid = bid_;
    const int G = gridDim.x, gw = bid * 8 + wave, NGW = G * 8;
    const size_t gt = (size_t)bid * 512 + tid, NGT = (size_t)G * 512;
    unsigned char* ws = p.ws; unsigned char* dout = (unsigned char*)p.out;
    asm volatile("" : "+s"(ws), "+s"(dout));
    float* PART1 = (float*)(ws + WS_PART1); float* PART2 = (float*)(ws + WS_PART2);
    float2* AP = (float2*)(ws + WS_AP); float2* BBAR = (float2*)(ws + WS_BBAR); float2* ROPE = (float2*)(ws + WS_ROPE);
    bf16_t* WUP = (bf16_t*)(ws + WS_WUP); bf16_t* WDN = (bf16_t*)(ws + WS_WDN); bf16_t* WIN = (bf16_t*)(ws + WS_WIN); bf16_t* WGLU = (bf16_t*)(ws + WS_WGLU);
    bf16_t* WBRA = (bf16_t*)(ws + WS_WBRA); bf16_t* WBRS = (bf16_t*)(ws + WS_WBRS); bf16_t* WOUT = (bf16_t*)(ws + WS_WOUT);
    bf16_t* H = (bf16_t*)(ws + WS_H); bf16_t* OATT = (bf16_t*)(ws + WS_OATT); bf16_t* Q = (bf16_t*)(ws + WS_Q); bf16_t* OSSM = (bf16_t*)(ws + WS_OSSM);
    bf16_t* Kb = (bf16_t*)(ws + WS_K); bf16_t* VT = (bf16_t*)(ws + WS_VT); bf16_t* AX = (bf16_t*)(ws + WS_AX); bf16_t* Y = (bf16_t*)(ws + WS_Y);
    bf16_t* Mb = (bf16_t*)(ws + WS_M); bf16_t* GA = (bf16_t*)(ws + WS_GA); bf16_t* GS = (bf16_t*)(ws + WS_GS); float* MIXED = (float*)(ws + WS_MIXED);
    bf16_t* H2 = (bf16_t*)(ws + WS_H2); bf16_t* Ab = (bf16_t*)(ws + WS_A); float* DN = (float*)(ws + WS_DN);
    float* S = (float*)(dout + DO_S); float* KTAB = (float*)(dout + DO_KTAB); bf16_t* BC = (bf16_t*)(dout + DO_BC); bf16_t* YB = (bf16_t*)(dout + DO_YB);
    float* T1 = (float*)dout; float* X1 = (float*)dout;
    const float* x = p.in[0];

    if constexpr (PH == 0) {
        LAS float* scr = (LAS float*)(lds + wave * 16384);
        for (int base = bid * 32; base < TI_IN; base += G * 32) transpose_quad(p, base + wave * 4, scr, lane);
        {
            const int r0 = (bid < 200) ? 25 * bid : 5000 + 57 * (bid - 200), r1 = (bid < 200) ? r0 + 25 : r0 + 57;
            if (r0 + wave < r1) {
            f32x4 v[8];
#pragma unroll
            for (int j = 0; j < 8; ++j) v[j] = __builtin_nontemporal_load((const f32x4*)(x + (size_t)(r0 + wave) * DM) + 64 * j + lane);
            for (int m = r0 + wave; m < r1; m += 8) {
                const bool more = m + 8 < r1; f32x4 nv[8];
                if (more) {
#pragma unroll
                    for (int j = 0; j < 8; ++j) nv[j] = __builtin_nontemporal_load((const f32x4*)(x + (size_t)(m + 8) * DM) + 64 * j + lane); }
                float ss = 0.f;
#pragma unroll
                for (int j = 0; j < 8; ++j) ss += v[j].x * v[j].x + v[j].y * v[j].y + v[j].z * v[j].z + v[j].w * v[j].w;
                const float rr = rsqrtf(wave_sum(ss) * (1.0f / DM) + 1e-6f);
#pragma unroll
                for (int j = 0; j < 8; ++j) { const f32x4 g = ((const f32x4*)p.in[1])[64 * j + lane]; const f32x4 o = v[j] * rr * g;
                    u32x2 w; w.x = pk2(o.x, o.y); w.y = pk2(o.z, o.w); ((u32x2*)(H + (size_t)m * DM))[64 * j + lane] = w; }
                if (more) {
#pragma unroll
                    for (int j = 0; j < 8; ++j) v[j] = nv[j]; }
            }
            }
        }
        for (size_t e = gt; e < (size_t)NG * SP * NAP; e += NGT) {
            const int i = (int)(e / NAP), n = (int)(e % NAP), g = i / SP;
            const double dt = exp((double)p.in[9][g]), lr = (double)p.in[7][i], li = (double)p.in[8][i];
            const double pw = (n == 17) ? 1024.0 : (double)n;
            const float mag = (float)exp(pw * lr * dt); float sn, cs; sincos_d(pw * li * dt, sn, cs);
            AP[((size_t)g * NAP + n) * SP + (i % SP)] = make_float2(mag * cs, mag * sn);
        }
        for (size_t e = gt; e < (size_t)NG * SP * GC; e += NGT) {
            const int i = (int)(e >> 4), g = i / SP;
            const double dt = exp((double)p.in[9][g]), lr = (double)p.in[7][i], li = (double)p.in[8][i];
            float s1, c1; sincos_d(li * dt, s1, c1);
            const double mag1 = exp(lr * dt), are = mag1 * (double)c1, aim = mag1 * (double)s1;
            const double nr = are - 1.0, ni = aim, den = lr * lr + li * li;
            const double cre = (nr * lr + ni * li) / den, cim = (ni * lr - nr * li) / den;
            const double br = (double)p.in[10][e], bi = (double)p.in[11][e];
            BBAR[e] = make_float2((float)(cre * br - cim * bi), (float)(cre * bi + cim * br));
        }
        for (size_t i = gt; i < (size_t)SEQ * 8; i += NGT) {
            const int pos = (int)(i >> 3), k = (int)(i & 7);
            const double inv = exp(-(double)k * 0.125 * 13.122363377404328);
            float s, c; sincos_d((double)pos * inv, s, c);
            ROPE[i] = make_float2(c, s);
        }
        }
    if constexpr (PH == 1) {
        { pg8::Gemm g{H, WIN, SEQ, INW, DM, DM, DM, 1, 0, 0}; pg8::Order S; S.init(SEQ, INW, 1, G, bid, 3);
          EpiZf E{Q, Kb, VT, AX, GA, GS, (const float*)ROPE}; pg8::gemm_phase(lds, g, S, E, tid); }
        for (size_t e = gt; e < (size_t)NG * 256 * 32; e += NGT) {
            const int g = (int)(e >> 13), r = (int)(e >> 5) & 255, k8 = (int)e & 31, s_ = k8 >> 1, ci0 = (k8 & 1) * 8;
            u32x4 w = {0u, 0u, 0u, 0u};
            if (r < 128) { const int pp = r & 63; const float2 a = AP[((size_t)g * NAP + 15 - s_) * SP + pp];
                const f32x4* bp = (const f32x4*)(BBAR + ((size_t)g * SP + pp) * GC + ci0); const f32x4 b0 = bp[0], b1 = bp[1], b2 = bp[2], b3 = bp[3];
                if (r >> 6) { w.x = pk2(a.x * b0.y + a.y * b0.x, a.x * b0.w + a.y * b0.z); w.y = pk2(a.x * b1.y + a.y * b1.x, a.x * b1.w + a.y * b1.z);
                              w.z = pk2(a.x * b2.y + a.y * b2.x, a.x * b2.w + a.y * b2.z); w.w = pk2(a.x * b3.y + a.y * b3.x, a.x * b3.w + a.y * b3.z); }
                else {        w.x = pk2(a.x * b0.x - a.y * b0.y, a.x * b0.z - a.y * b0.w); w.y = pk2(a.x * b1.x - a.y * b1.y, a.x * b1.z - a.y * b1.w);
                              w.z = pk2(a.x * b2.x - a.y * b2.y, a.x * b2.z - a.y * b2.w); w.w = pk2(a.x * b3.x - a.y * b3.y, a.x * b3.z - a.y * b3.w); } }
            *(u32x4*)(BC + e * 8) = w;
        }
        for (size_t e = gt; e < (size_t)NG * 256 * 16; e += NGT) {
            const int g = (int)(e >> 12), row = (int)(e >> 4) & 255, r0 = ((int)e & 15) * 8, t = row >> 4, co = row & 15, pp0 = r0 & 63;
            const f32x4* ap = (const f32x4*)(AP + ((size_t)g * NAP + t + 1) * SP + pp0); const f32x4 a0 = ap[0], a1 = ap[1], a2 = ap[2], a3 = ap[3];
            const f32x4* crp = (const f32x4*)(p.in[12] + ((size_t)g * GC + co) * SP + pp0); const f32x4* cip = (const f32x4*)(p.in[13] + ((size_t)g * GC + co) * SP + pp0);
            const f32x4 cr0 = crp[0], cr1 = crp[1], ci0 = cip[0], ci1 = cip[1];
            u32x4 w;
            if (r0 >> 6) { w.x = pk2(-(cr0.x * a0.y + ci0.x * a0.x), -(cr0.y * a0.w + ci0.y * a0.z)); w.y = pk2(-(cr0.z * a1.y + ci0.z * a1.x), -(cr0.w * a1.w + ci0.w * a1.z));
                           w.z = pk2(-(cr1.x * a2.y + ci1.x * a2.x), -(cr1.y * a2.w + ci1.y * a2.z)); w.w = pk2(-(cr1.z * a3.y + ci1.z * a3.x), -(cr1.w * a3.w + ci1.w * a3.z)); }
            else {         w.x = pk2(cr0.x * a0.x - ci0.x * a0.y, cr0.y * a0.z - ci0.y * a0.w); w.y = pk2(cr0.z * a1.x - ci0.z * a1.y, cr0.w * a1.z - ci0.w * a1.w);
                           w.z = pk2(cr1.x * a2.x - ci1.x * a2.y, cr1.y * a2.z - ci1.y * a2.w); w.w = pk2(cr1.z * a3.x - ci1.z * a3.y, cr1.w * a3.z - ci1.w * a3.w); }
            *(u32x4*)(YB + ((size_t)g * 256 + row) * 384 + 256 + r0) = w;
        }
        {
            LAS float* Cre = (LAS float*)lds; LAS float* Cim = Cre + 16 * 65; LAS float* APr = Cim + 16 * 65; LAS float* APi = APr + 256; LAS float* Bbr = APi + 256; LAS float* Bbi = Bbr + 1024;
            for (int item = bid; item < NG * 4; item += G) {
                const int g = item >> 2, tq = item & 3;
                __syncthreads();
                for (int i = tid; i < 1024; i += 512) { Cre[(i >> 6) * 65 + (i & 63)] = p.in[12][(size_t)g * 1024 + i]; Cim[(i >> 6) * 65 + (i & 63)] = p.in[13][(size_t)g * 1024 + i];
                    const float2 b = BBAR[(size_t)g * 1024 + i]; Bbr[i] = b.x; Bbi[i] = b.y; }
                if (tid < 256) { const float2 a = AP[((size_t)g * NAP + 4 * tq + (tid >> 6)) * SP + (tid & 63)]; APr[tid] = a.x; APi[tid] = a.y; }
                __syncthreads();
#pragma unroll
                for (int rr = 0; rr < 2; ++rr) {
                    const int idx = tid + 512 * rr, tl = idx >> 8, co = (idx >> 4) & 15, ci = idx & 15;
                    float acc = 0.f;
#pragma unroll 8
                    for (int pp = 0; pp < SP; ++pp) {
                        const float cr = Cre[co * 65 + pp], cim = Cim[co * 65 + pp], ax = APr[tl * 64 + pp], ay = APi[tl * 64 + pp];
                        const float wre = cr * ax - cim * ay, wim = cr * ay + cim * ax;
                        acc += wre * Bbr[pp * 16 + ci] - wim * Bbi[pp * 16 + ci];
                    }
                    const int tau = 4 * tq + tl;
                    if (tau == 0 && co == ci) acc += p.in[14][g * GC + co];
                    KTAB[(((size_t)g * 16 + tau) * 16 + co) * 16 + ci] = acc;
                }
            }
            __syncthreads();
        }
        }
    if constexpr (PH == 2) {
        if (bid < 2 * NG) {
            const int g = bid & 63, h = bid >> 6;
            unsigned* flagS = (unsigned*)(ws + WS_CTL + 14464) + g;
            unsigned* flagX = (unsigned*)(ws + WS_CTL + 14464 + 256) + g;
            if (h == 0) {
                for (int e = tid; e < 256 * 32; e += 512) {
                    const int row = e >> 5, k8 = e & 31, s_ = k8 >> 1, ci0 = (k8 & 1) * 8, t = row >> 4, co = row & 15;
                    u32x4 w = {0u, 0u, 0u, 0u};
                    if (t >= s_) { const f32x4* kp = (const f32x4*)(KTAB + (((size_t)g * 16 + (t - s_)) * 16 + co) * 16 + ci0); w = pack8(kp[0], kp[1]); }
                    *(u32x4*)(YB + ((size_t)g * 256 + row) * 384 + 8 * k8) = w;
                }
            }
            { pg8::Gemm gm{AX, BC, 512, 256, 256, 384, 256, NG, (size_t)512 * 384, (size_t)256 * 256}; pg8::Order S_; S_.init(512, 256, NG, 1, 0, 1, 2 * g + h);
              EpiSf E{S}; pg8::gemm_phase(lds, gm, S_, E, tid); }
            asm volatile("s_waitcnt vmcnt(0)" ::: "memory"); __syncthreads();
            if (h == 1) {
                if (tid == 0) { __builtin_amdgcn_fence(__ATOMIC_RELEASE, "agent"); asm volatile("s_waitcnt vmcnt(0)" ::: "memory"); __hip_atomic_store(flagS, 1u, __ATOMIC_RELAXED, __HIP_MEMORY_SCOPE_AGENT);
                    unsigned sp = 0; while (__hip_atomic_load(flagX, __ATOMIC_RELAXED, __HIP_MEMORY_SCOPE_AGENT) == 0u && ++sp < (1u << 24)) __builtin_amdgcn_s_sleep(2);
                    __builtin_amdgcn_fence(__ATOMIC_ACQUIRE, "agent"); asm volatile("s_waitcnt vmcnt(0)" ::: "memory"); }
                __syncthreads();
            } else {
                if (tid == 0) { unsigned sp = 0; while (__hip_atomic_load(flagS, __ATOMIC_RELAXED, __HIP_MEMORY_SCOPE_AGENT) == 0u && ++sp < (1u << 24)) __builtin_amdgcn_s_sleep(2);
                    __builtin_amdgcn_fence(__ATOMIC_ACQUIRE, "agent"); asm volatile("s_waitcnt vmcnt(0)" ::: "memory"); }
                __syncthreads();
        LAS float* Elr = (LAS float*)lds; LAS float* Eli = Elr + 512;
        {
            const int pp = tid & 63, seg = tid >> 6;
            const float2 A16 = AP[((size_t)g * NAP + 16) * SP + pp], A1k = AP[((size_t)g * NAP + 17) * SP + pp];
            const float* Sg = S + (size_t)g * 512 * 128;
            float lre = 0.f, lim = 0.f;
            for (int j0 = seg * 64; j0 < seg * 64 + 64; j0 += 16) {
                float sr[16], si[16];
#pragma unroll
                for (int q = 0; q < 16; ++q) { sr[q] = Sg[(j0 + q) * 128 + pp]; si[q] = Sg[(j0 + q) * 128 + 64 + pp]; }
#pragma unroll
                for (int q = 0; q < 16; ++q) { const float nr = A16.x * lre - A16.y * lim + sr[q], ni = A16.x * lim + A16.y * lre + si[q]; lre = nr; lim = ni; }
            }
            __syncthreads();
            Elr[seg * 64 + pp] = lre; Eli[seg * 64 + pp] = lim;
            __syncthreads();
            float cre = 0.f, cim = 0.f;
            for (int s2 = 0; s2 < seg; ++s2) { const float2 e = make_float2(Elr[s2 * 64 + pp], Eli[s2 * 64 + pp]);
                const float nr = A1k.x * cre - A1k.y * cim + e.x, ni = A1k.x * cim + A1k.y * cre + e.y; cre = nr; cim = ni; }
            for (int j0 = seg * 64; j0 < seg * 64 + 64; j0 += 16) {
                float sr[16], si[16];
#pragma unroll
                for (int q = 0; q < 16; ++q) { sr[q] = Sg[(j0 + q) * 128 + pp]; si[q] = Sg[(j0 + q) * 128 + 64 + pp]; }
#pragma unroll
                for (int q = 0; q < 16; ++q) {
                    bf16_t* axr = AX + ((size_t)g * 512 + j0 + q) * 384 + 256;
                    axr[pp] = (bf16_t)f2bf(cre); axr[64 + pp] = (bf16_t)f2bf(cim);
                    const float nr = A16.x * cre - A16.y * cim + sr[q], ni = A16.x * cim + A16.y * cre + si[q]; cre = nr; cim = ni; }
            }
            }
                asm volatile("s_waitcnt vmcnt(0)" ::: "memory"); __syncthreads();
                if (tid == 0) { __builtin_amdgcn_fence(__ATOMIC_RELEASE, "agent"); asm volatile("s_waitcnt vmcnt(0)" ::: "memory"); __hip_atomic_store(flagX, 1u, __ATOMIC_RELAXED, __HIP_MEMORY_SCOPE_AGENT); }
                __syncthreads();
            }
            { pg8::Gemm gm{AX, YB, 512, 256, 384, 384, 384, NG, (size_t)512 * 384, (size_t)256 * 384}; pg8::Order S_; S_.init(512, 256, NG, 1, 0, 1, 2 * g + h);
              EpiYf E{Y}; pg8::gemm_phase(lds, gm, S_, E, tid); }
        } else if (bid < 2 * NG + 32) {
            pg8::Gemm gm{H, WIN, SEQ, INW, DM, DM, DM, 1, 0, 0}; pg8::Order S_; S_.init(SEQ, INW, 1, 1 << 20, bid - 2 * NG, 1, 768);
            EpiZf E{Q, Kb, VT, AX, GA, GS, (const float*)ROPE}; pg8::gemm_phase(lds, gm, S_, E, tid);
        } else {
            for (int item = bid - (2 * NG + 32); item < 512; item += G - (2 * NG + 32)) {
                const int hk = item & 1, q0 = (item >> 1) * 32, h = hk * 8 + wave;
                __syncthreads();
                attn_stage(lds, Kb, VT, q0, hk, tid);
                __syncthreads();
                attn_item(lds, Q, OATT, p.in[6][h], q0, h, lane);
            }
        }
        {
            unsigned* ctr = (unsigned*)(ws + WS_CTL + 14336); volatile LAS int* slot = (volatile LAS int*)(lds + 131072 + 64);
            for (;;) {
                __syncthreads();
                if (tid == 0) slot[0] = TI_IN + (int)__hip_atomic_fetch_add(ctr, 32u, __ATOMIC_RELAXED, __HIP_MEMORY_SCOPE_AGENT);
                __syncthreads();
                const int base = slot[0];
                if (base >= TI_ALL) break;
                transpose_quad(p, base + wave * 4, (LAS float*)(lds + wave * 16384), lane);
            }
        }
    }
    if constexpr (PH == 3) { pg8::Gemm g{Y, WGLU, SEQ, 2048, 1024, 1024, 1024, 1, 0, 0}; pg8::Order S_; S_.init(SEQ, 2048, 1, G, bid);
        EpiGLUf E{OSSM}; pg8::gemm_phase(lds, g, S_, E, tid); }
    if constexpr (PH == 4) {
        pg8::Gemm g{OATT, WBRA, SEQ, 2048, 1024, 1024, 1024, 2, (size_t)(OSSM - OATT), (size_t)(WBRS - WBRA)}; pg8::Order S_; S_.init(SEQ, 2048, 2, G, bid);
        EpiBrF E{GA, GS, Mb}; pg8::gemm_phase(lds, g, S_, E, tid);
    }
    if constexpr (PH == 5) { pg8::Gemm g{Mb, WOUT, SEQ, 2048, 2048, 2048, 2048, 1, 0, 0}; pg8::Order S_; S_.init(SEQ, 2048, 1, G, bid);
        EpiOutNormF E{x, p.in[2], p.in[3], X1, H2, PART1, PART2, xb}; pg8::gemm_phase(lds, g, S_, E, tid); }
    if constexpr (PH == 6) { pg8::Gemm g{H2, WUP, SEQ, DFF, DM, DM, DM, 1, 0, 0}; pg8::Order S_; S_.init(SEQ, DFF, 1, G, bid);
        EpiUpf E{Ab, PART2}; pg8::gemm_phase(lds, g, S_, E, tid); }
    if constexpr (PH == 7) { pg8::Gemm g{Ab, WDN, SEQ, DM, DFF, DFF, DFF, 1, 0, 0}; pg8::Order S_; S_.init(SEQ, DM, 1, G, bid);
        EpiDownNormF E{p.in[4], X1, PART1, xb}; pg8::gemm_phase(lds, g, S_, E, tid); }
}

constexpr int LDS_BYTES = 147456;

#ifndef TPROBE
#define TPROBE -1
#endif
template <int PH>
__device__ __forceinline__ void run_all(const P& p, LAS unsigned char* lds, cg::grid_group& grid, const XcdBarrier& xb, volatile LAS unsigned* misc) {
    if constexpr (PH == PROBE_PH) { run_phase<PH, 0>(p, lds, xb); xcd_barrier(xb); }
    run_phase<PH>(p, lds, xb);
    if constexpr (PH + 1 < NPHASE) {
        if constexpr (PH == 0) { if (p.use_cg_sync) grid.sync(); else xcd_barrier(xb); } else xcd_barrier(xb);
        if constexpr (TPROBE >= 0) { if (blockIdx.x == 0 && threadIdx.x == 0) misc[4 + PH + 1] = (unsigned)__builtin_amdgcn_s_memrealtime(); }
        run_all<PH + 1>(p, lds, grid, xb, misc);
    }
}
__global__ void __launch_bounds__(512, 2) k_all(P p) {
    extern __shared__ __attribute__((aligned(16))) unsigned char lds_raw[];
    cg::grid_group grid = cg::this_grid();
    LAS unsigned char* lds = (LAS unsigned char*)lds_raw;
    volatile LAS unsigned* misc = (volatile LAS unsigned*)(lds + 131072);
    if (threadIdx.x < 2) misc[threadIdx.x] = 0u;
    __syncthreads();
    const XcdBarrier xb = xcd_barrier_post((unsigned*)(p.ws + WS_CTL), misc);
    if constexpr (TPROBE >= 0) { if (blockIdx.x == 0 && threadIdx.x == 0) misc[4] = (unsigned)__builtin_amdgcn_s_memrealtime(); }
    run_all<0>(p, lds, grid, xb, misc);
    if constexpr (TPROBE >= 0) {
        if (blockIdx.x == 0 && threadIdx.x == 0) {
            const unsigned now = (unsigned)__builtin_amdgcn_s_memrealtime(); misc[4 + NPHASE] = now;
            const unsigned d = misc[4 + TPROBE + 1] - misc[4 + TPROBE];
            while ((unsigned)__builtin_amdgcn_s_memrealtime() - now < 8u * d) __builtin_amdgcn_s_sleep(8);
        }
    }
}

extern "C" void kernel_launch(void* const* d_in, const int* in_sizes, int n_in, void* d_out, int out_size, void* d_ws, size_t ws_size, hipStream_t stream) {
    static int grid = 0;
    if (grid == 0) {
        if (n_in != 20 || out_size != SEQ * DM || ws_size < WS_END) { fprintf(stderr, "kernel_launch: unexpected shapes (n_in %d out %d ws %zu)\n", n_in, out_size, ws_size); grid = -1; return; }
        int dev = 0, cus = 0;
        (void)hipGetDevice(&dev); (void)hipDeviceGetAttribute(&cus, hipDeviceAttributeMultiprocessorCount, dev);
        (void)hipFuncSetAttribute((const void*)k_all, hipFuncAttributeMaxDynamicSharedMemorySize, LDS_BYTES);
        int per_cu = 0;
        (void)hipOccupancyMaxActiveBlocksPerMultiprocessor(&per_cu, (const void*)k_all, 512, LDS_BYTES);
        if (per_cu < 1) fprintf(stderr, "kernel_launch: occupancy query says %d blocks/CU\n", per_cu);
        (void)hipGetLastError();
        if (cus != 256) { fprintf(stderr, "kernel_launch: built for a 256-CU device (one 512-thread workgroup per CU, one 256x256 tile per workgroup in the fused-norm GEMM phases); found %d CUs\n", cus); grid = -1; return; }
        grid = cus;
    }
    if (grid < 0) return;
    P p{};
    for (int i = 0; i < 20; ++i) p.in[i] = (const float*)d_in[i];
    p.out = (float*)d_out; p.ws = (unsigned char*)d_ws;
    (void)hipMemsetAsync((char*)d_ws + WS_CTL, 0, CTL_BYTES, stream);
    void* args[] = {&p};
    hipError_t e = hipLaunchCooperativeKernel((const void*)k_all, dim3(grid), dim3(512), args, LDS_BYTES, stream);
    if (e != hipSuccess) fprintf(stderr, "cooperative launch failed: %s (grid %d)\n", hipGetErrorString(e), grid);
}
```

```cpp
#include <hip/hip_runtime.h>
#include <hip/hip_cooperative_groups.h>
#include <cstdio>
#include <cstdint>
namespace cg = cooperative_groups;


typedef unsigned short bf16_t;
typedef float f32x4 __attribute__((ext_vector_type(4)));
typedef unsigned u32x2 __attribute__((ext_vector_type(2)));
typedef unsigned u32x4 __attribute__((ext_vector_type(4)));
#define LAS __attribute__((address_space(3)))

constexpr int SEQ = 8192, DM = 2048, INW = 6400, QW = 1024, SSMW = 1024, DFF = 8192;
constexpr int NG = 64, GC = 16, SP = 64, NH = 16;
constexpr size_t MiB = 1u << 20;
constexpr size_t WS_AP = 0, WS_BBAR = 1 * MiB, WS_ROPE = 1 * MiB + 512 * 1024, WS_CTL = 2 * MiB, CTL_BYTES = 16384, WS_PART1 = 3 * MiB, WS_PART2 = 0;
constexpr size_t WS_WUP = 4 * MiB, WS_WDN = 36 * MiB, WS_WIN = 68 * MiB, WS_WGLU = 93 * MiB, WS_WBRA = 97 * MiB, WS_WBRS = 101 * MiB, WS_WOUT = 105 * MiB;
constexpr size_t WS_H = 113 * MiB, WS_OSSM = 113 * MiB  , WS_Q = 145 * MiB, WS_OATT = 145 * MiB  , WS_K = 161 * MiB, WS_VT = 163 * MiB, WS_AX = 165 * MiB, WS_Y = 189 * MiB;
constexpr size_t WS_M = 161 * MiB, WS_GA = 205 * MiB, WS_GS = 237 * MiB, WS_MIXED = 205 * MiB, WS_H2 = 68 * MiB, WS_A = 141 * MiB, WS_DN = 68 * MiB, WS_END = 269 * MiB;
constexpr size_t DO_S = 0, DO_KTAB = 16 * MiB, DO_BC = 17 * MiB, DO_YB = 25 * MiB;
constexpr int NAP = 18;

struct P {
    const float* in[20];
    float* out;
    unsigned char* ws;
    unsigned long long use_cg_sync;
};

__device__ __forceinline__ float bf2f(unsigned v) { return __uint_as_float(v << 16); }
__device__ __forceinline__ unsigned f2bf(float f) { unsigned u = __float_as_uint(f); return (u + 0x7fffu + ((u >> 16) & 1u)) >> 16; }
__device__ __forceinline__ unsigned pk2(float lo, float hi) { return f2bf(lo) | (f2bf(hi) << 16); }
__device__ __forceinline__ float wave_sum(float v) {
#pragma unroll
    for (int o = 1; o < 64; o <<= 1) v += __shfl_xor(v, o);
    return v;
}
__device__ __forceinline__ float wave_max(float v) {
#pragma unroll
    for (int o = 1; o < 64; o <<= 1) v = fmaxf(v, __shfl_xor(v, o));
    return v;
}
__device__ __forceinline__ float sigmoidf_(float v) { return __builtin_amdgcn_rcpf(1.0f + __expf(-v)); }
__device__ __forceinline__ float gelu_tanh(float v) {
    const float z2 = 1.5957691216057308f * (v + 0.044715f * v * v * v);
    return v * __builtin_amdgcn_rcpf(1.0f + __expf(-z2));
}
__device__ __forceinline__ void sincos_d(double ang, float& s, float& c) {
    double rev = ang * 0.15915494309189535; rev -= rint(rev);
    const double q4 = rev * 4.0, qr = rint(q4); const int q = ((int)qr) & 3;
    const double th = (q4 - qr) * 1.5707963267948966, t2 = th * th;
    const double sn = th * (1.0 + t2 * (-1.0 / 6 + t2 * (1.0 / 120 + t2 * (-1.0 / 5040 + t2 * (1.0 / 362880 + t2 * (-1.0 / 39916800 + t2 * (1.0 / 6227020800.0)))))));
    const double cs = 1.0 + t2 * (-0.5 + t2 * (1.0 / 24 + t2 * (-1.0 / 720 + t2 * (1.0 / 40320 + t2 * (-1.0 / 3628800 + t2 * (1.0 / 479001600.0 + t2 * (-1.0 / 87178291200.0)))))));
    const double so = (q == 0) ? sn : (q == 1) ? cs : (q == 2) ? -sn : -cs;
    const double co = (q == 0) ? cs : (q == 1) ? -sn : (q == 2) ? -cs : sn;
    s = (float)so; c = (float)co;
}

struct TItem { const float* W; bf16_t* WT; int N, ldk, k0, n0, drow0; };
constexpr int TI_IN = 32 * 200, TI_GLU = 16 * 64, TI_BR = 16 * 64, TI_OUT = 32 * 64, TI_UP = 32 * 256, TI_DN = 128 * 64;
constexpr int TI_P0 = TI_IN + TI_GLU + 2 * TI_BR + TI_OUT, TI_ALL = TI_P0 + TI_UP + TI_DN;
__device__ __forceinline__ void tdecode(int r, int ncols, int& kb, int& nb) { const int st = r >> 5, c = r & 31, sn = ncols >> 8; kb = 4 * (st / sn) + (c & 3); nb = 8 * (st % sn) + (c >> 2); }
__device__ __forceinline__ TItem titem(const P& p, int r) {
    unsigned char* ws = p.ws; TItem t; int kb, nb;
    if (r < TI_IN) { tdecode(r, INW, kb, nb); t = TItem{p.in[5], (bf16_t*)(ws + WS_WIN), INW, 2048, 64 * kb, 32 * nb, 32 * nb}; return t; } r -= TI_IN;
    if (r < TI_GLU) { tdecode(r, 2048, kb, nb); const int n0 = 32 * nb, bj = n0 >> 10, j = n0 & 1023, tt = j >> 7, jj = j & 127;
        t = TItem{p.in[15], (bf16_t*)(ws + WS_WGLU), 2048, 1024, 64 * kb, n0, 256 * tt + 128 * bj + jj}; return t; } r -= TI_GLU;
    if (r < TI_BR) { tdecode(r, 2048, kb, nb); t = TItem{p.in[16], (bf16_t*)(ws + WS_WBRA), 2048, 1024, 64 * kb, 32 * nb, 32 * nb}; return t; } r -= TI_BR;
    if (r < TI_BR) { tdecode(r, 2048, kb, nb); t = TItem{p.in[16] + (size_t)1024 * 2048, (bf16_t*)(ws + WS_WBRS), 2048, 1024, 64 * kb, 32 * nb, 32 * nb}; return t; } r -= TI_BR;
    if (r < TI_OUT) { tdecode(r, 2048, kb, nb); t = TItem{p.in[17], (bf16_t*)(ws + WS_WOUT), 2048, 2048, 64 * kb, 32 * nb, 32 * nb}; return t; } r -= TI_OUT;
    if (r < TI_UP) { tdecode(r, DFF, kb, nb); t = TItem{p.in[18], (bf16_t*)(ws + WS_WUP), DFF, 2048, 64 * kb, 32 * nb, 32 * nb}; return t; } r -= TI_UP;
    { tdecode(r, 2048, kb, nb); t = TItem{p.in[19], (bf16_t*)(ws + WS_WDN), 2048, DFF, 64 * kb, 32 * nb, 32 * nb}; return t; }
}
__device__ __forceinline__ void titem_load(const TItem& t, f32x4 (&v)[8], int lane) {
#pragma unroll
    for (int i = 0; i < 8; ++i) v[i] = __builtin_nontemporal_load((const f32x4*)(t.W + (size_t)(t.k0 + 8 * i + (lane >> 3)) * t.N + t.n0 + (lane & 7) * 4));
}
__device__ __forceinline__ void transpose_quad(const P& p, int i0, LAS float* scr, int lane) {
    TItem t[4]; f32x4 v[4][8];
#pragma unroll
    for (int q = 0; q < 4; ++q) { t[q] = titem(p, i0 + q); titem_load(t[q], v[q], lane); }
#pragma unroll
    for (int q = 0; q < 4; ++q) {
#pragma unroll
        for (int i = 0; i < 8; ++i) { LAS float* d = scr + (8 * i + (lane >> 3)) * 33 + (lane & 7) * 4; d[0] = v[q][i].x; d[1] = v[q][i].y; d[2] = v[q][i].z; d[3] = v[q][i].w; }
        asm volatile("s_waitcnt lgkmcnt(0)" ::: "memory");
        const int c = lane & 7;
#pragma unroll
        for (int j = 0; j < 4; ++j) { const int n = (lane >> 3) + 8 * j; const LAS float* sp = scr + (8 * c) * 33 + n;
            u32x4 o; o.x = pk2(sp[0 * 33], sp[1 * 33]); o.y = pk2(sp[2 * 33], sp[3 * 33]); o.z = pk2(sp[4 * 33], sp[5 * 33]); o.w = pk2(sp[6 * 33], sp[7 * 33]);
            *(u32x4*)(t[q].WT + (size_t)(t[q].drow0 + n) * t[q].ldk + t[q].k0 + 8 * c) = o; }
        asm volatile("s_waitcnt lgkmcnt(0)" ::: "memory");
    }
}
namespace pg8 {
typedef short bf16x8 __attribute__((ext_vector_type(8)));
constexpr int BM = 256, BK = 64, HALF = 128, HTB = HALF * BK * 2, STAGE_BYTES = 8 * HTB, NXCD = 8, WGM = 8;
__device__ __forceinline__ int lds_byte(int r, int c) { const int st = (r >> 4) * 2 + (c >> 5), rr = r & 15, cc = c & 31, ob = rr * 64 + cc * 2; return st * 1024 + (ob ^ (((ob >> 9) & 1) << 5)); }
__device__ __forceinline__ void stage_rc(int b, int& R, int& C) { const int st = b / 1024, sb = b % 1024, swz = sb ^ (((sb >> 9) & 1) << 5); R = (st >> 1) * 16 + swz / 64; C = (st & 1) * 32 + (swz % 64) / 2; }
__device__ __forceinline__ int perm32(int rho) { const int n = rho >> 4, i = rho & 15; return 8 * (i >> 2) + 4 * n + (i & 3); }

struct Unit { int pm, pn, b; };
struct Gemm { const bf16_t* A; const bf16_t* Bt; int M, N, K, lda, ldb, nb; size_t sA, sB; };

struct Order {
    int nM, nN, nwg, nb, G, c, maxi, base;
    __device__ void init(int M, int N, int nb_, int G_, int c_, int maxi_ = (1 << 30), int base_ = 0) { nM = M / BM; nN = N / BM; nwg = nM * nN; nb = nb_; G = G_; c = c_; maxi = maxi_; base = base_; }
    __device__ bool next(int i, Unit& u) const {
        if (i >= maxi) return false;
        const long L = (long)base + (long)i * G + c; if (L >= (long)nwg * nb) return false;
        u.b = (int)(L / nwg); int wgid = (int)(L % nwg);
        { const int q = nwg / NXCD, r = nwg % NXCD, xcd = wgid % NXCD, off = wgid / NXCD; wgid = (xcd < r ? xcd * (q + 1) : r * (q + 1) + (xcd - r) * q) + off; }
        const int nig = WGM * nN, gid = wgid / nig, fm = gid * WGM, gsz = (nM - fm) < WGM ? (nM - fm) : WGM;
        u.pm = fm + ((wgid % nig) % gsz); u.pn = (wgid % nig) / gsz; return true;
    }
};

template <class Epi>
__device__ __forceinline__ void gemm_phase(LAS unsigned char* lds, const Gemm g, const Order& S, const Epi& E, const int tid) {
    const int wid = __builtin_amdgcn_readfirstlane(tid >> 6), lane = tid & 63, wr = wid >> 2, wc = wid & 3, fr = lane & 15, fq = lane >> 4;
    int K_ = g.K; asm volatile("" : "+s"(K_));
    const int nt = K_ / BK;
    unsigned voffA[2], voffB[2];
#pragma unroll
    for (int i = 0; i < 2; ++i) { int R, C; stage_rc(tid * 16 + i * 8192, R, C); const int Rb = Epi::PERM ? ((R & ~31) + perm32(R & 31)) : R;
        voffA[i] = (unsigned)(R * g.lda + C) * 2u; voffB[i] = (unsigned)(Rb * g.ldb + C) * 2u; }
    const size_t kstep = (size_t)(BK * 2);
    const size_t hstepA = (size_t)HALF * g.lda * 2, tstepA = 2 * hstepA, hstepB = (size_t)HALF * g.ldb * 2, tstepB = 2 * hstepB;
    const unsigned ldsw = (unsigned)wid * 1024u;
    const int aoff = lds_byte(wr * 64 + fr, fq * 8), boff = lds_byte(wc * 32 + fr, fq * 8);
#define PG8_SA(b, h) (((b) * 2 + (h)) * HTB)
#define PG8_SB(b, h) ((4 + (b) * 2 + (h)) * HTB)
#define PG8_STAGE(bufoff, gbase, voff) do { _Pragma("unroll") for (int _i = 0; _i < 2; ++_i) \
        __builtin_amdgcn_global_load_lds((const unsigned*)((const char*)(gbase) + (voff)[_i]), (LAS unsigned*)(lds + (bufoff) + ldsw + _i * 8192), 16, 0, 0); } while (0)
#define PG8_LDA(dst, b, h) do { _Pragma("unroll") for (int m = 0; m < 4; ++m) _Pragma("unroll") for (int k = 0; k < 2; ++k) dst[m][k] = *(const LAS bf16x8*)(lds + PG8_SA(b, h) + aoff + m * 2048 + k * 1024); } while (0)
#define PG8_LDB(dst, b, h) do { _Pragma("unroll") for (int n = 0; n < 2; ++n) _Pragma("unroll") for (int k = 0; k < 2; ++k) dst[n][k] = *(const LAS bf16x8*)(lds + PG8_SB(b, h) + boff + n * 2048 + k * 1024); } while (0)
#define PG8_MMA(ai, bj, At, Bt) do { __builtin_amdgcn_s_setprio(1); _Pragma("unroll") for (int m = 0; m < 4; ++m) _Pragma("unroll") for (int n = 0; n < 2; ++n) _Pragma("unroll") for (int k = 0; k < 2; ++k) \
        acc[ai][bj][m][n] = __builtin_amdgcn_mfma_f32_16x16x32_bf16(Bt[n][k], At[m][k], acc[ai][bj][m][n], 0, 0, 0); __builtin_amdgcn_s_setprio(0); } while (0)
#define PG8_WAIT_V(n) asm volatile("s_waitcnt vmcnt(" #n ")" ::: "memory")
#define PG8_WAIT_L(n) asm volatile("s_waitcnt lgkmcnt(" #n ")" ::: "memory")
#define PG8_BAR __builtin_amdgcn_s_barrier()
#define PG8_SCHED __builtin_amdgcn_sched_barrier(0)
    Unit cur, nxt; int ui = 0;
    if (!S.next(0, cur)) return;
    f32x4 acc[2][2][4][2];
#pragma unroll
    for (int a = 0; a < 2; ++a)
#pragma unroll
        for (int b = 0; b < 2; ++b)
#pragma unroll
            for (int m = 0; m < 4; ++m)
#pragma unroll
                for (int n = 0; n < 2; ++n) acc[a][b][m][n] = (f32x4){0.f, 0.f, 0.f, 0.f};
    bf16x8 At[4][2], B0[2][2], B1[2][2];
    const char* cA = (const char*)g.A + (size_t)cur.b * g.sA * 2 + (size_t)cur.pm * tstepA; const char* cB = (const char*)g.Bt + (size_t)cur.b * g.sB * 2 + (size_t)cur.pn * tstepB;
    PG8_STAGE(PG8_SB(0, 0), cB, voffB); PG8_STAGE(PG8_SB(0, 1), cB + hstepB, voffB); PG8_STAGE(PG8_SA(0, 0), cA, voffA); PG8_STAGE(PG8_SA(0, 1), cA + hstepA, voffA);
    if (wr == 1) PG8_BAR;
    PG8_WAIT_V(2); PG8_BAR;
    PG8_STAGE(PG8_SB(1, 0), cB + kstep, voffB); PG8_STAGE(PG8_SA(1, 0), cA + kstep, voffA); PG8_STAGE(PG8_SB(1, 1), cB + hstepB + kstep, voffB);
    PG8_WAIT_V(6); PG8_BAR;
    for (;;) {
        const bool has_next = S.next(ui + 1, nxt);
        const char* nA = has_next ? (const char*)g.A + (size_t)nxt.b * g.sA * 2 + (size_t)nxt.pm * tstepA : cA;
        const char* nB = has_next ? (const char*)g.Bt + (size_t)nxt.b * g.sB * 2 + (size_t)nxt.pn * tstepB : cB;
        for (int t = 0; t < nt; t += 2) {
            const bool last = (t == nt - 2);
            const char* a1 = cA + (size_t)(t + 1) * kstep;
            const char* a2 = last ? nA : cA + (size_t)(t + 2) * kstep; const char* b2 = last ? nB : cB + (size_t)(t + 2) * kstep;
            const char* a3 = a2 + kstep; const char* b3 = b2 + kstep;
            PG8_LDB(B0, 0, 0); PG8_LDB(B1, 0, 1); PG8_SCHED; PG8_LDA(At, 0, 0); PG8_STAGE(PG8_SA(1, 1), a1 + hstepA, voffA);
            PG8_WAIT_V(8); PG8_WAIT_L(0); PG8_BAR; PG8_MMA(0, 0, At, B0); PG8_MMA(0, 1, At, B1); PG8_BAR; PG8_SCHED;
            PG8_LDA(At, 0, 1); PG8_STAGE(PG8_SB(0, 0), b2, voffB); PG8_STAGE(PG8_SB(0, 1), b2 + hstepB, voffB); PG8_STAGE(PG8_SA(0, 0), a2, voffA);
            PG8_WAIT_V(8); PG8_WAIT_L(0); PG8_BAR; PG8_MMA(1, 0, At, B0); PG8_MMA(1, 1, At, B1); PG8_BAR; PG8_SCHED;
            PG8_LDB(B0, 1, 0); PG8_LDB(B1, 1, 1); PG8_SCHED; PG8_LDA(At, 1, 0); PG8_STAGE(PG8_SA(0, 1), a2 + hstepA, voffA);
            PG8_WAIT_V(8); PG8_WAIT_L(0); PG8_BAR; PG8_MMA(0, 0, At, B0); PG8_MMA(0, 1, At, B1); PG8_BAR; PG8_SCHED;
            PG8_LDA(At, 1, 1); PG8_STAGE(PG8_SB(1, 0), b3, voffB); PG8_STAGE(PG8_SB(1, 1), b3 + hstepB, voffB); PG8_STAGE(PG8_SA(1, 0), a3, voffA);
            PG8_WAIT_V(8); PG8_WAIT_L(0); PG8_BAR; PG8_MMA(1, 0, At, B0); PG8_MMA(1, 1, At, B1); PG8_BAR; PG8_SCHED;
        }
        if (wr == 0) PG8_BAR;
        if constexpr (Epi::FUSED) E.fused(acc, cur, wr, wc, fr, fq); else E(acc, cur, wr, wc, fr, fq);
        if (!has_next) break;
        if (!(Epi::CHAIN && cur.b == 0)) {
#pragma unroll
        for (int a = 0; a < 2; ++a)
#pragma unroll
            for (int b = 0; b < 2; ++b)
#pragma unroll
                for (int m = 0; m < 4; ++m)
#pragma unroll
                    for (int n = 0; n < 2; ++n) acc[a][b][m][n] = (f32x4){0.f, 0.f, 0.f, 0.f};
        }
        cur = nxt; cA = nA; cB = nB; ++ui;
        if (wr == 1) PG8_BAR;
    }
    PG8_WAIT_V(0);
    PG8_BAR;
#undef PG8_SA
#undef PG8_SB
#undef PG8_STAGE
#undef PG8_LDA
#undef PG8_LDB
#undef PG8_MMA
#undef PG8_WAIT_V
#undef PG8_WAIT_L
#undef PG8_BAR
#undef PG8_SCHED
}
}

#define XB_TMO      128
#define XB_XCNT(j)  (256  + 64 * (j))
#define XB_XSUB(j)  (1280 + 64 * (j))
#define XB_XGEN(j)  (2304 + 64 * (j))
#define XB_TOP      3328
#define XB_TOPGEN   3392
#define XCD_BAR_WORDS 3456
#define XB_SPIN_CAP (1u << 22)
__device__ __forceinline__ unsigned xb_ld(unsigned* p)              { return __hip_atomic_load(p, __ATOMIC_RELAXED, __HIP_MEMORY_SCOPE_AGENT); }
__device__ __forceinline__ unsigned xb_add(unsigned* p, unsigned v) { return __hip_atomic_fetch_add(p, v, __ATOMIC_RELAXED, __HIP_MEMORY_SCOPE_AGENT); }
__device__ __forceinline__ unsigned xb_xcc_id() { return (unsigned)__builtin_amdgcn_s_getreg((3 << 11) | 20) & 0xFu; }
#define XB_SPIN(cond, bar) do { unsigned _sp = 0; while (cond) { __builtin_amdgcn_s_sleep(1); \
    if ((++_sp & 255u) == 0u) { if (xb_ld(&(bar)[XB_TMO])) break; if (_sp > XB_SPIN_CAP) { atomicAdd(&(bar)[XB_TMO], 1u); break; } } } } while (0)
struct XcdBarrier { unsigned* bar; unsigned x; volatile LAS unsigned* st; };
__device__ __forceinline__ XcdBarrier xcd_barrier_post(unsigned* bar, volatile LAS unsigned* st) {
    XcdBarrier b; b.bar = bar; b.x = xb_xcc_id(); b.st = st;
    if (threadIdx.x == 0) (void)xb_add(&bar[XB_XCNT(b.x)], 1u);
    return b;
}
__device__ __forceinline__ void xcd_barrier_complete(unsigned* bar, unsigned x, unsigned& nloc, unsigned& nx) {
    const unsigned G = gridDim.x * gridDim.y * gridDim.z;
    unsigned sum, cnt, mine, sp = 0u;
    for (;;) {
        sum = 0u; cnt = 0u; mine = 0u;
#pragma unroll
        for (unsigned j = 0; j < 16; ++j) { const unsigned c = xb_ld(&bar[XB_XCNT(j)]); sum += c; cnt += (c > 0u) ? 1u : 0u; mine = (j == x) ? c : mine; }
        if (sum == G) break;
        __builtin_amdgcn_s_sleep(1);
        if ((++sp & 255u) == 0u) { if (xb_ld(&bar[XB_TMO])) break; if (sp > XB_SPIN_CAP) { atomicAdd(&bar[XB_TMO], 1u); break; } }
    }
    nloc = mine > 0u ? mine : 1u; nx = cnt > 0u ? cnt : 1u;
}
__device__ __forceinline__ void xcd_barrier(const XcdBarrier& b) {
    asm volatile("s_waitcnt vmcnt(0)" ::: "memory");
    __syncthreads();
    if (threadIdx.x == 0) {
        unsigned* bar = b.bar;
        __builtin_amdgcn_s_waitcnt(0);
        unsigned nloc = b.st[0], nx = b.st[1];
        if (nloc == 0u) { xcd_barrier_complete(bar, b.x, nloc, nx); b.st[0] = nloc; b.st[1] = nx; }
        const unsigned old = xb_add(&bar[XB_XSUB(b.x)], 1u);
        const unsigned gen = old / nloc;
        if (old + 1u == (gen + 1u) * nloc) {
            __builtin_amdgcn_fence(__ATOMIC_RELEASE, "agent");
            asm volatile("s_waitcnt vmcnt(0)" ::: "memory");
            const unsigned og = xb_add(&bar[XB_TOP], 1u);
            const unsigned tg = og / nx;
            if (og + 1u == (tg + 1u) * nx) xb_add(&bar[XB_TOPGEN], 1u);
            else XB_SPIN(xb_ld(&bar[XB_TOPGEN]) == tg, bar);
            __builtin_amdgcn_fence(__ATOMIC_ACQUIRE, "agent");
            xb_add(&bar[XB_XGEN(b.x)], 1u);
            asm volatile("s_waitcnt vmcnt(0)" ::: "memory");
        } else {
            XB_SPIN(xb_ld(&bar[XB_XGEN(b.x)]) == gen, bar);
            __builtin_amdgcn_fence(__ATOMIC_ACQUIRE, "agent");
            asm volatile("s_waitcnt vmcnt(0)" ::: "memory");
        }
    }
    __syncthreads();
}

typedef f32x4 acc_t[2][2][4][2];
#define EPI_ROW(ai, m) (u.pm * 256 + (ai) * 128 + wr * 64 + (m) * 16 + fr)
__device__ __forceinline__ u32x4 pack8(const f32x4 a, const f32x4 b) { u32x4 w; w.x = pk2(a.x, a.y); w.y = pk2(a.z, a.w); w.z = pk2(b.x, b.y); w.w = pk2(b.z, b.w); return w; }
__device__ __forceinline__ f32x4 sig4(const f32x4 v) { f32x4 o; o.x = sigmoidf_(v.x); o.y = sigmoidf_(v.y); o.z = sigmoidf_(v.z); o.w = sigmoidf_(v.w); return o; }

struct EpiZf {
    static constexpr bool PERM = true, FUSED = false, CHAIN = false;
    bf16_t *q, *k, *vT, *ax, *ga, *gs; const float* rope;
    __device__ __forceinline__ void operator()(const acc_t& acc, const pg8::Unit& u, int wr, int wc, int fr, int fq) const {
        const int pn = u.pn;
#pragma unroll
        for (int ai = 0; ai < 2; ++ai)
#pragma unroll
            for (int m = 0; m < 4; ++m) {
                const int row = EPI_ROW(ai, m);
#pragma unroll
                for (int bj = 0; bj < 2; ++bj) {
                    f32x4 v0 = acc[ai][bj][m][0], v1 = acc[ai][bj][m][1];
                    const int cl = bj * 128 + wc * 32 + 8 * fq;
                    if (pn < 4 || (pn == 4 && bj == 0)) {
                        if ((wc & 1) == 0) {
                            f32x4 p0, p1;
                            p0.x = __shfl_xor(v0.x, 16); p0.y = __shfl_xor(v0.y, 16); p0.z = __shfl_xor(v0.z, 16); p0.w = __shfl_xor(v0.w, 16);
                            p1.x = __shfl_xor(v1.x, 16); p1.y = __shfl_xor(v1.y, 16); p1.z = __shfl_xor(v1.z, 16); p1.w = __shfl_xor(v1.w, 16);
                            if (fq < 2) {
                                const f32x4* rp = (const f32x4*)(rope + (size_t)row * 16);
                                const f32x4 r0 = rp[0], r1 = rp[1], r2 = rp[2], r3 = rp[3];
                                const float sg = (fq == 0) ? -1.f : 1.f;
                                v0.x = v0.x * r0.x + sg * p0.x * r0.y; v0.y = v0.y * r0.z + sg * p0.y * r0.w;
                                v0.z = v0.z * r1.x + sg * p0.z * r1.y; v0.w = v0.w * r1.z + sg * p0.w * r1.w;
                                v1.x = v1.x * r2.x + sg * p1.x * r2.y; v1.y = v1.y * r2.z + sg * p1.y * r2.w;
                                v1.z = v1.z * r3.x + sg * p1.z * r3.y; v1.w = v1.w * r3.z + sg * p1.w * r3.w;
                            }
                        }
                        bf16_t* dst = (pn < 4) ? (q + (size_t)row * 1024 + pn * 256 + cl) : (k + (size_t)row * 128 + cl);
                        *(u32x4*)dst = pack8(v0, v1);
                    } else if (pn == 4) {
                        bf16_t* dst = vT + (size_t)(cl - 128) * SEQ + row;
                        dst[0 * (size_t)SEQ] = (bf16_t)f2bf(v0.x); dst[1 * (size_t)SEQ] = (bf16_t)f2bf(v0.y); dst[2 * (size_t)SEQ] = (bf16_t)f2bf(v0.z); dst[3 * (size_t)SEQ] = (bf16_t)f2bf(v0.w);
                        dst[4 * (size_t)SEQ] = (bf16_t)f2bf(v1.x); dst[5 * (size_t)SEQ] = (bf16_t)f2bf(v1.y); dst[6 * (size_t)SEQ] = (bf16_t)f2bf(v1.z); dst[7 * (size_t)SEQ] = (bf16_t)f2bf(v1.w);
                    } else if (pn < 9) {
                        const int c = (pn - 5) * 256 + cl, g = c >> 4, ci0 = c & 15;
                        *(u32x4*)(ax + ((size_t)g * 512 + (row >> 4)) * 384 + (row & 15) * 16 + ci0) = pack8(v0, v1);
                    } else if (pn < 17) {
                        *(u32x4*)(ga + (size_t)row * 2048 + (pn - 9) * 256 + cl) = pack8(sig4(v0), sig4(v1));
                    } else {
                        *(u32x4*)(gs + (size_t)row * 2048 + (pn - 17) * 256 + cl) = pack8(sig4(v0), sig4(v1));
                    }
                }
            }
    }
};
struct EpiSf {
    static constexpr bool PERM = false, FUSED = false, CHAIN = false; float* S;
    __device__ __forceinline__ void operator()(const acc_t& acc, const pg8::Unit& u, int wr, int wc, int fr, int fq) const {
#pragma unroll
        for (int ai = 0; ai < 2; ++ai)
#pragma unroll
            for (int m = 0; m < 4; ++m) { const int row = EPI_ROW(ai, m);
#pragma unroll
                for (int n = 0; n < 2; ++n) *(f32x4*)(S + ((size_t)u.b * 512 + row) * 128 + wc * 32 + 16 * n + 4 * fq) = acc[ai][0][m][n]; }
    }
};
struct EpiYf {
    static constexpr bool PERM = true, FUSED = false, CHAIN = false; bf16_t* y;
    __device__ __forceinline__ void operator()(const acc_t& acc, const pg8::Unit& u, int wr, int wc, int fr, int fq) const {
#pragma unroll
        for (int ai = 0; ai < 2; ++ai)
#pragma unroll
            for (int m = 0; m < 4; ++m) { const int row = EPI_ROW(ai, m);
#pragma unroll
                for (int bj = 0; bj < 2; ++bj) { const int c = bj * 128 + wc * 32 + 8 * fq, t = c >> 4, co0 = c & 15;
                    const f32x4 a0 = acc[ai][bj][m][0], a1 = acc[ai][bj][m][1];
                    u32x4 w; w.x = pk2(gelu_tanh(a0.x), gelu_tanh(a0.y)); w.y = pk2(gelu_tanh(a0.z), gelu_tanh(a0.w)); w.z = pk2(gelu_tanh(a1.x), gelu_tanh(a1.y)); w.w = pk2(gelu_tanh(a1.z), gelu_tanh(a1.w));
                    *(u32x4*)(y + (unsigned)((row * 16 + t) * 1024 + u.b * 16 + co0)) = w;
                    asm volatile("" ::: "memory"); } }
    }
};
struct EpiGLUf {
    static constexpr bool PERM = true, FUSED = false, CHAIN = false; bf16_t* o;
    __device__ __forceinline__ void operator()(const acc_t& acc, const pg8::Unit& u, int wr, int wc, int fr, int fq) const {
#pragma unroll
        for (int ai = 0; ai < 2; ++ai)
#pragma unroll
            for (int m = 0; m < 4; ++m) { const int row = EPI_ROW(ai, m);
                const f32x4 v0 = acc[ai][0][m][0] * sig4(acc[ai][1][m][0]), v1 = acc[ai][0][m][1] * sig4(acc[ai][1][m][1]);
                *(u32x4*)(o + (size_t)row * 1024 + u.pn * 128 + wc * 32 + 8 * fq) = pack8(v0, v1); }
    }
};
__device__ __forceinline__ void ld_bf8(const bf16_t* p, f32x4& lo, f32x4& hi) { const u32x4 w = *(const u32x4*)p;
    lo.x = bf2f(w.x & 0xffffu); lo.y = bf2f(w.x >> 16); lo.z = bf2f(w.y & 0xffffu); lo.w = bf2f(w.y >> 16); hi.x = bf2f(w.z & 0xffffu); hi.y = bf2f(w.z >> 16); hi.z = bf2f(w.w & 0xffffu); hi.w = bf2f(w.w >> 16); }
__device__ __forceinline__ void ld_bf8_nt(const bf16_t* p, f32x4& lo, f32x4& hi) { const u32x4 w = __builtin_nontemporal_load((const u32x4*)p);
    lo.x = bf2f(w.x & 0xffffu); lo.y = bf2f(w.x >> 16); lo.z = bf2f(w.y & 0xffffu); lo.w = bf2f(w.y >> 16); hi.x = bf2f(w.z & 0xffffu); hi.y = bf2f(w.z >> 16); hi.z = bf2f(w.w & 0xffffu); hi.w = bf2f(w.w >> 16); }
struct EpiBrF {
    static constexpr bool PERM = true, FUSED = true, CHAIN = true; const bf16_t* ga; const bf16_t* gs; bf16_t* mo;
    __device__ __forceinline__ void fused(acc_t& acc, const pg8::Unit& u, int wr, int wc, int fr, int fq) const {
#pragma unroll
        for (int ai = 0; ai < 2; ++ai)
#pragma unroll
            for (int m = 0; m < 4; ++m) { const int row = EPI_ROW(ai, m);
#pragma unroll
                for (int bj = 0; bj < 2; ++bj) { const unsigned o = (unsigned)(row * 2048 + u.pn * 256 + bj * 128 + wc * 32 + 8 * fq); f32x4 s0, s1; if (u.b == 0) ld_bf8(gs + o, s0, s1); else ld_bf8_nt(gs + o, s0, s1);
                    if (u.b == 0) { f32x4 a0, a1; ld_bf8_nt(ga + o, a0, a1);
                        f32x4 r0, r1; r0.x = a0.x * __builtin_amdgcn_rcpf(fmaxf(s0.x, 1e-30f)); r0.y = a0.y * __builtin_amdgcn_rcpf(fmaxf(s0.y, 1e-30f)); r0.z = a0.z * __builtin_amdgcn_rcpf(fmaxf(s0.z, 1e-30f)); r0.w = a0.w * __builtin_amdgcn_rcpf(fmaxf(s0.w, 1e-30f));
                        r1.x = a1.x * __builtin_amdgcn_rcpf(fmaxf(s1.x, 1e-30f)); r1.y = a1.y * __builtin_amdgcn_rcpf(fmaxf(s1.y, 1e-30f)); r1.z = a1.z * __builtin_amdgcn_rcpf(fmaxf(s1.z, 1e-30f)); r1.w = a1.w * __builtin_amdgcn_rcpf(fmaxf(s1.w, 1e-30f));
                        acc[ai][bj][m][0] = acc[ai][bj][m][0] * r0; acc[ai][bj][m][1] = acc[ai][bj][m][1] * r1; }
                    else *(u32x4*)(mo + o) = pack8(acc[ai][bj][m][0] * s0, acc[ai][bj][m][1] * s1); } }
    }
};
struct EpiUpf {
    static constexpr bool PERM = true, FUSED = false, CHAIN = false; bf16_t* a; const float* part2;
    __device__ __forceinline__ void operator()(const acc_t& acc, const pg8::Unit& u, int wr, int wc, int fr, int fq) const {
#pragma unroll
        for (int ai = 0; ai < 2; ++ai)
#pragma unroll
            for (int m = 0; m < 4; ++m) { const int row = EPI_ROW(ai, m);
                const f32x4* pp = (const f32x4*)(part2 + (size_t)row * 32 + fq * 8); const f32x4 pa = pp[0], pb = pp[1];
                float ss = ((pa.x + pa.y) + (pa.z + pa.w)) + ((pb.x + pb.y) + (pb.z + pb.w)); ss += __shfl_xor(ss, 16); ss += __shfl_xor(ss, 32);
                const float ri = rsqrtf(ss * (1.0f / DM) + 1e-6f);
#pragma unroll
                for (int bj = 0; bj < 2; ++bj) {
                    f32x4 v0 = acc[ai][bj][m][0] * ri, v1 = acc[ai][bj][m][1] * ri;
                    v0.x = fmaxf(v0.x, 0.f); v0.y = fmaxf(v0.y, 0.f); v0.z = fmaxf(v0.z, 0.f); v0.w = fmaxf(v0.w, 0.f);
                    v1.x = fmaxf(v1.x, 0.f); v1.y = fmaxf(v1.y, 0.f); v1.z = fmaxf(v1.z, 0.f); v1.w = fmaxf(v1.w, 0.f);
                    *(u32x4*)(a + (size_t)row * DFF + u.pn * 256 + bj * 128 + wc * 32 + 8 * fq) = pack8(v0 * v0, v1 * v1); } }
    }
};

__device__ __forceinline__ void row_partials(const acc_t& acc, float* part, const pg8::Unit& u, int wr, int wc, int fr, int fq) {
#pragma unroll
    for (int ai = 0; ai < 2; ++ai)
#pragma unroll
        for (int m = 0; m < 4; ++m) {
            float s = 0.f;
#pragma unroll
            for (int bj = 0; bj < 2; ++bj)
#pragma unroll
                for (int n = 0; n < 2; ++n) { const f32x4 v = acc[ai][bj][m][n]; s += (v.x * v.x + v.y * v.y) + (v.z * v.z + v.w * v.w); }
            s += __shfl_xor(s, 16); s += __shfl_xor(s, 32);
            if (fq == 0) part[(size_t)EPI_ROW(ai, m) * 32 + u.pn * 4 + wc] = s;
        }
}
__device__ __forceinline__ void row_rinv(const float* part, float (&rinv)[2][4], const pg8::Unit& u, int wr, int fr, int fq) {
#pragma unroll
    for (int ai = 0; ai < 2; ++ai)
#pragma unroll
        for (int m = 0; m < 4; ++m) {
            const f32x4* pp = (const f32x4*)(part + (size_t)EPI_ROW(ai, m) * 32 + fq * 8);
            const f32x4 a = pp[0], b = pp[1];
            float s = ((a.x + a.y) + (a.z + a.w)) + ((b.x + b.y) + (b.z + b.w));
            s += __shfl_xor(s, 16); s += __shfl_xor(s, 32);
            rinv[ai][m] = rsqrtf(s * (1.0f / DM) + 1e-6f);
        }
}
struct EpiOutNormF {
    static constexpr bool PERM = true, FUSED = true, CHAIN = false;
    const float* x; const float* g1; const float* g2; float* x1; bf16_t* h2; float* part1; float* part2; XcdBarrier xb;
    __device__ __forceinline__ void fused(acc_t& acc, const pg8::Unit& u, int wr, int wc, int fr, int fq) const {
        float rinv[2][4];
        row_partials(acc, part1, u, wr, wc, fr, fq);
        xcd_barrier(xb);
        row_rinv(part1, rinv, u, wr, fr, fq);
#pragma unroll
        for (int bj = 0; bj < 2; ++bj) { const int col = u.pn * 256 + bj * 128 + wc * 32 + 8 * fq;
            const f32x4 ga0 = *(const f32x4*)(g1 + col), ga1 = *(const f32x4*)(g1 + col + 4), gb0 = *(const f32x4*)(g2 + col), gb1 = *(const f32x4*)(g2 + col + 4);
#pragma unroll
            for (int ai = 0; ai < 2; ++ai)
#pragma unroll
              for (int mh = 0; mh < 2; ++mh) {
                f32x4 xv[2][2];
#pragma unroll
                for (int mm = 0; mm < 2; ++mm) { const unsigned o = (unsigned)(EPI_ROW(ai, 2 * mh + mm) * DM + col); xv[mm][0] = __builtin_nontemporal_load((const f32x4*)(x + o)); xv[mm][1] = __builtin_nontemporal_load((const f32x4*)(x + o + 4)); }
#pragma unroll
                for (int mm = 0; mm < 2; ++mm) { const int m = 2 * mh + mm; const unsigned o = (unsigned)(EPI_ROW(ai, m) * DM + col);
                    const f32x4 v0 = xv[mm][0] + acc[ai][bj][m][0] * rinv[ai][m] * ga0, v1 = xv[mm][1] + acc[ai][bj][m][1] * rinv[ai][m] * ga1;
                    acc[ai][bj][m][0] = v0; acc[ai][bj][m][1] = v1; *(f32x4*)(x1 + o) = v0; *(f32x4*)(x1 + o + 4) = v1; *(u32x4*)(h2 + o) = pack8(v0 * gb0, v1 * gb1); }
#pragma unroll
                for (int mm = 0; mm < 2; ++mm) asm volatile("" : "+v"(acc[ai][bj][2 * mh + mm][0]), "+v"(acc[ai][bj][2 * mh + mm][1]));
                asm volatile("" ::: "memory"); } }
        row_partials(acc, part2, u, wr, wc, fr, fq);
    }
};
struct EpiDownNormF {
    static constexpr bool PERM = true, FUSED = true, CHAIN = false;
    const float* g; float* x1; float* part; XcdBarrier xb;
    __device__ __forceinline__ void fused(acc_t& acc, const pg8::Unit& u, int wr, int wc, int fr, int fq) const {
        float rinv[2][4];
        row_partials(acc, part, u, wr, wc, fr, fq);
        xcd_barrier(xb);
        row_rinv(part, rinv, u, wr, fr, fq);
#pragma unroll
        for (int bj = 0; bj < 2; ++bj) { const int col = u.pn * 256 + bj * 128 + wc * 32 + 8 * fq;
            const f32x4 g0 = *(const f32x4*)(g + col), g1 = *(const f32x4*)(g + col + 4);
#pragma unroll
            for (int ai = 0; ai < 2; ++ai)
#pragma unroll
                for (int m = 0; m < 4; ++m) { float* o = x1 + (unsigned)(EPI_ROW(ai, m) * DM + col);
                    const f32x4 a0 = __builtin_nontemporal_load((const f32x4*)o), a1 = __builtin_nontemporal_load((const f32x4*)(o + 4));
                    __builtin_nontemporal_store(a0 + acc[ai][bj][m][0] * rinv[ai][m] * g0, (f32x4*)o); __builtin_nontemporal_store(a1 + acc[ai][bj][m][1] * rinv[ai][m] * g1, (f32x4*)(o + 4)); } }
    }
};

typedef float f32x16 __attribute__((ext_vector_type(16)));
typedef short s16x8 __attribute__((ext_vector_type(8)));
constexpr int ATT_KROW = 144, ATT_VROW = 336, ATT_VOFF = 160 * ATT_KROW;
struct AttnRegs { u32x4 k[3], v[3]; };
__device__ __forceinline__ void attn_load(AttnRegs& R, const bf16_t* Kb, const bf16_t* VT, const int q0, const int hk, const int tid) {
#pragma unroll
    for (int j = 0; j < 3; ++j) { const int c = tid + 512 * j;
        u32x4 kv = {0u, 0u, 0u, 0u}, vv = {0u, 0u, 0u, 0u};
        if (c < 1280) { const int row = c >> 3, ch = c & 7, key = q0 - 128 + row; if (key >= 0) kv = *(const u32x4*)(Kb + (size_t)key * 128 + hk * 64 + ch * 8);
            const int d = c / 20, cc = c % 20, k0 = q0 - 128 + cc * 8; if (k0 >= 0) vv = *(const u32x4*)(VT + (size_t)(hk * 64 + d) * SEQ + k0); }
        R.k[j] = kv; R.v[j] = vv; }
}
__device__ __forceinline__ void attn_store(const AttnRegs& R, LAS unsigned char* lds, const int tid) {
#pragma unroll
    for (int j = 0; j < 3; ++j) { const int c = tid + 512 * j;
        if (c < 1280) { const int row = c >> 3, ch = c & 7, d = c / 20, cc = c % 20;
            *(LAS u32x4*)(lds + row * ATT_KROW + ch * 16) = R.k[j]; *(LAS u32x4*)(lds + ATT_VOFF + d * ATT_VROW + cc * 16) = R.v[j]; } }
}
__device__ __forceinline__ void attn_item(LAS unsigned char* lds, const bf16_t* Q, bf16_t* O, const float sink, const int q0, const int h, const int lane,
                                          AttnRegs& R, const bf16_t* Kb, const bf16_t* VT, const int nq0, const int nhk, const bool pf, const int tid) {
    const int r = lane & 31, hf = lane >> 5;
    s16x8 qf[4];
#pragma unroll
    for (int kk = 0; kk < 4; ++kk) qf[kk] = *(const s16x8*)(Q + (size_t)(q0 + r) * 1024 + h * 64 + 16 * kk + 8 * hf);
    f32x16 st[5];
#pragma unroll
    for (int kt = 0; kt < 5; ++kt) {
        f32x16 a = {0.f, 0.f, 0.f, 0.f, 0.f, 0.f, 0.f, 0.f, 0.f, 0.f, 0.f, 0.f, 0.f, 0.f, 0.f, 0.f};
#pragma unroll
        for (int kk = 0; kk < 4; ++kk) {
            const s16x8 kf = *(const LAS s16x8*)(lds + (32 * kt + r) * ATT_KROW + (16 * kk + 8 * hf) * 2);
            a = __builtin_amdgcn_mfma_f32_32x32x16_bf16(kf, qf[kk], a, 0, 0, 0);
        }
        st[kt] = a;
    }
    if (pf) attn_load(R, Kb, VT, nq0, nhk, tid);
    float mx = sink;
#pragma unroll
    for (int kt = 0; kt < 5; ++kt)
#pragma unroll
        for (int e = 0; e < 16; ++e) {
            const int kofs = -128 + 32 * kt + (e & 3) + 8 * (e >> 2) + 4 * hf;
            const int diff = r - kofs;
            const bool ok = (diff >= 0) && (diff < 128) && (q0 + kofs >= 0);
            const float sv = ok ? st[kt][e] * 0.125f : -1e30f;
            st[kt][e] = sv; mx = fmaxf(mx, sv);
        }
    mx = fmaxf(mx, __shfl_xor(mx, 32));
    float sum = 0.f;
#pragma unroll
    for (int kt = 0; kt < 5; ++kt)
#pragma unroll
        for (int e = 0; e < 16; ++e) { const float pv = (st[kt][e] > -1e29f) ? __expf(st[kt][e] - mx) : 0.f; st[kt][e] = pv; sum += pv; }
    sum += __shfl_xor(sum, 32);
    sum += __expf(sink - mx);
    const float inv = 1.0f / sum;
    f32x16 o0 = {0.f, 0.f, 0.f, 0.f, 0.f, 0.f, 0.f, 0.f, 0.f, 0.f, 0.f, 0.f, 0.f, 0.f, 0.f, 0.f}, o1 = o0;
#pragma unroll
    for (int kt = 0; kt < 5; ++kt)
#pragma unroll
        for (int s = 0; s < 2; ++s) {
            u32x4 pw; pw.x = pk2(st[kt][8 * s + 0], st[kt][8 * s + 1]); pw.y = pk2(st[kt][8 * s + 2], st[kt][8 * s + 3]);
            pw.z = pk2(st[kt][8 * s + 4], st[kt][8 * s + 5]); pw.w = pk2(st[kt][8 * s + 6], st[kt][8 * s + 7]);
            const s16x8 pf = __builtin_bit_cast(s16x8, pw);
#pragma unroll
            for (int dt = 0; dt < 2; ++dt) {
                const LAS unsigned char* vp = lds + ATT_VOFF + (32 * dt + r) * ATT_VROW + (32 * kt + 16 * s + 4 * hf) * 2;
                const u32x2 a0 = *(const LAS u32x2*)vp, a1 = *(const LAS u32x2*)(vp + 16);
                u32x4 vw; vw.x = a0.x; vw.y = a0.y; vw.z = a1.x; vw.w = a1.y;
                const s16x8 vf = __builtin_bit_cast(s16x8, vw);
                if (dt == 0) o0 = __builtin_amdgcn_mfma_f32_32x32x16_bf16(vf, pf, o0, 0, 0, 0);
                else o1 = __builtin_amdgcn_mfma_f32_32x32x16_bf16(vf, pf, o1, 0, 0, 0);
            }
        }
    bf16_t* op = O + (size_t)(q0 + r) * 1024 + h * 64 + 4 * hf;
#pragma unroll
    for (int i = 0; i < 4; ++i) {
        u32x2 w; w.x = pk2(o0[4 * i] * inv, o0[4 * i + 1] * inv); w.y = pk2(o0[4 * i + 2] * inv, o0[4 * i + 3] * inv); *(u32x2*)(op + 8 * i) = w;
        u32x2 w1; w1.x = pk2(o1[4 * i] * inv, o1[4 * i + 1] * inv); w1.y = pk2(o1[4 * i + 2] * inv, o1[4 * i + 3] * inv); *(u32x2*)(op + 32 + 8 * i) = w1;
    }
}

constexpr int NPHASE = 8;

#ifndef PROBE_PH
#define PROBE_PH -1
#endif
template <int PH, int REP = 1>
__device__ __forceinline__ void run_phase(const P& p, LAS unsigned char* lds, const XcdBarrier& xb) {
    int tid_ = threadIdx.x; asm volatile("" : "+v"(tid_));
    const int tid = tid_, lane = tid & 63, wave = tid >> 6;
    int bid_ = blockIdx.x; asm volatile("" : "+s"(bid_));
    const int bid = bid_;
    const int G = gridDim.x, gw = bid * 8 + wave, NGW = G * 8;
    const size_t gt = (size_t)bid * 512 + tid, NGT = (size_t)G * 512;
    unsigned char* ws = p.ws; unsigned char* dout = (unsigned char*)p.out;
    asm volatile("" : "+s"(ws), "+s"(dout));
    float* PART1 = (float*)(ws + WS_PART1); float* PART2 = (float*)(ws + WS_PART2);
    float2* AP = (float2*)(ws + WS_AP); float2* BBAR = (float2*)(ws + WS_BBAR); float2* ROPE = (float2*)(ws + WS_ROPE);
    bf16_t* WUP = (bf16_t*)(ws + WS_WUP); bf16_t* WDN = (bf16_t*)(ws + WS_WDN); bf16_t* WIN = (bf16_t*)(ws + WS_WIN); bf16_t* WGLU = (bf16_t*)(ws + WS_WGLU);
    bf16_t* WBRA = (bf16_t*)(ws + WS_WBRA); bf16_t* WBRS = (bf16_t*)(ws + WS_WBRS); bf16_t* WOUT = (bf16_t*)(ws + WS_WOUT);
    bf16_t* H = (bf16_t*)(ws + WS_H); bf16_t* OATT = (bf16_t*)(ws + WS_OATT); bf16_t* Q = (bf16_t*)(ws + WS_Q); bf16_t* OSSM = (bf16_t*)(ws + WS_OSSM);
    bf16_t* Kb = (bf16_t*)(ws + WS_K); bf16_t* VT = (bf16_t*)(ws + WS_VT); bf16_t* AX = (bf16_t*)(ws + WS_AX); bf16_t* Y = (bf16_t*)(ws + WS_Y);
    bf16_t* Mb = (bf16_t*)(ws + WS_M); bf16_t* GA = (bf16_t*)(ws + WS_GA); bf16_t* GS = (bf16_t*)(ws + WS_GS); float* MIXED = (float*)(ws + WS_MIXED);
    bf16_t* H2 = (bf16_t*)(ws + WS_H2); bf16_t* Ab = (bf16_t*)(ws + WS_A); float* DN = (float*)(ws + WS_DN);
    float* S = (float*)(dout + DO_S); float* KTAB = (float*)(dout + DO_KTAB); bf16_t* BC = (bf16_t*)(dout + DO_BC); bf16_t* YB = (bf16_t*)(dout + DO_YB);
    float* T1 = (float*)dout; float* X1 = (float*)dout;
    const float* x = p.in[0];

    if constexpr (PH == 0) {
        LAS float* scr = (LAS float*)(lds + wave * 16384);
        for (int base = bid * 32; base < TI_IN; base += G * 32) transpose_quad(p, base + wave * 4, scr, lane);
        {
            const int r0 = (bid < 200) ? 25 * bid : 5000 + 57 * (bid - 200), r1 = (bid < 200) ? r0 + 25 : r0 + 57;
            if (r0 + wave < r1) {
            f32x4 v[8];
#pragma unroll
            for (int j = 0; j < 8; ++j) v[j] = __builtin_nontemporal_load((const f32x4*)(x + (size_t)(r0 + wave) * DM) + 64 * j + lane);
            for (int m = r0 + wave; m < r1; m += 8) {
                const bool more = m + 8 < r1; f32x4 nv[8];
                if (more) {
#pragma unroll
                    for (int j = 0; j < 8; ++j) nv[j] = __builtin_nontemporal_load((const f32x4*)(x + (size_t)(m + 8) * DM) + 64 * j + lane); }
                float ss = 0.f;
#pragma unroll
                for (int j = 0; j < 8; ++j) ss += v[j].x * v[j].x + v[j].y * v[j].y + v[j].z * v[j].z + v[j].w * v[j].w;
                const float rr = rsqrtf(wave_sum(ss) * (1.0f / DM) + 1e-6f);
#pragma unroll
                for (int j = 0; j < 8; ++j) { const f32x4 g = ((const f32x4*)p.in[1])[64 * j + lane]; const f32x4 o = v[j] * rr * g;
                    u32x2 w; w.x = pk2(o.x, o.y); w.y = pk2(o.z, o.w); ((u32x2*)(H + (size_t)m * DM))[64 * j + lane] = w; }
                if (more) {
#pragma unroll
                    for (int j = 0; j < 8; ++j) v[j] = nv[j]; }
            }
            }
        }
        for (size_t e = gt; e < (size_t)NG * SP * NAP; e += NGT) {
            const int i = (int)(e / NAP), n = (int)(e % NAP), g = i / SP;
            const double dt = exp((double)p.in[9][g]), lr = (double)p.in[7][i], li = (double)p.in[8][i];
            const double pw = (n == 17) ? 1024.0 : (double)n;
            const float mag = (float)exp(pw * lr * dt); float sn, cs; sincos_d(pw * li * dt, sn, cs);
            AP[((size_t)g * NAP + n) * SP + (i % SP)] = make_float2(mag * cs, mag * sn);
        }
        for (size_t e = gt; e < (size_t)NG * SP * GC; e += NGT) {
            const int i = (int)(e >> 4), g = i / SP;
            const double dt = exp((double)p.in[9][g]), lr = (double)p.in[7][i], li = (double)p.in[8][i];
            float s1, c1; sincos_d(li * dt, s1, c1);
            const double mag1 = exp(lr * dt), are = mag1 * (double)c1, aim = mag1 * (double)s1;
            const double nr = are - 1.0, ni = aim, den = lr * lr + li * li;
            const double cre = (nr * lr + ni * li) / den, cim = (ni * lr - nr * li) / den;
            const double br = (double)p.in[10][e], bi = (double)p.in[11][e];
            BBAR[e] = make_float2((float)(cre * br - cim * bi), (float)(cre * bi + cim * br));
        }
        for (size_t i = gt; i < (size_t)SEQ * 8; i += NGT) {
            const int pos = (int)(i >> 3), k = (int)(i & 7);
            const double inv = exp(-(double)k * 0.125 * 13.122363377404328);
            float s, c; sincos_d((double)pos * inv, s, c);
            ROPE[i] = make_float2(c, s);
        }
        }
    if constexpr (PH == 1) {
        { pg8::Gemm g{H, WIN, SEQ, INW, DM, DM, DM, 1, 0, 0}; pg8::Order S; S.init(SEQ, INW, 1, G, bid, 3);
          EpiZf E{Q, Kb, VT, AX, GA, GS, (const float*)ROPE}; pg8::gemm_phase(lds, g, S, E, tid); }
        for (size_t e = gt; e < (size_t)NG * 256 * 32; e += NGT) {
            const int g = (int)(e >> 13), r = (int)(e >> 5) & 255, k8 = (int)e & 31, s_ = k8 >> 1, ci0 = (k8 & 1) * 8;
            u32x4 w = {0u, 0u, 0u, 0u};
            if (r < 128) { const int pp = r & 63; const float2 a = AP[((size_t)g * NAP + 15 - s_) * SP + pp];
                const f32x4* bp = (const f32x4*)(BBAR + ((size_t)g * SP + pp) * GC + ci0); const f32x4 b0 = bp[0], b1 = bp[1], b2 = bp[2], b3 = bp[3];
                if (r >> 6) { w.x = pk2(a.x * b0.y + a.y * b0.x, a.x * b0.w + a.y * b0.z); w.y = pk2(a.x * b1.y + a.y * b1.x, a.x * b1.w + a.y * b1.z);
                              w.z = pk2(a.x * b2.y + a.y * b2.x, a.x * b2.w + a.y * b2.z); w.w = pk2(a.x * b3.y + a.y * b3.x, a.x * b3.w + a.y * b3.z); }
                else {        w.x = pk2(a.x * b0.x - a.y * b0.y, a.x * b0.z - a.y * b0.w); w.y = pk2(a.x * b1.x - a.y * b1.y, a.x * b1.z - a.y * b1.w);
                              w.z = pk2(a.x * b2.x - a.y * b2.y, a.x * b2.z - a.y * b2.w); w.w = pk2(a.x * b3.x - a.y * b3.y, a.x * b3.z - a.y * b3.w); } }
            *(u32x4*)(BC + e * 8) = w;
        }
        for (size_t e = gt; e < (size_t)NG * 256 * 16; e += NGT) {
            const int g = (int)(e >> 12), row = (int)(e >> 4) & 255, r0 = ((int)e & 15) * 8, t = row >> 4, co = row & 15, pp0 = r0 & 63;
            const f32x4* ap = (const f32x4*)(AP + ((size_t)g * NAP + t + 1) * SP + pp0); const f32x4 a0 = ap[0], a1 = ap[1], a2 = ap[2], a3 = ap[3];
            const f32x4* crp = (const f32x4*)(p.in[12] + ((size_t)g * GC + co) * SP + pp0); const f32x4* cip = (const f32x4*)(p.in[13] + ((size_t)g * GC + co) * SP + pp0);
            const f32x4 cr0 = crp[0], cr1 = crp[1], ci0 = cip[0], ci1 = cip[1];
            u32x4 w;
            if (r0 >> 6) { w.x = pk2(-(cr0.x * a0.y + ci0.x * a0.x), -(cr0.y * a0.w + ci0.y * a0.z)); w.y = pk2(-(cr0.z * a1.y + ci0.z * a1.x), -(cr0.w * a1.w + ci0.w * a1.z));
                           w.z = pk2(-(cr1.x * a2.y + ci1.x * a2.x), -(cr1.y * a2.w + ci1.y * a2.z)); w.w = pk2(-(cr1.z * a3.y + ci1.z * a3.x), -(cr1.w * a3.w + ci1.w * a3.z)); }
            else {         w.x = pk2(cr0.x * a0.x - ci0.x * a0.y, cr0.y * a0.z - ci0.y * a0.w); w.y = pk2(cr0.z * a1.x - ci0.z * a1.y, cr0.w * a1.z - ci0.w * a1.w);
                           w.z = pk2(cr1.x * a2.x - ci1.x * a2.y, cr1.y * a2.z - ci1.y * a2.w); w.w = pk2(cr1.z * a3.x - ci1.z * a3.y, cr1.w * a3.z - ci1.w * a3.w); }
            *(u32x4*)(YB + ((size_t)g * 256 + row) * 384 + 256 + r0) = w;
        }
        {
            LAS float* Cre = (LAS float*)lds; LAS float* Cim = Cre + 16 * 65; LAS float* APr = Cim + 16 * 65; LAS float* APi = APr + 256; LAS float* Bbr = APi + 256; LAS float* Bbi = Bbr + 1024;
            for (int item = bid; item < NG * 4; item += G) {
                const int g = item >> 2, tq = item & 3;
                __syncthreads();
                for (int i = tid; i < 1024; i += 512) { Cre[(i >> 6) * 65 + (i & 63)] = p.in[12][(size_t)g * 1024 + i]; Cim[(i >> 6) * 65 + (i & 63)] = p.in[13][(size_t)g * 1024 + i];
                    const float2 b = BBAR[(size_t)g * 1024 + i]; Bbr[i] = b.x; Bbi[i] = b.y; }
                if (tid < 256) { const float2 a = AP[((size_t)g * NAP + 4 * tq + (tid >> 6)) * SP + (tid & 63)]; APr[tid] = a.x; APi[tid] = a.y; }
                __syncthreads();
#pragma unroll
                for (int rr = 0; rr < 2; ++rr) {
                    const int idx = tid + 512 * rr, tl = idx >> 8, co = (idx >> 4) & 15, ci = idx & 15;
                    float acc = 0.f;
#pragma unroll 8
                    for (int pp = 0; pp < SP; ++pp) {
                        const float cr = Cre[co * 65 + pp], cim = Cim[co * 65 + pp], ax = APr[tl * 64 + pp], ay = APi[tl * 64 + pp];
                        const float wre = cr * ax - cim * ay, wim = cr * ay + cim * ax;
                        acc += wre * Bbr[pp * 16 + ci] - wim * Bbi[pp * 16 + ci];
                    }
                    const int tau = 4 * tq + tl;
                    if (tau == 0 && co == ci) acc += p.in[14][g * GC + co];
                    KTAB[(((size_t)g * 16 + tau) * 16 + co) * 16 + ci] = acc;
                }
            }
            __syncthreads();
        }
        }
    if constexpr (PH == 2) {
        if (bid < 2 * NG) {
            const int g = bid & 63, h = bid >> 6;
            unsigned* flagS = (unsigned*)(ws + WS_CTL + 14464) + g;
            unsigned* flagX = (unsigned*)(ws + WS_CTL + 14464 + 256) + g;
            if (h == 0) {
                for (int e = tid; e < 256 * 32; e += 512) {
                    const int row = e >> 5, k8 = e & 31, s_ = k8 >> 1, ci0 = (k8 & 1) * 8, t = row >> 4, co = row & 15;
                    u32x4 w = {0u, 0u, 0u, 0u};
                    if (t >= s_) { const f32x4* kp = (const f32x4*)(KTAB + (((size_t)g * 16 + (t - s_)) * 16 + co) * 16 + ci0); w = pack8(kp[0], kp[1]); }
                    *(u32x4*)(YB + ((size_t)g * 256 + row) * 384 + 8 * k8) = w;
                }
            }
            { pg8::Gemm gm{AX, BC, 512, 256, 256, 384, 256, NG, (size_t)512 * 384, (size_t)256 * 256}; pg8::Order S_; S_.init(512, 256, NG, 1, 0, 1, 2 * g + h);
              EpiSf E{S}; pg8::gemm_phase(lds, gm, S_, E, tid); }
            asm volatile("s_waitcnt vmcnt(0)" ::: "memory"); __syncthreads();
            if (h == 1) {
                if (tid == 0) { __builtin_amdgcn_fence(__ATOMIC_RELEASE, "agent"); asm volatile("s_waitcnt vmcnt(0)" ::: "memory"); __hip_atomic_store(flagS, 1u, __ATOMIC_RELAXED, __HIP_MEMORY_SCOPE_AGENT);
                    unsigned sp = 0; while (__hip_atomic_load(flagX, __ATOMIC_RELAXED, __HIP_MEMORY_SCOPE_AGENT) == 0u && ++sp < (1u << 24)) __builtin_amdgcn_s_sleep(2);
                    __builtin_amdgcn_fence(__ATOMIC_ACQUIRE, "agent"); asm volatile("s_waitcnt vmcnt(0)" ::: "memory"); }
                __syncthreads();
            } else {
                if (tid == 0) { unsigned sp = 0; while (__hip_atomic_load(flagS, __ATOMIC_RELAXED, __HIP_MEMORY_SCOPE_AGENT) == 0u && ++sp < (1u << 24)) __builtin_amdgcn_s_sleep(2);
                    __builtin_amdgcn_fence(__ATOMIC_ACQUIRE, "agent"); asm volatile("s_waitcnt vmcnt(0)" ::: "memory"); }
                __syncthreads();
        LAS float* Elr = (LAS float*)lds; LAS float* Eli = Elr + 512;
        {
            const int pp = tid & 63, seg = tid >> 6;
            const float2 A16 = AP[((size_t)g * NAP + 16) * SP + pp], A1k = AP[((size_t)g * NAP + 17) * SP + pp];
            const float* Sg = S + (size_t)g * 512 * 128;
            float lre = 0.f, lim = 0.f;
            for (int j0 = seg * 64; j0 < seg * 64 + 64; j0 += 16) {
                float sr[16], si[16];
#pragma unroll
                for (int q = 0; q < 16; ++q) { sr[q] = Sg[(j0 + q) * 128 + pp]; si[q] = Sg[(j0 + q) * 128 + 64 + pp]; }
#pragma unroll
                for (int q = 0; q < 16; ++q) { const float nr = A16.x * lre - A16.y * lim + sr[q], ni = A16.x * lim + A16.y * lre + si[q]; lre = nr; lim = ni; }
            }
            __syncthreads();
            Elr[seg * 64 + pp] = lre; Eli[seg * 64 + pp] = lim;
            __syncthreads();
            float cre = 0.f, cim = 0.f;
            for (int s2 = 0; s2 < seg; ++s2) { const float2 e = make_float2(Elr[s2 * 64 + pp], Eli[s2 * 64 + pp]);
                const float nr = A1k.x * cre - A1k.y * cim + e.x, ni = A1k.x * cim + A1k.y * cre + e.y; cre = nr; cim = ni; }
            for (int j0 = seg * 64; j0 < seg * 64 + 64; j0 += 16) {
                float sr[16], si[16];
#pragma unroll
                for (int q = 0; q < 16; ++q) { sr[q] = Sg[(j0 + q) * 128 + pp]; si[q] = Sg[(j0 + q) * 128 + 64 + pp]; }
#pragma unroll
                for (int q = 0; q < 16; ++q) {
                    bf16_t* axr = AX + ((size_t)g * 512 + j0 + q) * 384 + 256;
                    axr[pp] = (bf16_t)f2bf(cre); axr[64 + pp] = (bf16_t)f2bf(cim);
                    const float nr = A16.x * cre - A16.y * cim + sr[q], ni = A16.x * cim + A16.y * cre + si[q]; cre = nr; cim = ni; }
            }
            }
                asm volatile("s_waitcnt vmcnt(0)" ::: "memory"); __syncthreads();
                if (tid == 0) { __builtin_amdgcn_fence(__ATOMIC_RELEASE, "agent"); asm volatile("s_waitcnt vmcnt(0)" ::: "memory"); __hip_atomic_store(flagX, 1u, __ATOMIC_RELAXED, __HIP_MEMORY_SCOPE_AGENT); }
                __syncthreads();
            }
            { pg8::Gemm gm{AX, YB, 512, 256, 384, 384, 384, NG, (size_t)512 * 384, (size_t)256 * 384}; pg8::Order S_; S_.init(512, 256, NG, 1, 0, 1, 2 * g + h);
              EpiYf E{Y}; pg8::gemm_phase(lds, gm, S_, E, tid); }
        } else if (bid < 2 * NG + 32) {
            pg8::Gemm gm{H, WIN, SEQ, INW, DM, DM, DM, 1, 0, 0}; pg8::Order S_; S_.init(SEQ, INW, 1, 1 << 20, bid - 2 * NG, 1, 768);
            EpiZf E{Q, Kb, VT, AX, GA, GS, (const float*)ROPE}; pg8::gemm_phase(lds, gm, S_, E, tid);
        } else {
            {
                const int step = G - (2 * NG + 32); int item = bid - (2 * NG + 32);
                AttnRegs R;
                if (item < 512) attn_load(R, Kb, VT, (item >> 1) * 32, item & 1, tid);
                while (item < 512) {
                    const int hk = item & 1, q0 = (item >> 1) * 32, h = hk * 8 + wave, nxt = item + step;
                    __syncthreads();
                    attn_store(R, lds, tid);
                    __syncthreads();
                    attn_item(lds, Q, OATT, p.in[6][h], q0, h, lane, R, Kb, VT, (nxt >> 1) * 32, nxt & 1, nxt < 512, tid);
                    item = nxt;
                }
            }
        }
        {
            unsigned* ctr = (unsigned*)(ws + WS_CTL + 14336); volatile LAS int* slot = (volatile LAS int*)(lds + 131072 + 64);
            for (;;) {
                __syncthreads();
                if (tid == 0) slot[0] = TI_IN + (int)__hip_atomic_fetch_add(ctr, 32u, __ATOMIC_RELAXED, __HIP_MEMORY_SCOPE_AGENT);
                __syncthreads();
                const int base = slot[0];
                if (base >= TI_ALL) break;
                transpose_quad(p, base + wave * 4, (LAS float*)(lds + wave * 16384), lane);
            }
        }
    }
    if constexpr (PH == 3) { pg8::Gemm g{Y, WGLU, SEQ, 2048, 1024, 1024, 1024, 1, 0, 0}; pg8::Order S_; S_.init(SEQ, 2048, 1, G, bid);
        EpiGLUf E{OSSM}; pg8::gemm_phase(lds, g, S_, E, tid); }
    if constexpr (PH == 4) {
        pg8::Gemm g{OATT, WBRA, SEQ, 2048, 1024, 1024, 1024, 2, (size_t)(OSSM - OATT), (size_t)(WBRS - WBRA)}; pg8::Order S_; S_.init(SEQ, 2048, 2, G, bid);
        EpiBrF E{GA, GS, Mb}; pg8::gemm_phase(lds, g, S_, E, tid);
    }
    if constexpr (PH == 5) { pg8::Gemm g{Mb, WOUT, SEQ, 2048, 2048, 2048, 2048, 1, 0, 0}; pg8::Order S_; S_.init(SEQ, 2048, 1, G, bid);
        EpiOutNormF E{x, p.in[2], p.in[3], X1, H2, PART1, PART2, xb}; pg8::gemm_phase(lds, g, S_, E, tid); }
    if constexpr (PH == 6) { pg8::Gemm g{H2, WUP, SEQ, DFF, DM, DM, DM, 1, 0, 0}; pg8::Order S_; S_.init(SEQ, DFF, 1, G, bid);
        EpiUpf E{Ab, PART2}; pg8::gemm_phase(lds, g, S_, E, tid); }
    if constexpr (PH == 7) { pg8::Gemm g{Ab, WDN, SEQ, DM, DFF, DFF, DFF, 1, 0, 0}; pg8::Order S_; S_.init(SEQ, DM, 1, G, bid);
        EpiDownNormF E{p.in[4], X1, PART1, xb}; pg8::gemm_phase(lds, g, S_, E, tid); }
}

constexpr int LDS_BYTES = 147456;

#ifndef TPROBE
#define TPROBE -1
#endif
template <int PH>
__device__ __forceinline__ void run_all(const P& p, LAS unsigned char* lds, cg::grid_group& grid, const XcdBarrier& xb, volatile LAS unsigned* misc) {
    if constexpr (PH == PROBE_PH) { run_phase<PH, 0>(p, lds, xb); xcd_barrier(xb); }
    run_phase<PH>(p, lds, xb);
    if constexpr (PH + 1 < NPHASE) {
        if constexpr (PH == 0) { if (p.use_cg_sync) grid.sync(); else xcd_barrier(xb); } else xcd_barrier(xb);
        if constexpr (TPROBE >= 0) { if (blockIdx.x == 0 && threadIdx.x == 0) misc[4 + PH + 1] = (unsigned)__builtin_amdgcn_s_memrealtime(); }
        run_all<PH + 1>(p, lds, grid, xb, misc);
    }
}
__global__ void __launch_bounds__(512, 2) k_all(P p) {
    extern __shared__ __attribute__((aligned(16))) unsigned char lds_raw[];
    cg::grid_group grid = cg::this_grid();
    LAS unsigned char* lds = (LAS unsigned char*)lds_raw;
    volatile LAS unsigned* misc = (volatile LAS unsigned*)(lds + 131072);
    if (threadIdx.x < 2) misc[threadIdx.x] = 0u;
    __syncthreads();
    const XcdBarrier xb = xcd_barrier_post((unsigned*)(p.ws + WS_CTL), misc);
    if constexpr (TPROBE >= 0) { if (blockIdx.x == 0 && threadIdx.x == 0) misc[4] = (unsigned)__builtin_amdgcn_s_memrealtime(); }
    run_all<0>(p, lds, grid, xb, misc);
    if constexpr (TPROBE >= 0) {
        if (blockIdx.x == 0 && threadIdx.x == 0) {
            const unsigned now = (unsigned)__builtin_amdgcn_s_memrealtime(); misc[4 + NPHASE] = now;
            const unsigned d = misc[4 + TPROBE + 1] - misc[4 + TPROBE];
            while ((unsigned)__builtin_amdgcn_s_memrealtime() - now < 8u * d) __builtin_amdgcn_s_sleep(8);
        }
    }
}

extern "C" void kernel_launch(void* const* d_in, const int* in_sizes, int n_in, void* d_out, int out_size, void* d_ws, size_t ws_size, hipStream_t stream) {
    static int grid = 0;
    if (grid == 0) {
        if (n_in != 20 || out_size != SEQ * DM || ws_size < WS_END) { fprintf(stderr, "kernel_launch: unexpected shapes (n_in %d out %d ws %zu)\n", n_in, out_size, ws_size); grid = -1; return; }
        int dev = 0, cus = 0;
        (void)hipGetDevice(&dev); (void)hipDeviceGetAttribute(&cus, hipDeviceAttributeMultiprocessorCount, dev);
        (void)hipFuncSetAttribute((const void*)k_all, hipFuncAttributeMaxDynamicSharedMemorySize, LDS_BYTES);
        int per_cu = 0;
        (void)hipOccupancyMaxActiveBlocksPerMultiprocessor(&per_cu, (const void*)k_all, 512, LDS_BYTES);
        if (per_cu < 1) fprintf(stderr, "kernel_launch: occupancy query says %d blocks/CU\n", per_cu);
        (void)hipGetLastError();
        if (cus != 256) { fprintf(stderr, "kernel_launch: built for a 256-CU device (one 512-thread workgroup per CU, one 256x256 tile per workgroup in the fused-norm GEMM phases); found %d CUs\n", cus); grid = -1; return; }
        grid = cus;
    }
    if (grid < 0) return;
    P p{};
    for (int i = 0; i < 20; ++i) p.in[i] = (const float*)d_in[i];
    p.out = (float*)d_out; p.ws = (unsigned char*)d_ws;
    (void)hipMemsetAsync((char*)d_ws + WS_CTL, 0, CTL_BYTES, stream);
    void* args[] = {&p};
    hipError_t e = hipLaunchCooperativeKernel((const void*)k_all, dim3(grid), dim3(512), args, LDS_BYTES, stream);
    if (e != hipSuccess) fprintf(stderr, "cooperative launch failed: %s (grid %d)\n", hipGetErrorString(e), grid);
}
```

```cpp
#include <hip/hip_runtime.h>
#include <hip/hip_cooperative_groups.h>
#include <cstdio>
#include <cstdint>
namespace cg = cooperative_groups;


typedef unsigned short bf16_t;
typedef float f32x4 __attribute__((ext_vector_type(4)));
typedef unsigned u32x2 __attribute__((ext_vector_type(2)));
typedef unsigned u32x4 __attribute__((ext_vector_type(4)));
#define LAS __attribute__((address_space(3)))

constexpr int SEQ = 8192, DM = 2048, INW = 6400, QW = 1024, SSMW = 1024, DFF = 8192;
constexpr int NG = 64, GC = 16, SP = 64, NH = 16;
constexpr size_t MiB = 1u << 20;
constexpr size_t WS_AP = 0, WS_BBAR = 1 * MiB, WS_ROPE = 1 * MiB + 512 * 1024, WS_CTL = 2 * MiB, CTL_BYTES = 16384, WS_PART1 = 3 * MiB, WS_PART2 = 0;
constexpr size_t WS_WUP = 4 * MiB, WS_WDN = 36 * MiB, WS_WIN = 68 * MiB, WS_WGLU = 93 * MiB, WS_WBRA = 97 * MiB, WS_WBRS = 101 * MiB, WS_WOUT = 105 * MiB;
constexpr size_t WS_H = 113 * MiB, WS_OSSM = 113 * MiB  , WS_Q = 145 * MiB, WS_OATT = 145 * MiB  , WS_K = 161 * MiB, WS_VT = 163 * MiB, WS_AX = 165 * MiB, WS_Y = 189 * MiB;
constexpr size_t WS_M = 161 * MiB, WS_GA = 205 * MiB, WS_GS = 237 * MiB, WS_MIXED = 205 * MiB, WS_H2 = 68 * MiB, WS_A = 141 * MiB, WS_DN = 68 * MiB, WS_END = 269 * MiB;
constexpr size_t DO_S = 0, DO_KTAB = 16 * MiB, DO_BC = 17 * MiB, DO_YB = 25 * MiB;
constexpr int NAP = 18;

struct P {
    const float* in[20];
    float* out;
    unsigned char* ws;
    unsigned long long use_cg_sync;
};

__device__ __forceinline__ float bf2f(unsigned v) { return __uint_as_float(v << 16); }
__device__ __forceinline__ unsigned f2bf(float f) { unsigned u = __float_as_uint(f); return (u + 0x7fffu + ((u >> 16) & 1u)) >> 16; }
__device__ __forceinline__ unsigned pk2(float lo, float hi) { return f2bf(lo) | (f2bf(hi) << 16); }
__device__ __forceinline__ float wave_sum(float v) {
#pragma unroll
    for (int o = 1; o < 64; o <<= 1) v += __shfl_xor(v, o);
    return v;
}
__device__ __forceinline__ float wave_max(float v) {
#pragma unroll
    for (int o = 1; o < 64; o <<= 1) v = fmaxf(v, __shfl_xor(v, o));
    return v;
}
__device__ __forceinline__ float sigmoidf_(float v) { return __builtin_amdgcn_rcpf(1.0f + __expf(-v)); }
__device__ __forceinline__ float gelu_tanh(float v) {
    const float z2 = 1.5957691216057308f * (v + 0.044715f * v * v * v);
    return v * __builtin_amdgcn_rcpf(1.0f + __expf(-z2));
}
__device__ __forceinline__ void sincos_d(double ang, float& s, float& c) {
    double rev = ang * 0.15915494309189535; rev -= rint(rev);
    const double q4 = rev * 4.0, qr = rint(q4); const int q = ((int)qr) & 3;
    const double th = (q4 - qr) * 1.5707963267948966, t2 = th * th;
    const double sn = th * (1.0 + t2 * (-1.0 / 6 + t2 * (1.0 / 120 + t2 * (-1.0 / 5040 + t2 * (1.0 / 362880 + t2 * (-1.0 / 39916800 + t2 * (1.0 / 6227020800.0)))))));
    const double cs = 1.0 + t2 * (-0.5 + t2 * (1.0 / 24 + t2 * (-1.0 / 720 + t2 * (1.0 / 40320 + t2 * (-1.0 / 3628800 + t2 * (1.0 / 479001600.0 + t2 * (-1.0 / 87178291200.0)))))));
    const double so = (q == 0) ? sn : (q == 1) ? cs : (q == 2) ? -sn : -cs;
    const double co = (q == 0) ? cs : (q == 1) ? -sn : (q == 2) ? -cs : sn;
    s = (float)so; c = (float)co;
}

struct TItem { const float* W; bf16_t* WT; int N, ldk, k0, n0, drow0; };
constexpr int TI_IN = 32 * 200, TI_GLU = 16 * 64, TI_BR = 16 * 64, TI_OUT = 32 * 64, TI_UP = 32 * 256, TI_DN = 128 * 64;
constexpr int TI_P0 = TI_IN + TI_GLU + 2 * TI_BR + TI_OUT, TI_ALL = TI_P0 + TI_UP + TI_DN;
__device__ __forceinline__ void tdecode(int r, int ncols, int& kb, int& nb) { const int st = r >> 5, c = r & 31, sn = ncols >> 8; kb = 4 * (st / sn) + (c & 3); nb = 8 * (st % sn) + (c >> 2); }
__device__ __forceinline__ TItem titem(const P& p, int r) {
    unsigned char* ws = p.ws; TItem t; int kb, nb;
    if (r < TI_IN) { tdecode(r, INW, kb, nb); t = TItem{p.in[5], (bf16_t*)(ws + WS_WIN), INW, 2048, 64 * kb, 32 * nb, 32 * nb}; return t; } r -= TI_IN;
    if (r < TI_GLU) { tdecode(r, 2048, kb, nb); const int n0 = 32 * nb, bj = n0 >> 10, j = n0 & 1023, tt = j >> 7, jj = j & 127;
        t = TItem{p.in[15], (bf16_t*)(ws + WS_WGLU), 2048, 1024, 64 * kb, n0, 256 * tt + 128 * bj + jj}; return t; } r -= TI_GLU;
    if (r < TI_BR) { tdecode(r, 2048, kb, nb); t = TItem{p.in[16], (bf16_t*)(ws + WS_WBRA), 2048, 1024, 64 * kb, 32 * nb, 32 * nb}; return t; } r -= TI_BR;
    if (r < TI_BR) { tdecode(r, 2048, kb, nb); t = TItem{p.in[16] + (size_t)1024 * 2048, (bf16_t*)(ws + WS_WBRS), 2048, 1024, 64 * kb, 32 * nb, 32 * nb}; return t; } r -= TI_BR;
    if (r < TI_OUT) { tdecode(r, 2048, kb, nb); t = TItem{p.in[17], (bf16_t*)(ws + WS_WOUT), 2048, 2048, 64 * kb, 32 * nb, 32 * nb}; return t; } r -= TI_OUT;
    if (r < TI_UP) { tdecode(r, DFF, kb, nb); t = TItem{p.in[18], (bf16_t*)(ws + WS_WUP), DFF, 2048, 64 * kb, 32 * nb, 32 * nb}; return t; } r -= TI_UP;
    { tdecode(r, 2048, kb, nb); t = TItem{p.in[19], (bf16_t*)(ws + WS_WDN), 2048, DFF, 64 * kb, 32 * nb, 32 * nb}; return t; }
}
__device__ __forceinline__ void titem_load(const TItem& t, f32x4 (&v)[8], int lane) {
#pragma unroll
    for (int i = 0; i < 8; ++i) v[i] = __builtin_nontemporal_load((const f32x4*)(t.W + (size_t)(t.k0 + 8 * i + (lane >> 3)) * t.N + t.n0 + (lane & 7) * 4));
}
__device__ __forceinline__ void transpose_quad(const P& p, int i0, LAS float* scr, int lane) {
    TItem t[4]; f32x4 v[4][8];
#pragma unroll
    for (int q = 0; q < 4; ++q) { t[q] = titem(p, i0 + q); titem_load(t[q], v[q], lane); }
#pragma unroll
    for (int q = 0; q < 4; ++q) {
#pragma unroll
        for (int i = 0; i < 8; ++i) { LAS float* d = scr + (8 * i + (lane >> 3)) * 33 + (lane & 7) * 4; d[0] = v[q][i].x; d[1] = v[q][i].y; d[2] = v[q][i].z; d[3] = v[q][i].w; }
        asm volatile("s_waitcnt lgkmcnt(0)" ::: "memory");
        const int c = lane & 7;
#pragma unroll
        for (int j = 0; j < 4; ++j) { const int n = (lane >> 3) + 8 * j; const LAS float* sp = scr + (8 * c) * 33 + n;
            u32x4 o; o.x = pk2(sp[0 * 33], sp[1 * 33]); o.y = pk2(sp[2 * 33], sp[3 * 33]); o.z = pk2(sp[4 * 33], sp[5 * 33]); o.w = pk2(sp[6 * 33], sp[7 * 33]);
            *(u32x4*)(t[q].WT + (size_t)(t[q].drow0 + n) * t[q].ldk + t[q].k0 + 8 * c) = o; }
        asm volatile("s_waitcnt lgkmcnt(0)" ::: "memory");
    }
}
namespace pg8 {
typedef short bf16x8 __attribute__((ext_vector_type(8)));
constexpr int BM = 256, BK = 64, HALF = 128, HTB = HALF * BK * 2, STAGE_BYTES = 8 * HTB, NXCD = 8, WGM = 8;
__device__ __forceinline__ int lds_byte(int r, int c) { const int st = (r >> 4) * 2 + (c >> 5), rr = r & 15, cc = c & 31, ob = rr * 64 + cc * 2; return st * 1024 + (ob ^ (((ob >> 9) & 1) << 5)); }
__device__ __forceinline__ void stage_rc(int b, int& R, int& C) { const int st = b / 1024, sb = b % 1024, swz = sb ^ (((sb >> 9) & 1) << 5); R = (st >> 1) * 16 + swz / 64; C = (st & 1) * 32 + (swz % 64) / 2; }
__device__ __forceinline__ int perm32(int rho) { const int n = rho >> 4, i = rho & 15; return 8 * (i >> 2) + 4 * n + (i & 3); }

struct Unit { int pm, pn, b; };
struct Gemm { const bf16_t* A; const bf16_t* Bt; int M, N, K, lda, ldb, nb; size_t sA, sB; };

struct Order {
    int nM, nN, nwg, nb, G, c, maxi, base;
    __device__ void init(int M, int N, int nb_, int G_, int c_, int maxi_ = (1 << 30), int base_ = 0) { nM = M / BM; nN = N / BM; nwg = nM * nN; nb = nb_; G = G_; c = c_; maxi = maxi_; base = base_; }
    __device__ bool next(int i, Unit& u) const {
        if (i >= maxi) return false;
        const long L = (long)base + (long)i * G + c; if (L >= (long)nwg * nb) return false;
        u.b = (int)(L / nwg); int wgid = (int)(L % nwg);
        { const int q = nwg / NXCD, r = nwg % NXCD, xcd = wgid % NXCD, off = wgid / NXCD; wgid = (xcd < r ? xcd * (q + 1) : r * (q + 1) + (xcd - r) * q) + off; }
        const int nig = WGM * nN, gid = wgid / nig, fm = gid * WGM, gsz = (nM - fm) < WGM ? (nM - fm) : WGM;
        u.pm = fm + ((wgid % nig) % gsz); u.pn = (wgid % nig) / gsz; return true;
    }
};

template <class Epi>
__device__ __forceinline__ void gemm_phase(LAS unsigned char* lds, const Gemm g, const Order& S, const Epi& E, const int tid) {
    const int wid = __builtin_amdgcn_readfirstlane(tid >> 6), lane = tid & 63, wr = wid >> 2, wc = wid & 3, fr = lane & 15, fq = lane >> 4;
    int K_ = g.K; asm volatile("" : "+s"(K_));
    const int nt = K_ / BK;
    unsigned voffA[2], voffB[2];
#pragma unroll
    for (int i = 0; i < 2; ++i) { int R, C; stage_rc(tid * 16 + i * 8192, R, C); const int Rb = Epi::PERM ? ((R & ~31) + perm32(R & 31)) : R;
        voffA[i] = (unsigned)(R * g.lda + C) * 2u; voffB[i] = (unsigned)(Rb * g.ldb + C) * 2u; }
    const size_t kstep = (size_t)(BK * 2);
    const size_t hstepA = (size_t)HALF * g.lda * 2, tstepA = 2 * hstepA, hstepB = (size_t)HALF * g.ldb * 2, tstepB = 2 * hstepB;
    const unsigned ldsw = (unsigned)wid * 1024u;
    const int aoff = lds_byte(wr * 64 + fr, fq * 8), boff = lds_byte(wc * 32 + fr, fq * 8);
#define PG8_SA(b, h) (((b) * 2 + (h)) * HTB)
#define PG8_SB(b, h) ((4 + (b) * 2 + (h)) * HTB)
#define PG8_STAGE(bufoff, gbase, voff) do { _Pragma("unroll") for (int _i = 0; _i < 2; ++_i) \
        __builtin_amdgcn_global_load_lds((const unsigned*)((const char*)(gbase) + (voff)[_i]), (LAS unsigned*)(lds + (bufoff) + ldsw + _i * 8192), 16, 0, 0); } while (0)
#define PG8_LDA(dst, b, h) do { _Pragma("unroll") for (int m = 0; m < 4; ++m) _Pragma("unroll") for (int k = 0; k < 2; ++k) dst[m][k] = *(const LAS bf16x8*)(lds + PG8_SA(b, h) + aoff + m * 2048 + k * 1024); } while (0)
#define PG8_LDB(dst, b, h) do { _Pragma("unroll") for (int n = 0; n < 2; ++n) _Pragma("unroll") for (int k = 0; k < 2; ++k) dst[n][k] = *(const LAS bf16x8*)(lds + PG8_SB(b, h) + boff + n * 2048 + k * 1024); } while (0)
#define PG8_MMA(ai, bj, At, Bt) do { __builtin_amdgcn_s_setprio(1); _Pragma("unroll") for (int m = 0; m < 4; ++m) _Pragma("unroll") for (int n = 0; n < 2; ++n) _Pragma("unroll") for (int k = 0; k < 2; ++k) \
        acc[ai][bj][m][n] = __builtin_amdgcn_mfma_f32_16x16x32_bf16(Bt[n][k], At[m][k], acc[ai][bj][m][n], 0, 0, 0); __builtin_amdgcn_s_setprio(0); } while (0)
#define PG8_WAIT_V(n) asm volatile("s_waitcnt vmcnt(" #n ")" ::: "memory")
#define PG8_WAIT_L(n) asm volatile("s_waitcnt lgkmcnt(" #n ")" ::: "memory")
#define PG8_BAR __builtin_amdgcn_s_barrier()
#define PG8_SCHED __builtin_amdgcn_sched_barrier(0)
    Unit cur, nxt; int ui = 0;
    if (!S.next(0, cur)) return;
    f32x4 acc[2][2][4][2];
#pragma unroll
    for (int a = 0; a < 2; ++a)
#pragma unroll
        for (int b = 0; b < 2; ++b)
#pragma unroll
            for (int m = 0; m < 4; ++m)
#pragma unroll
                for (int n = 0; n < 2; ++n) acc[a][b][m][n] = (f32x4){0.f, 0.f, 0.f, 0.f};
    bf16x8 At[4][2], B0[2][2], B1[2][2];
    const char* cA = (const char*)g.A + (size_t)cur.b * g.sA * 2 + (size_t)cur.pm * tstepA; const char* cB = (const char*)g.Bt + (size_t)cur.b * g.sB * 2 + (size_t)cur.pn * tstepB;
    PG8_STAGE(PG8_SB(0, 0), cB, voffB); PG8_STAGE(PG8_SB(0, 1), cB + hstepB, voffB); PG8_STAGE(PG8_SA(0, 0), cA, voffA); PG8_STAGE(PG8_SA(0, 1), cA + hstepA, voffA);
    if (wr == 1) PG8_BAR;
    PG8_WAIT_V(2); PG8_BAR;
    PG8_STAGE(PG8_SB(1, 0), cB + kstep, voffB); PG8_STAGE(PG8_SA(1, 0), cA + kstep, voffA); PG8_STAGE(PG8_SB(1, 1), cB + hstepB + kstep, voffB);
    PG8_WAIT_V(6); PG8_BAR;
    for (;;) {
        const bool has_next = S.next(ui + 1, nxt);
        const char* nA = has_next ? (const char*)g.A + (size_t)nxt.b * g.sA * 2 + (size_t)nxt.pm * tstepA : cA;
        const char* nB = has_next ? (const char*)g.Bt + (size_t)nxt.b * g.sB * 2 + (size_t)nxt.pn * tstepB : cB;
        for (int t = 0; t < nt; t += 2) {
            const bool last = (t == nt - 2);
            const char* a1 = cA + (size_t)(t + 1) * kstep;
            const char* a2 = last ? nA : cA + (size_t)(t + 2) * kstep; const char* b2 = last ? nB : cB + (size_t)(t + 2) * kstep;
            const char* a3 = a2 + kstep; const char* b3 = b2 + kstep;
            PG8_LDB(B0, 0, 0); PG8_LDB(B1, 0, 1); PG8_SCHED; PG8_LDA(At, 0, 0); PG8_STAGE(PG8_SA(1, 1), a1 + hstepA, voffA);
            PG8_WAIT_V(8); PG8_WAIT_L(0); PG8_BAR; PG8_MMA(0, 0, At, B0); PG8_MMA(0, 1, At, B1); PG8_BAR; PG8_SCHED;
            PG8_LDA(At, 0, 1); PG8_STAGE(PG8_SB(0, 0), b2, voffB); PG8_STAGE(PG8_SB(0, 1), b2 + hstepB, voffB); PG8_STAGE(PG8_SA(0, 0), a2, voffA);
            PG8_WAIT_V(8); PG8_WAIT_L(0); PG8_BAR; PG8_MMA(1, 0, At, B0); PG8_MMA(1, 1, At, B1); PG8_BAR; PG8_SCHED;
            PG8_LDB(B0, 1, 0); PG8_LDB(B1, 1, 1); PG8_SCHED; PG8_LDA(At, 1, 0); PG8_STAGE(PG8_SA(0, 1), a2 + hstepA, voffA);
            PG8_WAIT_V(8); PG8_WAIT_L(0); PG8_BAR; PG8_MMA(0, 0, At, B0); PG8_MMA(0, 1, At, B1); PG8_BAR; PG8_SCHED;
            PG8_LDA(At, 1, 1); PG8_STAGE(PG8_SB(1, 0), b3, voffB); PG8_STAGE(PG8_SB(1, 1), b3 + hstepB, voffB); PG8_STAGE(PG8_SA(1, 0), a3, voffA);
            PG8_WAIT_V(8); PG8_WAIT_L(0); PG8_BAR; PG8_MMA(1, 0, At, B0); PG8_MMA(1, 1, At, B1); PG8_BAR; PG8_SCHED;
        }
        if (wr == 0) PG8_BAR;
        if constexpr (Epi::FUSED) E.fused(acc, cur, wr, wc, fr, fq); else E(acc, cur, wr, wc, fr, fq);
        if (!has_next) break;
        if (!(Epi::CHAIN && cur.b == 0)) {
#pragma unroll
        for (int a = 0; a < 2; ++a)
#pragma unroll
            for (int b = 0; b < 2; ++b)
#pragma unroll
                for (int m = 0; m < 4; ++m)
#pragma unroll
                    for (int n = 0; n < 2; ++n) acc[a][b][m][n] = (f32x4){0.f, 0.f, 0.f, 0.f};
        }
        cur = nxt; cA = nA; cB = nB; ++ui;
        if (wr == 1) PG8_BAR;
    }
    PG8_WAIT_V(0);
    PG8_BAR;
#undef PG8_SA
#undef PG8_SB
#undef PG8_STAGE
#undef PG8_LDA
#undef PG8_LDB
#undef PG8_MMA
#undef PG8_WAIT_V
#undef PG8_WAIT_L
#undef PG8_BAR
#undef PG8_SCHED
}
}

#define XB_TMO      128
#define XB_XCNT(j)  (256  + 64 * (j))
#define XB_XSUB(j)  (1280 + 64 * (j))
#define XB_XGEN(j)  (2304 + 64 * (j))
#define XB_TOP      3328
#define XB_TOPGEN   3392
#define XCD_BAR_WORDS 3456
#define XB_SPIN_CAP (1u << 22)
__device__ __forceinline__ unsigned xb_ld(unsigned* p)              { return __hip_atomic_load(p, __ATOMIC_RELAXED, __HIP_MEMORY_SCOPE_AGENT); }
__device__ __forceinline__ unsigned xb_add(unsigned* p, unsigned v) { return __hip_atomic_fetch_add(p, v, __ATOMIC_RELAXED, __HIP_MEMORY_SCOPE_AGENT); }
__device__ __forceinline__ unsigned xb_xcc_id() { return (unsigned)__builtin_amdgcn_s_getreg((3 << 11) | 20) & 0xFu; }
#define XB_SPIN(cond, bar) do { unsigned _sp = 0; while (cond) { __builtin_amdgcn_s_sleep(1); \
    if ((++_sp & 255u) == 0u) { if (xb_ld(&(bar)[XB_TMO])) break; if (_sp > XB_SPIN_CAP) { atomicAdd(&(bar)[XB_TMO], 1u); break; } } } } while (0)
struct XcdBarrier { unsigned* bar; unsigned x; volatile LAS unsigned* st; };
__device__ __forceinline__ XcdBarrier xcd_barrier_post(unsigned* bar, volatile LAS unsigned* st) {
    XcdBarrier b; b.bar = bar; b.x = xb_xcc_id(); b.st = st;
    if (threadIdx.x == 0) (void)xb_add(&bar[XB_XCNT(b.x)], 1u);
    return b;
}
__device__ __forceinline__ void xcd_barrier_complete(unsigned* bar, unsigned x, unsigned& nloc, unsigned& nx) {
    const unsigned G = gridDim.x * gridDim.y * gridDim.z;
    unsigned sum, cnt, mine, sp = 0u;
    for (;;) {
        sum = 0u; cnt = 0u; mine = 0u;
#pragma unroll
        for (unsigned j = 0; j < 16; ++j) { const unsigned c = xb_ld(&bar[XB_XCNT(j)]); sum += c; cnt += (c > 0u) ? 1u : 0u; mine = (j == x) ? c : mine; }
        if (sum == G) break;
        __builtin_amdgcn_s_sleep(1);
        if ((++sp & 255u) == 0u) { if (xb_ld(&bar[XB_TMO])) break; if (sp > XB_SPIN_CAP) { atomicAdd(&bar[XB_TMO], 1u); break; } }
    }
    nloc = mine > 0u ? mine : 1u; nx = cnt > 0u ? cnt : 1u;
}
__device__ __forceinline__ void xcd_barrier(const XcdBarrier& b) {
    asm volatile("s_waitcnt vmcnt(0)" ::: "memory");
    __syncthreads();
    if (threadIdx.x == 0) {
        unsigned* bar = b.bar;
        __builtin_amdgcn_s_waitcnt(0);
        unsigned nloc = b.st[0], nx = b.st[1];
        if (nloc == 0u) { xcd_barrier_complete(bar, b.x, nloc, nx); b.st[0] = nloc; b.st[1] = nx; }
        const unsigned old = xb_add(&bar[XB_XSUB(b.x)], 1u);
        const unsigned gen = old / nloc;
        if (old + 1u == (gen + 1u) * nloc) {
            __builtin_amdgcn_fence(__ATOMIC_RELEASE, "agent");
            asm volatile("s_waitcnt vmcnt(0)" ::: "memory");
            const unsigned og = xb_add(&bar[XB_TOP], 1u);
            const unsigned tg = og / nx;
            if (og + 1u == (tg + 1u) * nx) xb_add(&bar[XB_TOPGEN], 1u);
            else XB_SPIN(xb_ld(&bar[XB_TOPGEN]) == tg, bar);
            __builtin_amdgcn_fence(__ATOMIC_ACQUIRE, "agent");
            xb_add(&bar[XB_XGEN(b.x)], 1u);
            asm volatile("s_waitcnt vmcnt(0)" ::: "memory");
        } else {
            XB_SPIN(xb_ld(&bar[XB_XGEN(b.x)]) == gen, bar);
            __builtin_amdgcn_fence(__ATOMIC_ACQUIRE, "agent");
            asm volatile("s_waitcnt vmcnt(0)" ::: "memory");
        }
    }
    __syncthreads();
}

typedef f32x4 acc_t[2][2][4][2];
#define EPI_ROW(ai, m) (u.pm * 256 + (ai) * 128 + wr * 64 + (m) * 16 + fr)
__device__ __forceinline__ u32x4 pack8(const f32x4 a, const f32x4 b) { u32x4 w; w.x = pk2(a.x, a.y); w.y = pk2(a.z, a.w); w.z = pk2(b.x, b.y); w.w = pk2(b.z, b.w); return w; }
__device__ __forceinline__ f32x4 sig4(const f32x4 v) { f32x4 o; o.x = sigmoidf_(v.x); o.y = sigmoidf_(v.y); o.z = sigmoidf_(v.z); o.w = sigmoidf_(v.w); return o; }

struct EpiZf {
    static constexpr bool PERM = true, FUSED = false, CHAIN = false;
    bf16_t *q, *k, *vT, *ax, *ga, *gs; const float* rope;
    __device__ __forceinline__ void operator()(const acc_t& acc, const pg8::Unit& u, int wr, int wc, int fr, int fq) const {
        const int pn = u.pn;
#pragma unroll
        for (int ai = 0; ai < 2; ++ai)
#pragma unroll
            for (int m = 0; m < 4; ++m) {
                const int row = EPI_ROW(ai, m);
#pragma unroll
                for (int bj = 0; bj < 2; ++bj) {
                    f32x4 v0 = acc[ai][bj][m][0], v1 = acc[ai][bj][m][1];
                    const int cl = bj * 128 + wc * 32 + 8 * fq;
                    if (pn < 4 || (pn == 4 && bj == 0)) {
                        if ((wc & 1) == 0) {
                            f32x4 p0, p1;
                            p0.x = __shfl_xor(v0.x, 16); p0.y = __shfl_xor(v0.y, 16); p0.z = __shfl_xor(v0.z, 16); p0.w = __shfl_xor(v0.w, 16);
                            p1.x = __shfl_xor(v1.x, 16); p1.y = __shfl_xor(v1.y, 16); p1.z = __shfl_xor(v1.z, 16); p1.w = __shfl_xor(v1.w, 16);
                            if (fq < 2) {
                                const f32x4* rp = (const f32x4*)(rope + (size_t)row * 16);
                                const f32x4 r0 = rp[0], r1 = rp[1], r2 = rp[2], r3 = rp[3];
                                const float sg = (fq == 0) ? -1.f : 1.f;
                                v0.x = v0.x * r0.x + sg * p0.x * r0.y; v0.y = v0.y * r0.z + sg * p0.y * r0.w;
                                v0.z = v0.z * r1.x + sg * p0.z * r1.y; v0.w = v0.w * r1.z + sg * p0.w * r1.w;
                                v1.x = v1.x * r2.x + sg * p1.x * r2.y; v1.y = v1.y * r2.z + sg * p1.y * r2.w;
                                v1.z = v1.z * r3.x + sg * p1.z * r3.y; v1.w = v1.w * r3.z + sg * p1.w * r3.w;
                            }
                        }
                        bf16_t* dst = (pn < 4) ? (q + (size_t)row * 1024 + pn * 256 + cl) : (k + (size_t)row * 128 + cl);
                        *(u32x4*)dst = pack8(v0, v1);
                    } else if (pn == 4) {
                        bf16_t* dst = vT + (size_t)(cl - 128) * SEQ + row;
                        dst[0 * (size_t)SEQ] = (bf16_t)f2bf(v0.x); dst[1 * (size_t)SEQ] = (bf16_t)f2bf(v0.y); dst[2 * (size_t)SEQ] = (bf16_t)f2bf(v0.z); dst[3 * (size_t)SEQ] = (bf16_t)f2bf(v0.w);
                        dst[4 * (size_t)SEQ] = (bf16_t)f2bf(v1.x); dst[5 * (size_t)SEQ] = (bf16_t)f2bf(v1.y); dst[6 * (size_t)SEQ] = (bf16_t)f2bf(v1.z); dst[7 * (size_t)SEQ] = (bf16_t)f2bf(v1.w);
                    } else if (pn < 9) {
                        const int c = (pn - 5) * 256 + cl, g = c >> 4, ci0 = c & 15;
                        *(u32x4*)(ax + ((size_t)g * 512 + (row >> 4)) * 384 + (row & 15) * 16 + ci0) = pack8(v0, v1);
                    } else if (pn < 17) {
                        *(u32x4*)(ga + (size_t)row * 2048 + (pn - 9) * 256 + cl) = pack8(sig4(v0), sig4(v1));
                    } else {
                        *(u32x4*)(gs + (size_t)row * 2048 + (pn - 17) * 256 + cl) = pack8(sig4(v0), sig4(v1));
                    }
                }
            }
    }
};
struct EpiSf {
    static constexpr bool PERM = false, FUSED = false, CHAIN = false; float* S;
    __device__ __forceinline__ void operator()(const acc_t& acc, const pg8::Unit& u, int wr, int wc, int fr, int fq) const {
#pragma unroll
        for (int ai = 0; ai < 2; ++ai)
#pragma unroll
            for (int m = 0; m < 4; ++m) { const int row = EPI_ROW(ai, m);
#pragma unroll
                for (int n = 0; n < 2; ++n) *(f32x4*)(S + ((size_t)u.b * 512 + row) * 128 + wc * 32 + 16 * n + 4 * fq) = acc[ai][0][m][n]; }
    }
};
struct EpiYf {
    static constexpr bool PERM = true, FUSED = false, CHAIN = false; bf16_t* y;
    __device__ __forceinline__ void operator()(const acc_t& acc, const pg8::Unit& u, int wr, int wc, int fr, int fq) const {
#pragma unroll
        for (int ai = 0; ai < 2; ++ai)
#pragma unroll
            for (int m = 0; m < 4; ++m) { const int row = EPI_ROW(ai, m);
#pragma unroll
                for (int bj = 0; bj < 2; ++bj) { const int c = bj * 128 + wc * 32 + 8 * fq, t = c >> 4, co0 = c & 15;
                    const f32x4 a0 = acc[ai][bj][m][0], a1 = acc[ai][bj][m][1];
                    u32x4 w; w.x = pk2(gelu_tanh(a0.x), gelu_tanh(a0.y)); w.y = pk2(gelu_tanh(a0.z), gelu_tanh(a0.w)); w.z = pk2(gelu_tanh(a1.x), gelu_tanh(a1.y)); w.w = pk2(gelu_tanh(a1.z), gelu_tanh(a1.w));
                    *(u32x4*)(y + (unsigned)((row * 16 + t) * 1024 + u.b * 16 + co0)) = w;
                    asm volatile("" ::: "memory"); } }
    }
};
struct EpiGLUf {
    static constexpr bool PERM = true, FUSED = false, CHAIN = false; bf16_t* o;
    __device__ __forceinline__ void operator()(const acc_t& acc, const pg8::Unit& u, int wr, int wc, int fr, int fq) const {
#pragma unroll
        for (int ai = 0; ai < 2; ++ai)
#pragma unroll
            for (int m = 0; m < 4; ++m) { const int row = EPI_ROW(ai, m);
                const f32x4 v0 = acc[ai][0][m][0] * sig4(acc[ai][1][m][0]), v1 = acc[ai][0][m][1] * sig4(acc[ai][1][m][1]);
                *(u32x4*)(o + (size_t)row * 1024 + u.pn * 128 + wc * 32 + 8 * fq) = pack8(v0, v1); }
    }
};
__device__ __forceinline__ void ld_bf8(const bf16_t* p, f32x4& lo, f32x4& hi) { const u32x4 w = *(const u32x4*)p;
    lo.x = bf2f(w.x & 0xffffu); lo.y = bf2f(w.x >> 16); lo.z = bf2f(w.y & 0xffffu); lo.w = bf2f(w.y >> 16); hi.x = bf2f(w.z & 0xffffu); hi.y = bf2f(w.z >> 16); hi.z = bf2f(w.w & 0xffffu); hi.w = bf2f(w.w >> 16); }
__device__ __forceinline__ void ld_bf8_nt(const bf16_t* p, f32x4& lo, f32x4& hi) { const u32x4 w = __builtin_nontemporal_load((const u32x4*)p);
    lo.x = bf2f(w.x & 0xffffu); lo.y = bf2f(w.x >> 16); lo.z = bf2f(w.y & 0xffffu); lo.w = bf2f(w.y >> 16); hi.x = bf2f(w.z & 0xffffu); hi.y = bf2f(w.z >> 16); hi.z = bf2f(w.w & 0xffffu); hi.w = bf2f(w.w >> 16); }
__device__ __forceinline__ void unpk8(const u32x4 w, f32x4& lo, f32x4& hi) {
    lo.x = bf2f(w.x & 0xffffu); lo.y = bf2f(w.x >> 16); lo.z = bf2f(w.y & 0xffffu); lo.w = bf2f(w.y >> 16); hi.x = bf2f(w.z & 0xffffu); hi.y = bf2f(w.z >> 16); hi.z = bf2f(w.w & 0xffffu); hi.w = bf2f(w.w >> 16); }
struct EpiBrF {
    static constexpr bool PERM = true, FUSED = true, CHAIN = true; const bf16_t* ga; const bf16_t* gs; bf16_t* mo;
    __device__ __forceinline__ void fused(acc_t& acc, const pg8::Unit& u, int wr, int wc, int fr, int fq) const {
        const bool first = (u.b == 0);
        const unsigned cb = (unsigned)(u.pn * 256 + wc * 32 + 8 * fq);
        u32x4 cs[2], ca[2], ns[2], na[2];
#pragma unroll
        for (int bj = 0; bj < 2; ++bj) { const unsigned o = (unsigned)(EPI_ROW(0, 0) * 2048) + cb + bj * 128;
            cs[bj] = first ? *(const u32x4*)(gs + o) : __builtin_nontemporal_load((const u32x4*)(gs + o)); ca[bj] = cs[bj]; if (first) ca[bj] = __builtin_nontemporal_load((const u32x4*)(ga + o)); }
#pragma unroll
        for (int grp = 0; grp < 8; ++grp) { const int ai = grp >> 2, m = grp & 3;
            if (grp < 7) {
#pragma unroll
                for (int bj = 0; bj < 2; ++bj) { const unsigned o = (unsigned)(EPI_ROW((grp + 1) >> 2, (grp + 1) & 3) * 2048) + cb + bj * 128;
                    ns[bj] = first ? *(const u32x4*)(gs + o) : __builtin_nontemporal_load((const u32x4*)(gs + o)); na[bj] = ns[bj]; if (first) na[bj] = __builtin_nontemporal_load((const u32x4*)(ga + o)); } }
#pragma unroll
            for (int bj = 0; bj < 2; ++bj) { const unsigned o = (unsigned)(EPI_ROW(ai, m) * 2048) + cb + bj * 128; f32x4 s0, s1; unpk8(cs[bj], s0, s1);
                if (first) { f32x4 a0, a1; unpk8(ca[bj], a0, a1);
                    f32x4 r0, r1; r0.x = a0.x * __builtin_amdgcn_rcpf(fmaxf(s0.x, 1e-30f)); r0.y = a0.y * __builtin_amdgcn_rcpf(fmaxf(s0.y, 1e-30f)); r0.z = a0.z * __builtin_amdgcn_rcpf(fmaxf(s0.z, 1e-30f)); r0.w = a0.w * __builtin_amdgcn_rcpf(fmaxf(s0.w, 1e-30f));
                    r1.x = a1.x * __builtin_amdgcn_rcpf(fmaxf(s1.x, 1e-30f)); r1.y = a1.y * __builtin_amdgcn_rcpf(fmaxf(s1.y, 1e-30f)); r1.z = a1.z * __builtin_amdgcn_rcpf(fmaxf(s1.z, 1e-30f)); r1.w = a1.w * __builtin_amdgcn_rcpf(fmaxf(s1.w, 1e-30f));
                    acc[ai][bj][m][0] = acc[ai][bj][m][0] * r0; acc[ai][bj][m][1] = acc[ai][bj][m][1] * r1; }
                else *(u32x4*)(mo + o) = pack8(acc[ai][bj][m][0] * s0, acc[ai][bj][m][1] * s1); }
#pragma unroll
            for (int bj = 0; bj < 2; ++bj) { cs[bj] = ns[bj]; ca[bj] = na[bj]; }
        }
    }
};
struct EpiUpf {
    static constexpr bool PERM = true, FUSED = false, CHAIN = false; bf16_t* a; const float* part2;
    __device__ __forceinline__ void operator()(const acc_t& acc, const pg8::Unit& u, int wr, int wc, int fr, int fq) const {
#pragma unroll
        for (int ai = 0; ai < 2; ++ai)
#pragma unroll
            for (int m = 0; m < 4; ++m) { const int row = EPI_ROW(ai, m);
                const f32x4* pp = (const f32x4*)(part2 + (size_t)row * 32 + fq * 8); const f32x4 pa = pp[0], pb = pp[1];
                float ss = ((pa.x + pa.y) + (pa.z + pa.w)) + ((pb.x + pb.y) + (pb.z + pb.w)); ss += __shfl_xor(ss, 16); ss += __shfl_xor(ss, 32);
                const float ri = rsqrtf(ss * (1.0f / DM) + 1e-6f);
#pragma unroll
                for (int bj = 0; bj < 2; ++bj) {
                    f32x4 v0 = acc[ai][bj][m][0] * ri, v1 = acc[ai][bj][m][1] * ri;
                    v0.x = fmaxf(v0.x, 0.f); v0.y = fmaxf(v0.y, 0.f); v0.z = fmaxf(v0.z, 0.f); v0.w = fmaxf(v0.w, 0.f);
                    v1.x = fmaxf(v1.x, 0.f); v1.y = fmaxf(v1.y, 0.f); v1.z = fmaxf(v1.z, 0.f); v1.w = fmaxf(v1.w, 0.f);
                    *(u32x4*)(a + (size_t)row * DFF + u.pn * 256 + bj * 128 + wc * 32 + 8 * fq) = pack8(v0 * v0, v1 * v1); } }
    }
};

__device__ __forceinline__ void row_partials(const acc_t& acc, float* part, const pg8::Unit& u, int wr, int wc, int fr, int fq) {
#pragma unroll
    for (int ai = 0; ai < 2; ++ai)
#pragma unroll
        for (int m = 0; m < 4; ++m) {
            float s = 0.f;
#pragma unroll
            for (int bj = 0; bj < 2; ++bj)
#pragma unroll
                for (int n = 0; n < 2; ++n) { const f32x4 v = acc[ai][bj][m][n]; s += (v.x * v.x + v.y * v.y) + (v.z * v.z + v.w * v.w); }
            s += __shfl_xor(s, 16); s += __shfl_xor(s, 32);
            if (fq == 0) part[(size_t)EPI_ROW(ai, m) * 32 + u.pn * 4 + wc] = s;
        }
}
__device__ __forceinline__ void row_rinv(const float* part, float (&rinv)[2][4], const pg8::Unit& u, int wr, int fr, int fq) {
#pragma unroll
    for (int ai = 0; ai < 2; ++ai)
#pragma unroll
        for (int m = 0; m < 4; ++m) {
            const f32x4* pp = (const f32x4*)(part + (size_t)EPI_ROW(ai, m) * 32 + fq * 8);
            const f32x4 a = pp[0], b = pp[1];
            float s = ((a.x + a.y) + (a.z + a.w)) + ((b.x + b.y) + (b.z + b.w));
            s += __shfl_xor(s, 16); s += __shfl_xor(s, 32);
            rinv[ai][m] = rsqrtf(s * (1.0f / DM) + 1e-6f);
        }
}
struct EpiOutNormF {
    static constexpr bool PERM = true, FUSED = true, CHAIN = false;
    const float* x; const float* g1; const float* g2; float* x1; bf16_t* h2; float* part1; float* part2; XcdBarrier xb;
    __device__ __forceinline__ void fused(acc_t& acc, const pg8::Unit& u, int wr, int wc, int fr, int fq) const {
        float rinv[2][4];
        row_partials(acc, part1, u, wr, wc, fr, fq);
        xcd_barrier(xb);
        row_rinv(part1, rinv, u, wr, fr, fq);
#pragma unroll
        for (int bj = 0; bj < 2; ++bj) { const int col = u.pn * 256 + bj * 128 + wc * 32 + 8 * fq;
            const f32x4 ga0 = *(const f32x4*)(g1 + col), ga1 = *(const f32x4*)(g1 + col + 4), gb0 = *(const f32x4*)(g2 + col), gb1 = *(const f32x4*)(g2 + col + 4);
#pragma unroll
            for (int ai = 0; ai < 2; ++ai)
#pragma unroll
              for (int mh = 0; mh < 2; ++mh) {
                f32x4 xv[2][2];
#pragma unroll
                for (int mm = 0; mm < 2; ++mm) { const unsigned o = (unsigned)(EPI_ROW(ai, 2 * mh + mm) * DM + col); xv[mm][0] = __builtin_nontemporal_load((const f32x4*)(x + o)); xv[mm][1] = __builtin_nontemporal_load((const f32x4*)(x + o + 4)); }
#pragma unroll
                for (int mm = 0; mm < 2; ++mm) { const int m = 2 * mh + mm; const unsigned o = (unsigned)(EPI_ROW(ai, m) * DM + col);
                    const f32x4 v0 = xv[mm][0] + acc[ai][bj][m][0] * rinv[ai][m] * ga0, v1 = xv[mm][1] + acc[ai][bj][m][1] * rinv[ai][m] * ga1;
                    acc[ai][bj][m][0] = v0; acc[ai][bj][m][1] = v1; *(f32x4*)(x1 + o) = v0; *(f32x4*)(x1 + o + 4) = v1; *(u32x4*)(h2 + o) = pack8(v0 * gb0, v1 * gb1); }
#pragma unroll
                for (int mm = 0; mm < 2; ++mm) asm volatile("" : "+v"(acc[ai][bj][2 * mh + mm][0]), "+v"(acc[ai][bj][2 * mh + mm][1]));
                asm volatile("" ::: "memory"); } }
        row_partials(acc, part2, u, wr, wc, fr, fq);
    }
};
struct EpiDownNormF {
    static constexpr bool PERM = true, FUSED = true, CHAIN = false;
    const float* g; float* x1; float* part; XcdBarrier xb;
    __device__ __forceinline__ void fused(acc_t& acc, const pg8::Unit& u, int wr, int wc, int fr, int fq) const {
        float rinv[2][4];
        row_partials(acc, part, u, wr, wc, fr, fq);
        xcd_barrier(xb);
        row_rinv(part, rinv, u, wr, fr, fq);
#pragma unroll
        for (int bj = 0; bj < 2; ++bj) { const int col = u.pn * 256 + bj * 128 + wc * 32 + 8 * fq;
            const f32x4 g0 = *(const f32x4*)(g + col), g1 = *(const f32x4*)(g + col + 4);
#pragma unroll
            for (int ai = 0; ai < 2; ++ai)
#pragma unroll
                for (int m = 0; m < 4; ++m) { float* o = x1 + (unsigned)(EPI_ROW(ai, m) * DM + col);
                    const f32x4 a0 = __builtin_nontemporal_load((const f32x4*)o), a1 = __builtin_nontemporal_load((const f32x4*)(o + 4));
                    __builtin_nontemporal_store(a0 + acc[ai][bj][m][0] * rinv[ai][m] * g0, (f32x4*)o); __builtin_nontemporal_store(a1 + acc[ai][bj][m][1] * rinv[ai][m] * g1, (f32x4*)(o + 4)); } }
    }
};

typedef float f32x16 __attribute__((ext_vector_type(16)));
typedef short s16x8 __attribute__((ext_vector_type(8)));
constexpr int ATT_KROW = 144, ATT_VROW = 336, ATT_VOFF = 160 * ATT_KROW;
struct AttnRegs { u32x4 k[3], v[3]; };
__device__ __forceinline__ void attn_load(AttnRegs& R, const bf16_t* Kb, const bf16_t* VT, const int q0, const int hk, const int tid) {
#pragma unroll
    for (int j = 0; j < 3; ++j) { const int c = tid + 512 * j;
        u32x4 kv = {0u, 0u, 0u, 0u}, vv = {0u, 0u, 0u, 0u};
        if (c < 1280) { const int row = c >> 3, ch = c & 7, key = q0 - 128 + row; if (key >= 0) kv = *(const u32x4*)(Kb + (size_t)key * 128 + hk * 64 + ch * 8);
            const int d = c / 20, cc = c % 20, k0 = q0 - 128 + cc * 8; if (k0 >= 0) vv = *(const u32x4*)(VT + (size_t)(hk * 64 + d) * SEQ + k0); }
        R.k[j] = kv; R.v[j] = vv; }
}
__device__ __forceinline__ void attn_store(const AttnRegs& R, LAS unsigned char* lds, const int tid) {
#pragma unroll
    for (int j = 0; j < 3; ++j) { const int c = tid + 512 * j;
        if (c < 1280) { const int row = c >> 3, ch = c & 7, d = c / 20, cc = c % 20;
            *(LAS u32x4*)(lds + row * ATT_KROW + ch * 16) = R.k[j]; *(LAS u32x4*)(lds + ATT_VOFF + d * ATT_VROW + cc * 16) = R.v[j]; } }
}
__device__ __forceinline__ void attn_item(LAS unsigned char* lds, const bf16_t* Q, bf16_t* O, const float sink, const int q0, const int h, const int lane,
                                          AttnRegs& R, const bf16_t* Kb, const bf16_t* VT, const int nq0, const int nhk, const bool pf, const int tid) {
    const int r = lane & 31, hf = lane >> 5;
    s16x8 qf[4];
#pragma unroll
    for (int kk = 0; kk < 4; ++kk) qf[kk] = *(const s16x8*)(Q + (size_t)(q0 + r) * 1024 + h * 64 + 16 * kk + 8 * hf);
    f32x16 st[5];
#pragma unroll
    for (int kt = 0; kt < 5; ++kt) {
        f32x16 a = {0.f, 0.f, 0.f, 0.f, 0.f, 0.f, 0.f, 0.f, 0.f, 0.f, 0.f, 0.f, 0.f, 0.f, 0.f, 0.f};
#pragma unroll
        for (int kk = 0; kk < 4; ++kk) {
            const s16x8 kf = *(const LAS s16x8*)(lds + (32 * kt + r) * ATT_KROW + (16 * kk + 8 * hf) * 2);
            a = __builtin_amdgcn_mfma_f32_32x32x16_bf16(kf, qf[kk], a, 0, 0, 0);
        }
        st[kt] = a;
    }
    if (pf) attn_load(R, Kb, VT, nq0, nhk, tid);
    float mx = sink;
#pragma unroll
    for (int kt = 0; kt < 5; ++kt)
#pragma unroll
        for (int e = 0; e < 16; ++e) {
            const int kofs = -128 + 32 * kt + (e & 3) + 8 * (e >> 2) + 4 * hf;
            const int diff = r - kofs;
            const bool ok = (diff >= 0) && (diff < 128) && (q0 + kofs >= 0);
            const float sv = ok ? st[kt][e] * 0.125f : -1e30f;
            st[kt][e] = sv; mx = fmaxf(mx, sv);
        }
    mx = fmaxf(mx, __shfl_xor(mx, 32));
    float sum = 0.f;
#pragma unroll
    for (int kt = 0; kt < 5; ++kt)
#pragma unroll
        for (int e = 0; e < 16; ++e) { const float pv = (st[kt][e] > -1e29f) ? __expf(st[kt][e] - mx) : 0.f; st[kt][e] = pv; sum += pv; }
    sum += __shfl_xor(sum, 32);
    sum += __expf(sink - mx);
    const float inv = 1.0f / sum;
    f32x16 o0 = {0.f, 0.f, 0.f, 0.f, 0.f, 0.f, 0.f, 0.f, 0.f, 0.f, 0.f, 0.f, 0.f, 0.f, 0.f, 0.f}, o1 = o0;
#pragma unroll
    for (int kt = 0; kt < 5; ++kt)
#pragma unroll
        for (int s = 0; s < 2; ++s) {
            u32x4 pw; pw.x = pk2(st[kt][8 * s + 0], st[kt][8 * s + 1]); pw.y = pk2(st[kt][8 * s + 2], st[kt][8 * s + 3]);
            pw.z = pk2(st[kt][8 * s + 4], st[kt][8 * s + 5]); pw.w = pk2(st[kt][8 * s + 6], st[kt][8 * s + 7]);
            const s16x8 pf = __builtin_bit_cast(s16x8, pw);
#pragma unroll
            for (int dt = 0; dt < 2; ++dt) {
                const LAS unsigned char* vp = lds + ATT_VOFF + (32 * dt + r) * ATT_VROW + (32 * kt + 16 * s + 4 * hf) * 2;
                const u32x2 a0 = *(const LAS u32x2*)vp, a1 = *(const LAS u32x2*)(vp + 16);
                u32x4 vw; vw.x = a0.x; vw.y = a0.y; vw.z = a1.x; vw.w = a1.y;
                const s16x8 vf = __builtin_bit_cast(s16x8, vw);
                if (dt == 0) o0 = __builtin_amdgcn_mfma_f32_32x32x16_bf16(vf, pf, o0, 0, 0, 0);
                else o1 = __builtin_amdgcn_mfma_f32_32x32x16_bf16(vf, pf, o1, 0, 0, 0);
            }
        }
    bf16_t* op = O + (size_t)(q0 + r) * 1024 + h * 64 + 4 * hf;
#pragma unroll
    for (int i = 0; i < 4; ++i) {
        u32x2 w; w.x = pk2(o0[4 * i] * inv, o0[4 * i + 1] * inv); w.y = pk2(o0[4 * i + 2] * inv, o0[4 * i + 3] * inv); *(u32x2*)(op + 8 * i) = w;
        u32x2 w1; w1.x = pk2(o1[4 * i] * inv, o1[4 * i + 1] * inv); w1.y = pk2(o1[4 * i + 2] * inv, o1[4 * i + 3] * inv); *(u32x2*)(op + 32 + 8 * i) = w1;
    }
}

constexpr int NPHASE = 8;

#ifndef PROBE_PH
#define PROBE_PH -1
#endif
template <int PH, int REP = 1>
__device__ __forceinline__ void run_phase(const P& p, LAS unsigned char* lds, const XcdBarrier& xb) {
    int tid_ = threadIdx.x; asm volatile("" : "+v"(tid_));
    const int tid = tid_, lane = tid & 63, wave = tid >> 6;
    int bid_ = blockIdx.x; asm volatile("" : "+s"(bid_));
    const int bid = bid_;
    const int G = gridDim.x, gw = bid * 8 + wave, NGW = G * 8;
    const size_t gt = (size_t)bid * 512 + tid, NGT = (size_t)G * 512;
    unsigned char* ws = p.ws; unsigned char* dout = (unsigned char*)p.out;
    asm volatile("" : "+s"(ws), "+s"(dout));
    float* PART1 = (float*)(ws + WS_PART1); float* PART2 = (float*)(ws + WS_PART2);
    float2* AP = (float2*)(ws + WS_AP); float2* BBAR = (float2*)(ws + WS_BBAR); float2* ROPE = (float2*)(ws + WS_ROPE);
    bf16_t* WUP = (bf16_t*)(ws + WS_WUP); bf16_t* WDN = (bf16_t*)(ws + WS_WDN); bf16_t* WIN = (bf16_t*)(ws + WS_WIN); bf16_t* WGLU = (bf16_t*)(ws + WS_WGLU);
    bf16_t* WBRA = (bf16_t*)(ws + WS_WBRA); bf16_t* WBRS = (bf16_t*)(ws + WS_WBRS); bf16_t* WOUT = (bf16_t*)(ws + WS_WOUT);
    bf16_t* H = (bf16_t*)(ws + WS_H); bf16_t* OATT = (bf16_t*)(ws + WS_OATT); bf16_t* Q = (bf16_t*)(ws + WS_Q); bf16_t* OSSM = (bf16_t*)(ws + WS_OSSM);
    bf16_t* Kb = (bf16_t*)(ws + WS_K); bf16_t* VT = (bf16_t*)(ws + WS_VT); bf16_t* AX = (bf16_t*)(ws + WS_AX); bf16_t* Y = (bf16_t*)(ws + WS_Y);
    bf16_t* Mb = (bf16_t*)(ws + WS_M); bf16_t* GA = (bf16_t*)(ws + WS_GA); bf16_t* GS = (bf16_t*)(ws + WS_GS); float* MIXED = (float*)(ws + WS_MIXED);
    bf16_t* H2 = (bf16_t*)(ws + WS_H2); bf16_t* Ab = (bf16_t*)(ws + WS_A); float* DN = (float*)(ws + WS_DN);
    float* S = (float*)(dout + DO_S); float* KTAB = (float*)(dout + DO_KTAB); bf16_t* BC = (bf16_t*)(dout + DO_BC); bf16_t* YB = (bf16_t*)(dout + DO_YB);
    float* T1 = (float*)dout; float* X1 = (float*)dout;
    const float* x = p.in[0];

    if constexpr (PH == 0) {
        LAS float* scr = (LAS float*)(lds + wave * 16384);
        for (int base = bid * 32; base < TI_IN; base += G * 32) transpose_quad(p, base + wave * 4, scr, lane);
        {
            const int r0 = (bid < 200) ? 25 * bid : 5000 + 57 * (bid - 200), r1 = (bid < 200) ? r0 + 25 : r0 + 57;
            if (r0 + wave < r1) {
            f32x4 v[8];
#pragma unroll
            for (int j = 0; j < 8; ++j) v[j] = __builtin_nontemporal_load((const f32x4*)(x + (size_t)(r0 + wave) * DM) + 64 * j + lane);
            for (int m = r0 + wave; m < r1; m += 8) {
                const bool more = m + 8 < r1; f32x4 nv[8];
                if (more) {
#pragma unroll
                    for (int j = 0; j < 8; ++j) nv[j] = __builtin_nontemporal_load((const f32x4*)(x + (size_t)(m + 8) * DM) + 64 * j + lane); }
                float ss = 0.f;
#pragma unroll
                for (int j = 0; j < 8; ++j) ss += v[j].x * v[j].x + v[j].y * v[j].y + v[j].z * v[j].z + v[j].w * v[j].w;
                const float rr = rsqrtf(wave_sum(ss) * (1.0f / DM) + 1e-6f);
#pragma unroll
                for (int j = 0; j < 8; ++j) { const f32x4 g = ((const f32x4*)p.in[1])[64 * j + lane]; const f32x4 o = v[j] * rr * g;
                    u32x2 w; w.x = pk2(o.x, o.y); w.y = pk2(o.z, o.w); ((u32x2*)(H + (size_t)m * DM))[64 * j + lane] = w; }
                if (more) {
#pragma unroll
                    for (int j = 0; j < 8; ++j) v[j] = nv[j]; }
            }
            }
        }
        for (size_t e = gt; e < (size_t)NG * SP * NAP; e += NGT) {
            const int i = (int)(e / NAP), n = (int)(e % NAP), g = i / SP;
            const double dt = exp((double)p.in[9][g]), lr = (double)p.in[7][i], li = (double)p.in[8][i];
            const double pw = (n == 17) ? 1024.0 : (double)n;
            const float mag = (float)exp(pw * lr * dt); float sn, cs; sincos_d(pw * li * dt, sn, cs);
            AP[((size_t)g * NAP + n) * SP + (i % SP)] = make_float2(mag * cs, mag * sn);
        }
        for (size_t e = gt; e < (size_t)NG * SP * GC; e += NGT) {
            const int i = (int)(e >> 4), g = i / SP;
            const double dt = exp((double)p.in[9][g]), lr = (double)p.in[7][i], li = (double)p.in[8][i];
            float s1, c1; sincos_d(li * dt, s1, c1);
            const double mag1 = exp(lr * dt), are = mag1 * (double)c1, aim = mag1 * (double)s1;
            const double nr = are - 1.0, ni = aim, den = lr * lr + li * li;
            const double cre = (nr * lr + ni * li) / den, cim = (ni * lr - nr * li) / den;
            const double br = (double)p.in[10][e], bi = (double)p.in[11][e];
            BBAR[e] = make_float2((float)(cre * br - cim * bi), (float)(cre * bi + cim * br));
        }
        for (size_t i = gt; i < (size_t)SEQ * 8; i += NGT) {
            const int pos = (int)(i >> 3), k = (int)(i & 7);
            const double inv = exp(-(double)k * 0.125 * 13.122363377404328);
            float s, c; sincos_d((double)pos * inv, s, c);
            ROPE[i] = make_float2(c, s);
        }
        }
    if constexpr (PH == 1) {
        { pg8::Gemm g{H, WIN, SEQ, INW, DM, DM, DM, 1, 0, 0}; pg8::Order S; S.init(SEQ, INW, 1, G, bid, 3);
          EpiZf E{Q, Kb, VT, AX, GA, GS, (const float*)ROPE}; pg8::gemm_phase(lds, g, S, E, tid); }
        for (size_t e = gt; e < (size_t)NG * 256 * 32; e += NGT) {
            const int g = (int)(e >> 13), r = (int)(e >> 5) & 255, k8 = (int)e & 31, s_ = k8 >> 1, ci0 = (k8 & 1) * 8;
            u32x4 w = {0u, 0u, 0u, 0u};
            if (r < 128) { const int pp = r & 63; const float2 a = AP[((size_t)g * NAP + 15 - s_) * SP + pp];
                const f32x4* bp = (const f32x4*)(BBAR + ((size_t)g * SP + pp) * GC + ci0); const f32x4 b0 = bp[0], b1 = bp[1], b2 = bp[2], b3 = bp[3];
                if (r >> 6) { w.x = pk2(a.x * b0.y + a.y * b0.x, a.x * b0.w + a.y * b0.z); w.y = pk2(a.x * b1.y + a.y * b1.x, a.x * b1.w + a.y * b1.z);
                              w.z = pk2(a.x * b2.y + a.y * b2.x, a.x * b2.w + a.y * b2.z); w.w = pk2(a.x * b3.y + a.y * b3.x, a.x * b3.w + a.y * b3.z); }
                else {        w.x = pk2(a.x * b0.x - a.y * b0.y, a.x * b0.z - a.y * b0.w); w.y = pk2(a.x * b1.x - a.y * b1.y, a.x * b1.z - a.y * b1.w);
                              w.z = pk2(a.x * b2.x - a.y * b2.y, a.x * b2.z - a.y * b2.w); w.w = pk2(a.x * b3.x - a.y * b3.y, a.x * b3.z - a.y * b3.w); } }
            *(u32x4*)(BC + e * 8) = w;
        }
        for (size_t e = gt; e < (size_t)NG * 256 * 16; e += NGT) {
            const int g = (int)(e >> 12), row = (int)(e >> 4) & 255, r0 = ((int)e & 15) * 8, t = row >> 4, co = row & 15, pp0 = r0 & 63;
            const f32x4* ap = (const f32x4*)(AP + ((size_t)g * NAP + t + 1) * SP + pp0); const f32x4 a0 = ap[0], a1 = ap[1], a2 = ap[2], a3 = ap[3];
            const f32x4* crp = (const f32x4*)(p.in[12] + ((size_t)g * GC + co) * SP + pp0); const f32x4* cip = (const f32x4*)(p.in[13] + ((size_t)g * GC + co) * SP + pp0);
            const f32x4 cr0 = crp[0], cr1 = crp[1], ci0 = cip[0], ci1 = cip[1];
            u32x4 w;
            if (r0 >> 6) { w.x = pk2(-(cr0.x * a0.y + ci0.x * a0.x), -(cr0.y * a0.w + ci0.y * a0.z)); w.y = pk2(-(cr0.z * a1.y + ci0.z * a1.x), -(cr0.w * a1.w + ci0.w * a1.z));
                           w.z = pk2(-(cr1.x * a2.y + ci1.x * a2.x), -(cr1.y * a2.w + ci1.y * a2.z)); w.w = pk2(-(cr1.z * a3.y + ci1.z * a3.x), -(cr1.w * a3.w + ci1.w * a3.z)); }
            else {         w.x = pk2(cr0.x * a0.x - ci0.x * a0.y, cr0.y * a0.z - ci0.y * a0.w); w.y = pk2(cr0.z * a1.x - ci0.z * a1.y, cr0.w * a1.z - ci0.w * a1.w);
                           w.z = pk2(cr1.x * a2.x - ci1.x * a2.y, cr1.y * a2.z - ci1.y * a2.w); w.w = pk2(cr1.z * a3.x - ci1.z * a3.y, cr1.w * a3.z - ci1.w * a3.w); }
            *(u32x4*)(YB + ((size_t)g * 256 + row) * 384 + 256 + r0) = w;
        }
        {
            LAS float* Cre = (LAS float*)lds; LAS float* Cim = Cre + 16 * 65; LAS float* APr = Cim + 16 * 65; LAS float* APi = APr + 256; LAS float* Bbr = APi + 256; LAS float* Bbi = Bbr + 1024;
            for (int item = bid; item < NG * 4; item += G) {
                const int g = item >> 2, tq = item & 3;
                __syncthreads();
                for (int i = tid; i < 1024; i += 512) { Cre[(i >> 6) * 65 + (i & 63)] = p.in[12][(size_t)g * 1024 + i]; Cim[(i >> 6) * 65 + (i & 63)] = p.in[13][(size_t)g * 1024 + i];
                    const float2 b = BBAR[(size_t)g * 1024 + i]; Bbr[i] = b.x; Bbi[i] = b.y; }
                if (tid < 256) { const float2 a = AP[((size_t)g * NAP + 4 * tq + (tid >> 6)) * SP + (tid & 63)]; APr[tid] = a.x; APi[tid] = a.y; }
                __syncthreads();
#pragma unroll
                for (int rr = 0; rr < 2; ++rr) {
                    const int idx = tid + 512 * rr, tl = idx >> 8, co = (idx >> 4) & 15, ci = idx & 15;
                    float acc = 0.f;
#pragma unroll 8
                    for (int pp = 0; pp < SP; ++pp) {
                        const float cr = Cre[co * 65 + pp], cim = Cim[co * 65 + pp], ax = APr[tl * 64 + pp], ay = APi[tl * 64 + pp];
                        const float wre = cr * ax - cim * ay, wim = cr * ay + cim * ax;
                        acc += wre * Bbr[pp * 16 + ci] - wim * Bbi[pp * 16 + ci];
                    }
                    const int tau = 4 * tq + tl;
                    if (tau == 0 && co == ci) acc += p.in[14][g * GC + co];
                    KTAB[(((size_t)g * 16 + tau) * 16 + co) * 16 + ci] = acc;
                }
            }
            __syncthreads();
        }
        }
    if constexpr (PH == 2) {
        if (bid < 2 * NG) {
            const int g = bid & 63, h = bid >> 6;
            unsigned* flagS = (unsigned*)(ws + WS_CTL + 14464) + g;
            unsigned* flagX = (unsigned*)(ws + WS_CTL + 14464 + 256) + g;
            if (h == 0) {
                for (int e = tid; e < 256 * 32; e += 512) {
                    const int row = e >> 5, k8 = e & 31, s_ = k8 >> 1, ci0 = (k8 & 1) * 8, t = row >> 4, co = row & 15;
                    u32x4 w = {0u, 0u, 0u, 0u};
                    if (t >= s_) { const f32x4* kp = (const f32x4*)(KTAB + (((size_t)g * 16 + (t - s_)) * 16 + co) * 16 + ci0); w = pack8(kp[0], kp[1]); }
                    *(u32x4*)(YB + ((size_t)g * 256 + row) * 384 + 8 * k8) = w;
                }
            }
            { pg8::Gemm gm{AX, BC, 512, 256, 256, 384, 256, NG, (size_t)512 * 384, (size_t)256 * 256}; pg8::Order S_; S_.init(512, 256, NG, 1, 0, 1, 2 * g + h);
              EpiSf E{S}; pg8::gemm_phase(lds, gm, S_, E, tid); }
            asm volatile("s_waitcnt vmcnt(0)" ::: "memory"); __syncthreads();
            if (h == 1) {
                if (tid == 0) { __builtin_amdgcn_fence(__ATOMIC_RELEASE, "agent"); asm volatile("s_waitcnt vmcnt(0)" ::: "memory"); __hip_atomic_store(flagS, 1u, __ATOMIC_RELAXED, __HIP_MEMORY_SCOPE_AGENT);
                    unsigned sp = 0; while (__hip_atomic_load(flagX, __ATOMIC_RELAXED, __HIP_MEMORY_SCOPE_AGENT) == 0u && ++sp < (1u << 24)) __builtin_amdgcn_s_sleep(2);
                    __builtin_amdgcn_fence(__ATOMIC_ACQUIRE, "agent"); asm volatile("s_waitcnt vmcnt(0)" ::: "memory"); }
                __syncthreads();
            } else {
                if (tid == 0) { unsigned sp = 0; while (__hip_atomic_load(flagS, __ATOMIC_RELAXED, __HIP_MEMORY_SCOPE_AGENT) == 0u && ++sp < (1u << 24)) __builtin_amdgcn_s_sleep(2);
                    __builtin_amdgcn_fence(__ATOMIC_ACQUIRE, "agent"); asm volatile("s_waitcnt vmcnt(0)" ::: "memory"); }
                __syncthreads();
        LAS float* Elr = (LAS float*)lds; LAS float* Eli = Elr + 512;
        {
            const int pp = tid & 63, seg = tid >> 6;
            const float2 A16 = AP[((size_t)g * NAP + 16) * SP + pp], A1k = AP[((size_t)g * NAP + 17) * SP + pp];
            const float* Sg = S + (size_t)g * 512 * 128;
            float lre = 0.f, lim = 0.f;
            for (int j0 = seg * 64; j0 < seg * 64 + 64; j0 += 16) {
                float sr[16], si[16];
#pragma unroll
                for (int q = 0; q < 16; ++q) { sr[q] = Sg[(j0 + q) * 128 + pp]; si[q] = Sg[(j0 + q) * 128 + 64 + pp]; }
#pragma unroll
                for (int q = 0; q < 16; ++q) { const float nr = A16.x * lre - A16.y * lim + sr[q], ni = A16.x * lim + A16.y * lre + si[q]; lre = nr; lim = ni; }
            }
            __syncthreads();
            Elr[seg * 64 + pp] = lre; Eli[seg * 64 + pp] = lim;
            __syncthreads();
            float cre = 0.f, cim = 0.f;
            for (int s2 = 0; s2 < seg; ++s2) { const float2 e = make_float2(Elr[s2 * 64 + pp], Eli[s2 * 64 + pp]);
                const float nr = A1k.x * cre - A1k.y * cim + e.x, ni = A1k.x * cim + A1k.y * cre + e.y; cre = nr; cim = ni; }
            for (int j0 = seg * 64; j0 < seg * 64 + 64; j0 += 16) {
                float sr[16], si[16];
#pragma unroll
                for (int q = 0; q < 16; ++q) { sr[q] = Sg[(j0 + q) * 128 + pp]; si[q] = Sg[(j0 + q) * 128 + 64 + pp]; }
#pragma unroll
                for (int q = 0; q < 16; ++q) {
                    bf16_t* axr = AX + ((size_t)g * 512 + j0 + q) * 384 + 256;
                    axr[pp] = (bf16_t)f2bf(cre); axr[64 + pp] = (bf16_t)f2bf(cim);
                    const float nr = A16.x * cre - A16.y * cim + sr[q], ni = A16.x * cim + A16.y * cre + si[q]; cre = nr; cim = ni; }
            }
            }
                asm volatile("s_waitcnt vmcnt(0)" ::: "memory"); __syncthreads();
                if (tid == 0) { __builtin_amdgcn_fence(__ATOMIC_RELEASE, "agent"); asm volatile("s_waitcnt vmcnt(0)" ::: "memory"); __hip_atomic_store(flagX, 1u, __ATOMIC_RELAXED, __HIP_MEMORY_SCOPE_AGENT); }
                __syncthreads();
            }
            { pg8::Gemm gm{AX, YB, 512, 256, 384, 384, 384, NG, (size_t)512 * 384, (size_t)256 * 384}; pg8::Order S_; S_.init(512, 256, NG, 1, 0, 1, 2 * g + h);
              EpiYf E{Y}; pg8::gemm_phase(lds, gm, S_, E, tid); }
        } else if (bid < 2 * NG + 32) {
            pg8::Gemm gm{H, WIN, SEQ, INW, DM, DM, DM, 1, 0, 0}; pg8::Order S_; S_.init(SEQ, INW, 1, 1 << 20, bid - 2 * NG, 1, 768);
            EpiZf E{Q, Kb, VT, AX, GA, GS, (const float*)ROPE}; pg8::gemm_phase(lds, gm, S_, E, tid);
        } else {
            {
                const int step = G - (2 * NG + 32); int item = bid - (2 * NG + 32);
                AttnRegs R;
                if (item < 512) attn_load(R, Kb, VT, (item >> 1) * 32, item & 1, tid);
                while (item < 512) {
                    const int hk = item & 1, q0 = (item >> 1) * 32, h = hk * 8 + wave, nxt = item + step;
                    __syncthreads();
                    attn_store(R, lds, tid);
                    __syncthreads();
                    attn_item(lds, Q, OATT, p.in[6][h], q0, h, lane, R, Kb, VT, (nxt >> 1) * 32, nxt & 1, nxt < 512, tid);
                    item = nxt;
                }
            }
        }
        {
            unsigned* ctr = (unsigned*)(ws + WS_CTL + 14336); volatile LAS int* slot = (volatile LAS int*)(lds + 131072 + 64);
            for (;;) {
                __syncthreads();
                if (tid == 0) slot[0] = TI_IN + (int)__hip_atomic_fetch_add(ctr, 32u, __ATOMIC_RELAXED, __HIP_MEMORY_SCOPE_AGENT);
                __syncthreads();
                const int base = slot[0];
                if (base >= TI_ALL) break;
                transpose_quad(p, base + wave * 4, (LAS float*)(lds + wave * 16384), lane);
            }
        }
    }
    if constexpr (PH == 3) { pg8::Gemm g{Y, WGLU, SEQ, 2048, 1024, 1024, 1024, 1, 0, 0}; pg8::Order S_; S_.init(SEQ, 2048, 1, G, bid);
        EpiGLUf E{OSSM}; pg8::gemm_phase(lds, g, S_, E, tid); }
    if constexpr (PH == 4) {
        pg8::Gemm g{OATT, WBRA, SEQ, 2048, 1024, 1024, 1024, 2, (size_t)(OSSM - OATT), (size_t)(WBRS - WBRA)}; pg8::Order S_; S_.init(SEQ, 2048, 2, G, bid);
        EpiBrF E{GA, GS, Mb}; pg8::gemm_phase(lds, g, S_, E, tid);
    }
    if constexpr (PH == 5) { pg8::Gemm g{Mb, WOUT, SEQ, 2048, 2048, 2048, 2048, 1, 0, 0}; pg8::Order S_; S_.init(SEQ, 2048, 1, G, bid);
        EpiOutNormF E{x, p.in[2], p.in[3], X1, H2, PART1, PART2, xb}; pg8::gemm_phase(lds, g, S_, E, tid); }
    if constexpr (PH == 6) { pg8::Gemm g{H2, WUP, SEQ, DFF, DM, DM, DM, 1, 0, 0}; pg8::Order S_; S_.init(SEQ, DFF, 1, G, bid);
        EpiUpf E{Ab, PART2}; pg8::gemm_phase(lds, g, S_, E, tid); }
    if constexpr (PH == 7) { pg8::Gemm g{Ab, WDN, SEQ, DM, DFF, DFF, DFF, 1, 0, 0}; pg8::Order S_; S_.init(SEQ, DM, 1, G, bid);
        EpiDownNormF E{p.in[4], X1, PART1, xb}; pg8::gemm_phase(lds, g, S_, E, tid); }
}

constexpr int LDS_BYTES = 147456;

#ifndef TPROBE
#define TPROBE -1
#endif
template <int PH>
__device__ __forceinline__ void run_all(const P& p, LAS unsigned char* lds, cg::grid_group& grid, const XcdBarrier& xb, volatile LAS unsigned* misc) {
    if constexpr (PH == PROBE_PH) { run_phase<PH, 0>(p, lds, xb); xcd_barrier(xb); }
    run_phase<PH>(p, lds, xb);
    if constexpr (PH + 1 < NPHASE) {
        if constexpr (PH == 0) { if (p.use_cg_sync) grid.sync(); else xcd_barrier(xb); } else xcd_barrier(xb);
        if constexpr (TPROBE >= 0) { if (blockIdx.x == 0 && threadIdx.x == 0) misc[4 + PH + 1] = (unsigned)__builtin_amdgcn_s_memrealtime(); }
        run_all<PH + 1>(p, lds, grid, xb, misc);
    }
}
__global__ void __launch_bounds__(512, 2) k_all(P p) {
    extern __shared__ __attribute__((aligned(16))) unsigned char lds_raw[];
    cg::grid_group grid = cg::this_grid();
    LAS unsigned char* lds = (LAS unsigned char*)lds_raw;
    volatile LAS unsigned* misc = (volatile LAS unsigned*)(lds + 131072);
    if (threadIdx.x < 2) misc[threadIdx.x] = 0u;
    __syncthreads();
    const XcdBarrier xb = xcd_barrier_post((unsigned*)(p.ws + WS_CTL), misc);
    if constexpr (TPROBE >= 0) { if (blockIdx.x == 0 && threadIdx.x == 0) misc[4] = (unsigned)__builtin_amdgcn_s_memrealtime(); }
    run_all<0>(p, lds, grid, xb, misc);
    if constexpr (TPROBE >= 0) {
        if (blockIdx.x == 0 && threadIdx.x == 0) {
            const unsigned now = (unsigned)__builtin_amdgcn_s_memrealtime(); misc[4 + NPHASE] = now;
            const unsigned d = misc[4 + TPROBE + 1] - misc[4 + TPROBE];
            while ((unsigned)__builtin_amdgcn_s_memrealtime() - now < 8u * d) __builtin_amdgcn_s_sleep(8);
        }
    }
}

extern "C" void kernel_launch(void* const* d_in, const int* in_sizes, int n_in, void* d_out, int out_size, void* d_ws, size_t ws_size, hipStream_t stream) {
    static int grid = 0;
    if (grid == 0) {
        if (n_in != 20 || out_size != SEQ * DM || ws_size < WS_END) { fprintf(stderr, "kernel_launch: unexpected shapes (n_in %d out %d ws %zu)\n", n_in, out_size, ws_size); grid = -1; return; }
        int dev = 0, cus = 0;
        (void)hipGetDevice(&dev); (void)hipDeviceGetAttribute(&cus, hipDeviceAttributeMultiprocessorCount, dev);
        (void)hipFuncSetAttribute((const void*)k_all, hipFuncAttributeMaxDynamicSharedMemorySize, LDS_BYTES);
        int per_cu = 0;
        (void)hipOccupancyMaxActiveBlocksPerMultiprocessor(&per_cu, (const void*)k_all, 512, LDS_BYTES);
        if (per_cu < 1) fprintf(stderr, "kernel_launch: occupancy query says %d blocks/CU\n", per_cu);
        (void)hipGetLastError();
        if (cus != 256) { fprintf(stderr, "kernel_launch: built for a 256-CU device (one 512-thread workgroup per CU, one 256x256 tile per workgroup in the fused-norm GEMM phases); found %d CUs\n", cus); grid = -1; return; }
        grid = cus;
    }
    if (grid < 0) return;
    P p{};
    for (int i = 0; i < 20; ++i) p.in[i] = (const float*)d_in[i];
    p.out = (float*)d_out; p.ws = (unsigned char*)d_ws;
    (void)hipMemsetAsync((char*)d_ws + WS_CTL, 0, CTL_BYTES, stream);
    void* args[] = {&p};
    hipError_t e = hipLaunchCooperativeKernel((const void*)k_all, dim3(grid), dim3(512), args, LDS_BYTES, stream);
    if (e != hipSuccess) fprintf(stderr, "cooperative launch failed: %s (grid %d)\n", hipGetErrorString(e), grid);
}
```
